# Optimizing an MI355X kernel written in HIP

```python
import jax, jax.numpy as jnp
from jax import lax
import numpy as np

D_MODEL = 2048
BATCH = 1
SEQ = 8192
DEPTH = 4

N_META = 16
N_HEADS = 16
HEAD_DIM = 128
D_ATTN = N_HEADS * HEAD_DIM
KV_RANK = 256
IDX_HEADS = 8
IDX_DIM = 64
TOPK_MAX = 256
POOL_WINDOWS = (2, 4, 8, 16)
N_POOL_GROUPS = 4
D_POOL = D_MODEL // 2
POOL_GROUP = D_POOL // N_POOL_GROUPS
D_FF = 4 * D_MODEL
Q_BLOCK = 128
EPS = 1e-6
SPLIT_SIZES = (D_ATTN, KV_RANK, IDX_HEADS * IDX_DIM, IDX_DIM, IDX_HEADS, D_POOL, D_MODEL, D_MODEL)
N_IN = sum(SPLIT_SIZES)

kernel_name = "hybrid_dsa_multiscale_pool_gated"


def rms_norm(x, g):
    xf = x.astype(jnp.float32)
    y = xf * lax.rsqrt(jnp.mean(xf * xf, axis=-1, keepdims=True) + EPS)
    return (y * g.astype(jnp.float32)).astype(x.dtype)


def dsa_attention(q, c_kv, q_idx, k_idx, w_idx, w_uk, w_uv, n_keys):
    B, TP = q.shape[0], q.shape[1]
    topk = min(TOPK_MAX, n_keys // 4)
    nb = TP // Q_BLOCK
    q_lat = jnp.einsum('bthe,hce->bthc', q, w_uk)
    key_pos = jnp.arange(TP)
    batch_ix = jnp.arange(B)[:, None, None]

    def to_blocks(a):
        return a.reshape((B, nb, Q_BLOCK) + a.shape[2:]).swapaxes(0, 1)

    def block(args):
        ql, qi, wi, start = args
        qpos = start + jnp.arange(Q_BLOCK)
        causal = key_pos[None, :] <= qpos[:, None]
        logits = jnp.einsum('bqhd,bsd->bqhs', qi, k_idx).astype(jnp.float32) * (IDX_DIM ** -0.5)
        score = jnp.einsum('bqh,bqhs->bqs', wi.astype(jnp.float32), jax.nn.relu(logits))
        score = jnp.where(causal[None], score, -jnp.inf)
        _, idx = lax.top_k(score, topk)
        sel = c_kv[batch_ix, idx]
        s = jnp.einsum('bqhr,bqkr->bqhk', ql, sel).astype(jnp.float32) * (HEAD_DIM ** -0.5)
        valid = idx <= qpos[None, :, None]
        s = jnp.where(valid[:, :, None, :], s, -jnp.inf)
        p = jax.nn.softmax(s, axis=-1).astype(sel.dtype)
        return jnp.einsum('bqhk,bqkr->bqhr', p, sel)

    starts = jnp.arange(nb) * Q_BLOCK
    o_lat = lax.map(block, (to_blocks(q_lat), to_blocks(q_idx), to_blocks(w_idx), starts))
    o_lat = o_lat.swapaxes(0, 1).reshape(B, TP, N_HEADS, KV_RANK)
    o = jnp.einsum('bthc,hce->bthe', o_lat, w_uv)
    return o.reshape(B, TP, D_ATTN)


def multiscale_pool(p, w_pool, scale):
    B, TP = p.shape[0], p.shape[1]
    pg = p.astype(jnp.float32).reshape(B, TP, N_POOL_GROUPS, POOL_GROUP)
    csum = jnp.concatenate([jnp.zeros_like(pg[:, :1]), jnp.cumsum(pg, axis=1)], axis=1)
    t1 = jnp.arange(1, TP + 1)[:, None]
    win = jnp.array(POOL_WINDOWS, dtype=jnp.int32)[None, :]
    lo = jnp.maximum(t1 - win, 0)
    gix = jnp.arange(N_POOL_GROUPS)[None, :]
    window_sum = csum[:, 1:] - csum[:, lo, gix]
    count = (t1 - lo).astype(jnp.float32)[None, :, :, None]
    y = (window_sum / count - pg).astype(p.dtype)
    y = jnp.einsum('btgc,gcd->btgd', y, w_pool).reshape(B, TP, D_POOL)
    return y * scale


def setup_inputs(seed: int = 0) -> dict:
    key = jax.random.key(seed)
    ks = jax.random.split(key, 17)
    f32 = jnp.float32

    def nrm(k, shape, fan_in):
        return jax.random.normal(k, shape, f32) * (fan_in ** -0.5)

    def gain(k, shape):
        return 1.0 + 0.02 * jax.random.normal(k, shape, f32)

    return {
        "x": jax.random.normal(ks[0], (BATCH, SEQ, D_MODEL), f32),
        "meta_tokens": jax.random.normal(ks[1], (N_META, D_MODEL), f32),
        "norm_mix_g": gain(ks[2], (DEPTH, D_MODEL)),
        "w_in": nrm(ks[3], (DEPTH, D_MODEL, N_IN), D_MODEL),
        "kv_norm_g": gain(ks[4], (DEPTH, KV_RANK)),
        "idx_k_norm_g": gain(ks[5], (DEPTH, IDX_DIM)),
        "w_uk": nrm(ks[6], (DEPTH, N_HEADS, KV_RANK, HEAD_DIM), KV_RANK),
        "w_uv": nrm(ks[7], (DEPTH, N_HEADS, KV_RANK, HEAD_DIM), KV_RANK),
        "w_attn_o": nrm(ks[8], (DEPTH, D_ATTN, D_MODEL), D_ATTN),
        "w_pool": nrm(ks[9], (DEPTH, N_POOL_GROUPS, POOL_GROUP, POOL_GROUP), POOL_GROUP),
        "pool_scale": gain(ks[10], (DEPTH, D_POOL)),
        "w_pool_o": nrm(ks[11], (DEPTH, D_POOL, D_MODEL), D_POOL),
        "w_out": nrm(ks[12], (DEPTH, D_MODEL, D_MODEL), D_MODEL),
        "norm_mlp_g": gain(ks[13], (DEPTH, D_MODEL)),
        "w_mlp_in": nrm(ks[14], (DEPTH, D_MODEL, D_FF), D_MODEL),
        "w_mlp_out": nrm(ks[15], (DEPTH, D_FF, D_MODEL), D_FF),
        "final_norm_g": gain(ks[16], (D_MODEL,)),
    }


def reference(x, meta_tokens, norm_mix_g, w_in, kv_norm_g, idx_k_norm_g, w_uk, w_uv, w_attn_o,
              w_pool, pool_scale, w_pool_o, w_out, norm_mlp_g, w_mlp_in, w_mlp_out, final_norm_g):
    B, S, D = x.shape
    n_keys = S + N_META
    tp = -(-n_keys // Q_BLOCK) * Q_BLOCK
    meta = jnp.broadcast_to(meta_tokens.astype(x.dtype)[None], (B, N_META, D))
    pad = jnp.zeros((B, tp - n_keys, D), x.dtype)
    h_res = jnp.concatenate([meta, x, pad], axis=1)
    split_points = [int(v) for v in np.cumsum(SPLIT_SIZES)[:-1]]

    for l in range(DEPTH):
        h = rms_norm(h_res, norm_mix_g[l])
        proj = h @ w_in[l]
        q, c_kv, q_idx, k_idx, w_idx, p_in, g_a, g_b = jnp.split(proj, split_points, axis=-1)
        q = q.reshape(B, tp, N_HEADS, HEAD_DIM)
        c_kv = rms_norm(c_kv, kv_norm_g[l])
        q_idx = q_idx.reshape(B, tp, IDX_HEADS, IDX_DIM)
        k_idx = rms_norm(k_idx, idx_k_norm_g[l])
        w_idx = w_idx * (IDX_HEADS ** -0.5)
        a = dsa_attention(q, c_kv, q_idx, k_idx, w_idx, w_uk[l], w_uv[l], n_keys) @ w_attn_o[l]
        b = multiscale_pool(p_in, w_pool[l], pool_scale[l]) @ w_pool_o[l]
        merged = jax.nn.sigmoid(g_a) * a + jax.nn.sigmoid(g_b) * b
        h_res = h_res + merged @ w_out[l]
        h2 = rms_norm(h_res, norm_mlp_g[l])
        h_res = h_res + jnp.square(jax.nn.relu(h2 @ w_mlp_in[l])) @ w_mlp_out[l]

    y = rms_norm(h_res, final_norm_g)
    return y[:, N_META:N_META + S]
```

```cpp
#include <hip/hip_runtime.h>
#include <hip/hip_bf16.h>
#include <hip/hip_cooperative_groups.h>
#include <cstdio>
#include <type_traits>
namespace cg = cooperative_groups;

typedef unsigned short bf16_t;
typedef short bf16x8 __attribute__((ext_vector_type(8)));
typedef float f32x4 __attribute__((ext_vector_type(4)));
typedef float f32x16 __attribute__((ext_vector_type(16)));
typedef unsigned short u16x4 __attribute__((ext_vector_type(4)));
typedef unsigned u32x4 __attribute__((ext_vector_type(4)));

constexpr int D = 2048, SEQ = 8192, NMETA = 16, NKEYS = SEQ + NMETA, MP = 8448, DEPTH = 4;
constexpr int NIN = 8008, NINP = 8192, DFF = 8192;
constexpr int C_CKV = 2048, C_QIDX = 2304, C_KIDX = 2816, C_WIDX = 2880, C_PIN = 2888, C_GA = 3912, C_GB = 5960;
constexpr int NMT = 32;
constexpr int TAIL0 = 8192;

constexpr size_t SZ_HRES = (size_t)MP * D * 4, SZ_HN = (size_t)MP * D * 2, SZ_PROJ = (size_t)MP * NINP * 2;
constexpr size_t OFF_HRES = 0;
constexpr size_t OFF_HN = OFF_HRES + SZ_HRES;
constexpr size_t OFF_PROJ = OFF_HN + SZ_HN;
constexpr size_t OFF_CKV = OFF_PROJ + SZ_PROJ;
constexpr size_t OFF_KIDX = OFF_CKV + (size_t)MP * 256 * 2;
constexpr size_t OFF_YPOOL = OFF_KIDX + (size_t)MP * 64 * 2;
constexpr size_t OFF_YP2 = OFF_YPOOL + (size_t)MP * 1024 * 2;
constexpr size_t OFF_QLAT = OFF_YP2 + (size_t)MP * 1024 * 2;
constexpr size_t OFF_OLAT = OFF_QLAT + (size_t)MP * 4096 * 2;
constexpr size_t OFF_O = OFF_OLAT + (size_t)MP * 4096 * 2;
constexpr size_t OFF_MB = OFF_O + (size_t)MP * D * 2;
constexpr size_t OFF_MERGED = OFF_MB + (size_t)MP * D * 4;
constexpr size_t OFF_WIN = OFF_MERGED + (size_t)MP * D * 2;
constexpr size_t OFF_WUK = OFF_WIN + (size_t)NINP * D * 2;
constexpr size_t OFF_WUV = OFF_WUK + (size_t)16 * 256 * 256 * 2;
constexpr size_t OFF_WAO = OFF_WUV + (size_t)16 * 256 * 256 * 2;
constexpr size_t OFF_WPOOL = OFF_WAO + (size_t)D * D * 2;
constexpr size_t OFF_WPO = OFF_WPOOL + (size_t)4 * 256 * 256 * 2;
constexpr size_t OFF_WOUT = OFF_WPO + (size_t)D * 1024 * 2;
constexpr size_t OFF_WMI = OFF_WOUT + (size_t)D * D * 2;
constexpr size_t OFF_WMO = OFF_WMI + (size_t)DFF * D * 2;
constexpr size_t OFF_BAR = OFF_WMO + (size_t)D * DFF * 2;
constexpr size_t BAR_BYTES = 16384;
constexpr size_t WS_END = OFF_BAR + BAR_BYTES;

constexpr int SCLD = 8448;
constexpr int ST_LD = 272;
constexpr int LDS_SC_BYTES = 4 * SCLD * 4;
constexpr int LDS_IDX_OFF = (8 * 32 * ST_LD * 2 > LDS_SC_BYTES) ? 8 * 32 * ST_LD * 2 : LDS_SC_BYTES;
constexpr int CAND_CAP = 1024;
constexpr int LDS_CAND_OFF = LDS_IDX_OFF + 4 * 256 * 4;
constexpr int LDS_XB_OFF = LDS_CAND_OFF + 4 * CAND_CAP * 4;
constexpr int LDS_XCH_OFF = LDS_XB_OFF + 16;
constexpr int CAND_CAP2 = CAND_CAP / 2;
constexpr int LDS_BYTES = LDS_XCH_OFF + 144;

#ifndef REP_P1
#define REP_P1 1
#endif
#ifndef REP_P4
#define REP_P4 1
#endif
#ifndef REP_SC
#define REP_SC 1
#endif
#ifndef REP_SEL
#define REP_SEL 1
#endif
#ifndef REP_ATT
#define REP_ATT 1
#endif
#ifndef REP_P9
#define REP_P9 1
#endif
struct Params {
  const float* in[17];
  float* out;
  unsigned char* ws;
};

__device__ __forceinline__ unsigned short f2bf(float f) {
  unsigned u = __float_as_uint(f);
  u += 0x7FFFu + ((u >> 16) & 1u);
  return (unsigned short)(u >> 16);
}
__device__ __forceinline__ float bf2f(unsigned short h) { return __uint_as_float(((unsigned)h) << 16); }
typedef float f32x2_t __attribute__((ext_vector_type(2)));
typedef __bf16 bf16x2_t __attribute__((ext_vector_type(2)));
__device__ __forceinline__ unsigned pk2(float a, float b) { const f32x2_t f = {a, b}; return __builtin_bit_cast(unsigned, __builtin_convertvector(f, bf16x2_t)); }
__device__ __forceinline__ float shx(float v, int o, int lane) { return __int_as_float(__builtin_amdgcn_ds_bpermute((lane ^ o) << 2, __float_as_int(v))); }
__device__ __forceinline__ int shxi(int v, int o, int lane) { return __builtin_amdgcn_ds_bpermute((lane ^ o) << 2, v); }
__device__ __forceinline__ float wave_sum(float v, int lane) {
#pragma unroll
  for (int o = 1; o < 64; o <<= 1) v += shx(v, o, lane);
  return v;
}
__device__ __forceinline__ int lane_id() { return (int)__builtin_amdgcn_mbcnt_hi(~0u, __builtin_amdgcn_mbcnt_lo(~0u, 0u)); }
__device__ __forceinline__ float sigmoidf(float x) { return __builtin_amdgcn_rcpf(1.0f + __builtin_amdgcn_exp2f(-1.4426950408889634f * x)); }

constexpr int BM = 256, BK = 64, HALF = 128, HT = HALF * BK;
__device__ __forceinline__ int lds_byte(int r, int c) {
  int st = (r >> 4) * 2 + (c >> 5), rr = r & 15, cc = c & 31, ob = rr * 64 + cc * 2;
  return st * 1024 + (ob ^ (((ob >> 9) & 1) << 5));
}
__device__ __forceinline__ void stage_rc(int b, int& R, int& C) {
  int st = b / 1024, sb = b % 1024, swz = sb ^ (((sb >> 9) & 1) << 5);
  R = (st >> 1) * 16 + swz / 64;
  C = (st & 1) * 32 + (swz % 64) / 2;
}

template <class Epi>
__device__ __forceinline__ void gemm_tile(const bf16_t* __restrict__ A, const int lda, const bf16_t* __restrict__ Bt, const int ldb,
                                          const int brow, const int bcol, const int K, const Epi& epi, const int wave_s) {
  extern __shared__ __attribute__((aligned(16))) bf16_t shm[];
#define SA(b, h) (shm + ((b) * 2 + (h)) * HT)
#define SB(b, h) (shm + (4 + (b) * 2 + (h)) * HT)
#define STAGE_A(P, br, kt)                                                                                                   \
  do {                                                                                                                       \
    const bf16_t* _g = A + (long)(br) * lda + (long)(kt) * BK;                                                               \
    __builtin_amdgcn_global_load_lds((const unsigned*)(_g + aoff0), (unsigned*)((char*)(P) + sb0), 16, 0, 0);               \
    __builtin_amdgcn_global_load_lds((const unsigned*)(_g + aoff1), (unsigned*)((char*)(P) + sb1), 16, 0, 0);               \
  } while (0)
#define STAGE_B(P, br, kt)                                                                                                   \
  do {                                                                                                                       \
    const bf16_t* _g = Bt + (long)(br) * ldb + (long)(kt) * BK;                                                              \
    __builtin_amdgcn_global_load_lds((const unsigned*)(_g + boff0), (unsigned*)((char*)(P) + sb0), 16, 0, 0);               \
    __builtin_amdgcn_global_load_lds((const unsigned*)(_g + boff1), (unsigned*)((char*)(P) + sb1), 16, 0, 0);               \
  } while (0)
#define LDA(dst, b, h)                                                                                                       \
  for (int m = 0; m < 4; ++m)                                                                                                \
    for (int k = 0; k < 2; ++k) dst[m][k] = *reinterpret_cast<const bf16x8*>((char*)SA(b, h) + lds_byte(wr * 64 + m * 16 + fr, k * 32 + fq * 8))
#define LDB(dst, b, h)                                                                                                       \
  for (int n = 0; n < 2; ++n)                                                                                                \
    for (int k = 0; k < 2; ++k) dst[n][k] = *reinterpret_cast<const bf16x8*>((char*)SB(b, h) + lds_byte(wc * 32 + n * 16 + fr, k * 32 + fq * 8))
#define MMA(ai, bj, At_, Bt_)                                                                                                \
  do {                                                                                                                       \
    __builtin_amdgcn_s_setprio(1);                                                                                           \
    for (int m = 0; m < 4; ++m)                                                                                              \
      for (int n = 0; n < 2; ++n)                                                                                            \
        for (int k = 0; k < 2; ++k)                                                                                          \
          acc[ai][bj][m][n] = __builtin_amdgcn_mfma_f32_16x16x32_bf16(Bt_[n][k], At_[m][k], acc[ai][bj][m][n], 0, 0, 0);    \
    __builtin_amdgcn_s_setprio(0);                                                                                           \
  } while (0)
#define WAIT_V(n) asm volatile("s_waitcnt vmcnt(" #n ")" ::: "memory")
#define WAIT_L(n) asm volatile("s_waitcnt lgkmcnt(" #n ")" ::: "memory")
#define BAR __builtin_amdgcn_s_barrier()
#define SCHED __builtin_amdgcn_sched_barrier(0)

  int tx = wave_s * 64 + lane_id();
  asm volatile("" : "+v"(tx));
  const int wid = tx >> 6, lane = tx & 63, wr = wid >> 2, wc = wid & 3, fr = lane & 15, fq = lane >> 4;
  const int sb0 = tx * 16, sb1 = sb0 + 8192;
  int r0, c0, r1, c1;
  stage_rc(sb0, r0, c0);
  stage_rc(sb1, r1, c1);
  const unsigned aoff0 = (unsigned)(r0 * lda + c0), aoff1 = (unsigned)(r1 * lda + c1);
  const int rp0 = (r0 & ~31) | (8 * ((r0 & 15) >> 2) + 4 * ((r0 >> 4) & 1) + (r0 & 3));
  const int rp1 = (r1 & ~31) | (8 * ((r1 & 15) >> 2) + 4 * ((r1 >> 4) & 1) + (r1 & 3));
  const unsigned boff0 = (unsigned)(rp0 * ldb + c0), boff1 = (unsigned)(rp1 * ldb + c1);
  f32x4 acc[2][2][4][2];
#pragma unroll
  for (int a = 0; a < 2; ++a)
#pragma unroll
    for (int b = 0; b < 2; ++b)
#pragma unroll
      for (int m = 0; m < 4; ++m)
#pragma unroll
        for (int n = 0; n < 2; ++n) acc[a][b][m][n] = (f32x4){0.f, 0.f, 0.f, 0.f};
  bf16x8 At[4][2], B0[2][2], B1[2][2];
  const int nt = K / BK;
  STAGE_B(SB(0, 0), bcol, 0);
  STAGE_A(SA(0, 0), brow, 0);
  STAGE_B(SB(0, 1), bcol + HALF, 0);
  STAGE_A(SA(0, 1), brow + HALF, 0);
  if (wr == 1) BAR;
  WAIT_V(4);
  BAR;
  STAGE_B(SB(1, 0), bcol, 1);
  STAGE_A(SA(1, 0), brow, 1);
  STAGE_B(SB(1, 1), bcol + HALF, 1);
  WAIT_V(6);
  BAR;
  for (int t = 0; t < nt - 2; t += 2) {
    LDB(B0, 0, 0); SCHED; LDA(At, 0, 0); STAGE_A(SA(1, 1), brow + HALF, t + 1);
    WAIT_L(8); BAR; WAIT_L(0); MMA(0, 0, At, B0); BAR; SCHED;
    LDB(B1, 0, 1); STAGE_B(SB(0, 0), bcol, t + 2);
    BAR; WAIT_L(0); MMA(0, 1, At, B1); BAR;
    LDA(At, 0, 1); STAGE_A(SA(0, 0), brow, t + 2);
    BAR; WAIT_L(0); MMA(1, 0, At, B0); BAR; SCHED;
    STAGE_B(SB(0, 1), bcol + HALF, t + 2);
    WAIT_V(6); BAR; MMA(1, 1, At, B1); BAR;
    LDB(B0, 1, 0); SCHED; LDA(At, 1, 0); STAGE_A(SA(0, 1), brow + HALF, t + 2);
    WAIT_L(8); BAR; WAIT_L(0); MMA(0, 0, At, B0); BAR; SCHED;
    LDB(B1, 1, 1); STAGE_B(SB(1, 0), bcol, t + 3);
    BAR; WAIT_L(0); MMA(0, 1, At, B1); BAR;
    LDA(At, 1, 1); STAGE_A(SA(1, 0), brow, t + 3);
    BAR; WAIT_L(0); MMA(1, 0, At, B0); BAR; SCHED;
    STAGE_B(SB(1, 1), bcol + HALF, t + 3);
    WAIT_V(6); BAR; MMA(1, 1, At, B1); BAR;
  }
  {
    LDB(B0, 0, 0); LDA(At, 0, 0); STAGE_A(SA(1, 1), brow + HALF, nt - 1);
    BAR; WAIT_L(0); MMA(0, 0, At, B0); BAR;
    LDB(B1, 0, 1); BAR; WAIT_L(0); MMA(0, 1, At, B1); BAR;
    LDA(At, 0, 1); WAIT_V(4); BAR; WAIT_L(0); MMA(1, 0, At, B0); MMA(1, 1, At, B1); BAR;
  }
  {
    LDB(B0, 1, 0); LDA(At, 1, 0); WAIT_V(2); BAR; WAIT_L(0); MMA(0, 0, At, B0); BAR;
    LDB(B1, 1, 1); WAIT_V(0); BAR; WAIT_L(0); MMA(0, 1, At, B1); BAR;
    LDA(At, 1, 1); BAR; WAIT_L(0); MMA(1, 0, At, B0); MMA(1, 1, At, B1); BAR;
  }
  if (wr == 0) BAR;
#pragma unroll
  for (int ai = 0; ai < 2; ++ai)
#pragma unroll
    for (int m = 0; m < 4; ++m)
#pragma unroll
      for (int bj = 0; bj < 2; ++bj)
        epi(brow + ai * HALF + wr * 64 + m * 16 + fr, bcol + bj * HALF + wc * 32 + fq * 8, acc[ai][bj][m][0], acc[ai][bj][m][1]);
#undef SA
#undef SB
#undef STAGE_A
#undef STAGE_B
#undef LDA
#undef LDB
#undef MMA
}


template <class Epi>
__device__ __forceinline__ void tail_gemm8(const bf16_t* __restrict__ A, const int lda, const bf16_t* __restrict__ Bt, const int ldb,
                                           const int nct, const int K, const Epi& epi, const int wave_s) {
  extern __shared__ __attribute__((aligned(16))) bf16_t shm[];
  float* red = (float*)shm;
  int tx = wave_s * 64 + lane_id(), bid_ = blockIdx.x;
  asm volatile("" : "+v"(tx), "+s"(bid_));
  const int wave = tx >> 6, lane = tx & 63, fr = lane & 15, fq = lane >> 4;
  const int kw = K >> 3;
  for (int ct = bid_; ct < nct; ct += gridDim.x) {
    const bf16_t* ap = A + (size_t)fr * lda + wave * kw + fq * 8;
    const bf16_t* bp = Bt + (size_t)(ct * 16 + fr) * ldb + wave * kw + fq * 8;
    f32x4 acc = (f32x4){0.f, 0.f, 0.f, 0.f};
#pragma unroll 8
    for (int k = 0; k < kw; k += 32) {
      const bf16x8 a = *(const bf16x8*)(ap + k);
      const bf16x8 b = *(const bf16x8*)(bp + k);
      acc = __builtin_amdgcn_mfma_f32_16x16x32_bf16(b, a, acc, 0, 0, 0);
    }
    *(f32x4*)(red + (wave * 64 + lane) * 4) = acc;
    __syncthreads();
    if (wave == 0) {
      f32x4 sum = acc;
#pragma unroll
      for (int w = 1; w < 8; ++w) sum += *(const f32x4*)(red + (w * 64 + lane) * 4);
      epi(TAIL0 + fr, ct * 16 + fq * 4, sum);
    }
    __syncthreads();
  }
}
template <class Epi>
__device__ __forceinline__ void tail_tile1(const bf16_t* __restrict__ A, const int lda, const bf16_t* __restrict__ Bt, const int ldb,
                                           const int ct, const int K, const int lane, const Epi& epi) {
  const int fr = lane & 15, fq = lane >> 4;
  const bf16_t* ap = A + (size_t)fr * lda + fq * 8;
  const bf16_t* bp = Bt + (size_t)(ct * 16 + fr) * ldb + fq * 8;
  f32x4 acc = (f32x4){0.f, 0.f, 0.f, 0.f};
#pragma unroll 8
  for (int k = 0; k < K; k += 32) {
    const bf16x8 a = *(const bf16x8*)(ap + k);
    const bf16x8 b = *(const bf16x8*)(bp + k);
    acc = __builtin_amdgcn_mfma_f32_16x16x32_bf16(b, a, acc, 0, 0, 0);
  }
  epi(TAIL0 + fr, ct * 16 + fq * 4, acc);
}

__device__ __forceinline__ void tile_map(int wgid, int nM, int nN, int& pm, int& pn) {
  const int nwg = nM * nN, q = nwg / 8, r = nwg % 8, xcd = wgid % 8, off = wgid / 8;
  wgid = (xcd < r ? xcd * (q + 1) : r * (q + 1) + (xcd - r) * q) + off;
  const int nig = 8 * nN, gid = wgid / nig, fm = gid * 8, gsz = (nM - fm) < 8 ? (nM - fm) : 8;
  pm = fm + ((wgid % nig) % gsz);
  pn = (wgid % nig) / gsz;
}


typedef unsigned u32x2 __attribute__((ext_vector_type(2)));
template <int GRP>
__device__ __forceinline__ void pool_group(const bf16_t* __restrict__ PROJ, bf16_t* __restrict__ YPOOL, const int r, const int lane) {
  constexpr int W = 2 << GRP;
  u32x2 raw[W];
#pragma unroll
  for (int i = 0; i < W; ++i) {
    const int t = (r - i) < 0 ? 0 : (r - i);
    raw[i] = *(const u32x2*)(PROJ + (size_t)t * NINP + C_PIN + GRP * 256 + lane * 4);
  }
  float s0 = 0.f, s1 = 0.f, s2 = 0.f, s3 = 0.f;
#pragma unroll
  for (int i = W - 1; i >= 0; --i) {
    if (r - i >= 0) {
      s0 += bf2f(raw[i].x & 0xffff); s1 += bf2f(raw[i].x >> 16); s2 += bf2f(raw[i].y & 0xffff); s3 += bf2f(raw[i].y >> 16);
    }
  }
  const float c0 = bf2f(raw[0].x & 0xffff), c1 = bf2f(raw[0].x >> 16), c2 = bf2f(raw[0].y & 0xffff), c3 = bf2f(raw[0].y >> 16);
  const int cntw = (r + 1) < W ? (r + 1) : W;
  const float inv = 1.0f / (float)cntw;
  uint2 o; o.x = pk2(s0 * inv - c0, s1 * inv - c1); o.y = pk2(s2 * inv - c2, s3 * inv - c3);
  *(uint2*)(YPOOL + (size_t)r * 1024 + GRP * 256 + lane * 4) = o;
}


__device__ __forceinline__ void rmsnorm_rows(const float* __restrict__ HRES, const float* __restrict__ g, bf16_t* __restrict__ HN,
                                             const int gw, const int NGW, const int lane) {
  for (int r = gw; r < NKEYS; r += 2 * NGW) {
    const int r2 = (r + NGW < NKEYS) ? r + NGW : r;
    f32x4 va[8], vb[8];
#pragma unroll
    for (int j = 0; j < 8; ++j) {
      va[j] = *(const f32x4*)(HRES + (size_t)r * D + j * 256 + lane * 4);
      vb[j] = *(const f32x4*)(HRES + (size_t)r2 * D + j * 256 + lane * 4);
    }
    float sa = 0.f, sb = 0.f;
#pragma unroll
    for (int j = 0; j < 8; ++j) {
      sa += va[j][0] * va[j][0] + va[j][1] * va[j][1] + va[j][2] * va[j][2] + va[j][3] * va[j][3];
      sb += vb[j][0] * vb[j][0] + vb[j][1] * vb[j][1] + vb[j][2] * vb[j][2] + vb[j][3] * vb[j][3];
    }
#pragma unroll
    for (int o = 1; o < 64; o <<= 1) { sa += shx(sa, o, lane); sb += shx(sb, o, lane); }
    const float ra = rsqrtf(sa * (1.0f / D) + 1e-6f), rb = rsqrtf(sb * (1.0f / D) + 1e-6f);
#pragma unroll
    for (int j = 0; j < 8; ++j) {
      const f32x4 gg = *(const f32x4*)(g + j * 256 + lane * 4);
      uint2 oa, ob;
      oa.x = pk2(va[j][0] * ra * gg[0], va[j][1] * ra * gg[1]); oa.y = pk2(va[j][2] * ra * gg[2], va[j][3] * ra * gg[3]);
      ob.x = pk2(vb[j][0] * rb * gg[0], vb[j][1] * rb * gg[1]); ob.y = pk2(vb[j][2] * rb * gg[2], vb[j][3] * rb * gg[3]);
      *(uint2*)(HN + (size_t)r * D + j * 256 + lane * 4) = oa;
      *(uint2*)(HN + (size_t)r2 * D + j * 256 + lane * 4) = ob;
    }
  }
}

__device__ __forceinline__ void wconv_T(const float* __restrict__ W, int K, int N, int Npad, bf16_t* __restrict__ WT, int ldt,
                                        int nbatch, size_t strideW, size_t strideWT, float scale, const int wave_s) {
  extern __shared__ __attribute__((aligned(16))) bf16_t shm[];
  float* tile = (float*)shm;
  const int nkb = K / 64, nnb = Npad / 256, per = nkb * nnb, items = per * nbatch;
  int t = wave_s * 64 + lane_id(), bid_ = blockIdx.x;
  asm volatile("" : "+v"(t), "+s"(bid_));
  for (int item = bid_; item < items; item += gridDim.x) {
    const int b = item / per, it = item % per, kb = it % nkb, nb = it / nkb, k0 = kb * 64, n0 = nb * 256;
    const float* Wb = W + (size_t)b * strideW;
    bf16_t* WTb = WT + (size_t)b * strideWT;
    float4 v[8];
#pragma unroll
    for (int i = 0; i < 8; ++i) {
      const int kk = (t >> 4) + 32 * (i & 1), n4 = (t & 15) * 4 + (i >> 1) * 64;
      v[i] = make_float4(0.f, 0.f, 0.f, 0.f);
      if (n0 + n4 < N) {
        const f32x4 w4 = __builtin_nontemporal_load((const f32x4*)(Wb + (size_t)(k0 + kk) * N + n0 + n4));
        v[i] = make_float4(w4[0], w4[1], w4[2], w4[3]);
      }
    }
#pragma unroll
    for (int i = 0; i < 8; ++i) {
      const int kk = (t >> 4) + 32 * (i & 1), c4 = (t & 15) * 4;
      float* tp = tile + (i >> 1) * (64 * 65) + kk * 65 + c4;
      tp[0] = v[i].x; tp[1] = v[i].y; tp[2] = v[i].z; tp[3] = v[i].w;
    }
    __syncthreads();
    {
      const int n = t >> 3, kc = (t & 7) * 8;
#pragma unroll
      for (int sub = 0; sub < 4; ++sub) {
        const float* tp = tile + sub * (64 * 65) + kc * 65 + n;
        uint4 o;
        o.x = pk2(tp[0 * 65] * scale, tp[1 * 65] * scale);
        o.y = pk2(tp[2 * 65] * scale, tp[3 * 65] * scale);
        o.z = pk2(tp[4 * 65] * scale, tp[5 * 65] * scale);
        o.w = pk2(tp[6 * 65] * scale, tp[7 * 65] * scale);
        *(uint4*)(WTb + (size_t)(n0 + sub * 64 + n) * ldt + k0 + kc) = o;
      }
    }
    __syncthreads();
  }
}


#define XB_TMO      128
#define XB_XCNT(j)  (256  + 64 * (j))
#define XB_XSUB(j)  (1280 + 64 * (j))
#define XB_XGEN(j)  (2304 + 64 * (j))
#define XB_TOP      3328
#define XB_TOPGEN   3392
#define XCD_BAR_WORDS 3456
#define XB_SPIN_CAP (1u << 18)
#define LAS __attribute__((address_space(3)))
__device__ __forceinline__ unsigned xb_ld(unsigned* p)              { return __hip_atomic_load(p, __ATOMIC_RELAXED, __HIP_MEMORY_SCOPE_AGENT); }
__device__ __forceinline__ unsigned xb_add(unsigned* p, unsigned v) { return __hip_atomic_fetch_add(p, v, __ATOMIC_RELAXED, __HIP_MEMORY_SCOPE_AGENT); }
__device__ __forceinline__ unsigned xb_xcc_id() { return (unsigned)__builtin_amdgcn_s_getreg((3 << 11) | 20) & 0xFu; }
#define XB_SPIN(cond, bar) do { unsigned _sp = 0; while (cond) { __builtin_amdgcn_s_sleep(1); \
    if ((++_sp & 255u) == 0u) { if (xb_ld(&(bar)[XB_TMO])) break; if (_sp > XB_SPIN_CAP) { atomicAdd(&(bar)[XB_TMO], 1u); break; } } } } while (0)
struct XcdBarrier { unsigned* bar; unsigned x; volatile LAS unsigned* st; };
__device__ __forceinline__ XcdBarrier xcd_barrier_post(unsigned* bar, volatile LAS unsigned* st) {
    XcdBarrier b; b.bar = bar; b.x = xb_xcc_id(); b.st = st;
    if (threadIdx.x == 0) (void)xb_add(&bar[XB_XCNT(b.x)], 1u);
    return b;
}
__device__ __forceinline__ void xcd_barrier_complete(unsigned* bar, unsigned x, unsigned& nloc, unsigned& nx) {
    const unsigned G = gridDim.x * gridDim.y * gridDim.z;
    unsigned sum, cnt, mine, sp = 0u;
    for (;;) {
        sum = 0u; cnt = 0u; mine = 0u;
#pragma unroll
        for (unsigned j = 0; j < 16; ++j) { const unsigned c = xb_ld(&bar[XB_XCNT(j)]); sum += c; cnt += (c > 0u) ? 1u : 0u; mine = (j == x) ? c : mine; }
        if (sum == G) break;
        __builtin_amdgcn_s_sleep(1);
        if ((++sp & 255u) == 0u) { if (xb_ld(&bar[XB_TMO])) break; if (sp > XB_SPIN_CAP) { atomicAdd(&bar[XB_TMO], 1u); break; } }
    }
    nloc = mine > 0u ? mine : 1u; nx = cnt > 0u ? cnt : 1u;
}
__device__ __forceinline__ void xcd_barrier(const XcdBarrier& b, const int wave_s) {
    asm volatile("s_waitcnt vmcnt(0)" ::: "memory");
    __syncthreads();
    if (wave_s == 0 && lane_id() == 0) {
        unsigned* bar = b.bar;
        __builtin_amdgcn_s_waitcnt(0);
        unsigned nloc = b.st[0], nx = b.st[1];
        if (nloc == 0u) { xcd_barrier_complete(bar, b.x, nloc, nx); b.st[0] = nloc; b.st[1] = nx; }
        const unsigned old = xb_add(&bar[XB_XSUB(b.x)], 1u);
        const unsigned gen = old / nloc;
        if (old + 1u == (gen + 1u) * nloc) {
            __builtin_amdgcn_fence(__ATOMIC_RELEASE, "agent");
            asm volatile("s_waitcnt vmcnt(0)" ::: "memory");
            const unsigned og = xb_add(&bar[XB_TOP], 1u);
            const unsigned tg = og / nx;
            if (og + 1u == (tg + 1u) * nx) xb_add(&bar[XB_TOPGEN], 1u);
            else XB_SPIN(xb_ld(&bar[XB_TOPGEN]) == tg, bar);
            __builtin_amdgcn_fence(__ATOMIC_ACQUIRE, "agent");
            xb_add(&bar[XB_XGEN(b.x)], 1u);
            asm volatile("s_waitcnt vmcnt(0)" ::: "memory");
        } else {
            XB_SPIN(xb_ld(&bar[XB_XGEN(b.x)]) == gen, bar);
            __builtin_amdgcn_fence(__ATOMIC_ACQUIRE, "agent");
            asm volatile("s_waitcnt vmcnt(0)" ::: "memory");
        }
    }
    __syncthreads();
}

__global__ void __launch_bounds__(512) fwd(Params p) {
  extern __shared__ __attribute__((aligned(16))) bf16_t shm[];
  cg::grid_group grid = cg::this_grid();
  const int wave_s = __builtin_amdgcn_readfirstlane((int)(threadIdx.x >> 6));
  volatile LAS unsigned* xst = (volatile LAS unsigned*)((LAS char*)shm + LDS_XB_OFF);
  if (threadIdx.x == 0) { xst[0] = 0u; xst[1] = 0u; xst[2] = 0u; xst[3] = 0u; }
  __syncthreads();
  const XcdBarrier xbar = xcd_barrier_post((unsigned*)(p.ws + OFF_BAR), xst);
#define BLOCK_IDS                                   \
  int bid = blockIdx.x, G = gridDim.x;              \
  asm volatile("" : "+s"(bid), "+s"(G));            \
  const int NGW = G * 8; (void)NGW;
#define PHASE_PTRS \
  unsigned long long zo_ = 0; \
  asm volatile("" : "+s"(zo_)); \
  unsigned char* wsb = p.ws + zo_; \
  float* HRES = (float*)(wsb + OFF_HRES); \
  bf16_t* HN = (bf16_t*)(wsb + OFF_HN); \
  bf16_t* PROJ = (bf16_t*)(wsb + OFF_PROJ); \
  bf16_t* CKV = (bf16_t*)(wsb + OFF_CKV); \
  bf16_t* KIDX = (bf16_t*)(wsb + OFF_KIDX); \
  bf16_t* YPOOL = (bf16_t*)(wsb + OFF_YPOOL); \
  bf16_t* YP2 = (bf16_t*)(wsb + OFF_YP2); \
  bf16_t* QLAT = (bf16_t*)(wsb + OFF_QLAT); \
  bf16_t* OLAT = (bf16_t*)(wsb + OFF_OLAT); \
  bf16_t* OB = (bf16_t*)(wsb + OFF_O); \
  float* MB = (float*)(wsb + OFF_MB); \
  bf16_t* MERGED = (bf16_t*)(wsb + OFF_MERGED); \
  bf16_t* WIN = (bf16_t*)(wsb + OFF_WIN); \
  bf16_t* WUK = (bf16_t*)(wsb + OFF_WUK); \
  bf16_t* WUV = (bf16_t*)(wsb + OFF_WUV); \
  bf16_t* WAO = (bf16_t*)(wsb + OFF_WAO); \
  bf16_t* WPOOL = (bf16_t*)(wsb + OFF_WPOOL); \
  bf16_t* WPO = (bf16_t*)(wsb + OFF_WPO); \
  bf16_t* WOUT = (bf16_t*)(wsb + OFF_WOUT); \
  bf16_t* WMI = (bf16_t*)(wsb + OFF_WMI); \
  bf16_t* WMO = (bf16_t*)(wsb + OFF_WMO); \
  bf16_t* UB = PROJ; \
  (void)HRES; (void)HN; (void)CKV; (void)KIDX; (void)YPOOL; (void)YP2; (void)QLAT; (void)OLAT; (void)OB; (void)MB; (void)MERGED; (void)WIN; (void)WUK; (void)WUV; (void)WAO; (void)WPOOL; (void)WPO; (void)WOUT; (void)WMI; (void)WMO; (void)UB;
#define PHASE_IDS                                  \
  int tid = wave_s * 64 + lane_id();               \
  asm volatile("" : "+v"(tid));                    \
  const int wave = tid >> 6, lane = tid & 63, gw = bid * 8 + wave; \
  (void)lane; (void)gw; \
  PHASE_PTRS


  {
  BLOCK_IDS
  PHASE_IDS
  for (int r = gw; r < NKEYS; r += NGW) {
#pragma unroll
    for (int j = 0; j < 8; ++j) {
      const int c = j * 256 + lane * 4;
      float4 v = make_float4(0.f, 0.f, 0.f, 0.f);
      if (r < NMETA) v = *(const float4*)(p.in[1] + (size_t)r * D + c);
      else if (r < NKEYS) v = *(const float4*)(p.in[0] + (size_t)(r - NMETA) * D + c);
      *(float4*)(HRES + (size_t)r * D + c) = v;
    }
  }
  }
  grid.sync();

#pragma unroll 1
  for (int l = 0; l < DEPTH; ++l) {
    BLOCK_IDS
    for (int rep = 0; rep < REP_P1; ++rep) {
      PHASE_IDS
      rmsnorm_rows(HRES, p.in[2] + (size_t)l * D, HN, gw, NGW, lane);
      wconv_T(p.in[3] + (size_t)l * D * NIN, D, NIN, NINP, WIN, D, 1, 0, 0, 1.0f, wave_s);
      wconv_T(p.in[7] + (size_t)l * 16 * 256 * 128, 256, 128, 256, WUV, 256, 16, (size_t)256 * 128, (size_t)65536, 1.0f, wave_s);
      wconv_T(p.in[8] + (size_t)l * D * D, D, D, D, WAO, D, 1, 0, 0, 1.0f, wave_s);
      wconv_T(p.in[9] + (size_t)l * 4 * 65536, 256, 256, 256, WPOOL, 256, 4, (size_t)65536, (size_t)65536, 1.0f, wave_s);
      wconv_T(p.in[11] + (size_t)l * 1024 * D, 1024, D, D, WPO, 1024, 1, 0, 0, 1.0f, wave_s);
      wconv_T(p.in[12] + (size_t)l * D * D, D, D, D, WOUT, D, 1, 0, 0, 1.0f, wave_s);
      wconv_T(p.in[14] + (size_t)l * D * DFF, D, DFF, DFF, WMI, D, 1, 0, 0, 1.0f, wave_s);
      wconv_T(p.in[15] + (size_t)l * DFF * D, DFF, D, D, WMO, DFF, 1, 0, 0, 1.0f, wave_s);
      {
        const float* wuk = p.in[6] + (size_t)l * 16 * 256 * 128;
        const float sc = 0.08838834764831845f * 1.4426950408889634f;
        for (int i = bid * 512 + tid; i < 16 * 256 * 32; i += G * 512) {
          const int row = i >> 5, kc = (i & 31) * 8;
          uint4 o = make_uint4(0u, 0u, 0u, 0u);
          if (kc < 128) {
            const f32x4 a = __builtin_nontemporal_load((const f32x4*)(wuk + (size_t)row * 128 + kc));
            const f32x4 b = __builtin_nontemporal_load((const f32x4*)(wuk + (size_t)row * 128 + kc + 4));
            o.x = pk2(a[0] * sc, a[1] * sc); o.y = pk2(a[2] * sc, a[3] * sc);
            o.z = pk2(b[0] * sc, b[1] * sc); o.w = pk2(b[2] * sc, b[3] * sc);
          }
          *(uint4*)(WUK + (size_t)row * 256 + kc) = o;
        }
      }
    }
    xcd_barrier(xbar, wave_s);

    {
      PHASE_PTRS
      auto epi = [&](int row, int col, f32x4 v) {
        uint2 o; o.x = pk2(v[0], v[1]); o.y = pk2(v[2], v[3]);
        *(uint2*)(PROJ + (size_t)row * NINP + col) = o;
      };
      auto epi8 = [&](int row, int col, f32x4 a, f32x4 b) {
        uint4 o; o.x = pk2(a[0], a[1]); o.y = pk2(a[2], a[3]); o.z = pk2(b[0], b[1]); o.w = pk2(b[2], b[3]);
        *(uint4*)(PROJ + (size_t)row * NINP + col) = o;
      };
      const int nN = NINP / 256, ntiles = NMT * nN;
      for (int t = bid; t < ntiles; t += G) {
        int pm, pn; tile_map(t, NMT, nN, pm, pn);
        gemm_tile(HN, D, WIN, D, pm * 256, pn * 256, D, epi8, wave_s);
      }
      tail_gemm8(HN + (size_t)TAIL0 * D, D, WIN, D, NINP / 16, D, epi, wave_s);
    }
    xcd_barrier(xbar, wave_s);

    {
      PHASE_IDS
      const float* gkv = p.in[4] + (size_t)l * 256;
      const float* gik = p.in[5] + (size_t)l * 64;
      for (int r = gw; r < NKEYS; r += NGW) {
        const bf16_t* pr = PROJ + (size_t)r * NINP;
        {
          const uint2 raw = *(const uint2*)(pr + C_CKV + lane * 4);
          float a0 = bf2f(raw.x & 0xffff), a1 = bf2f(raw.x >> 16), a2 = bf2f(raw.y & 0xffff), a3 = bf2f(raw.y >> 16);
          float s = wave_sum(a0 * a0 + a1 * a1 + a2 * a2 + a3 * a3, lane);
          const float rs = rsqrtf(s * (1.0f / 256.0f) + 1e-6f);
          const float4 gg = *(const float4*)(gkv + lane * 4);
          uint2 o; o.x = pk2(a0 * rs * gg.x, a1 * rs * gg.y); o.y = pk2(a2 * rs * gg.z, a3 * rs * gg.w);
          *(uint2*)(CKV + (size_t)r * 256 + lane * 4) = o;
        }
        {
          const float a = bf2f(pr[C_KIDX + lane]);
          const float s = wave_sum(a * a, lane);
          const float rs = rsqrtf(s * (1.0f / 64.0f) + 1e-6f);
          KIDX[((size_t)((r >> 5) * 4 + (lane >> 4)) * 64 + ((lane >> 3) & 1) * 32 + (r & 31)) * 8 + (lane & 7)] = f2bf(a * rs * gik[lane]);
        }
        pool_group<0>(PROJ, YPOOL, r, lane);
        pool_group<1>(PROJ, YPOOL, r, lane);
        pool_group<2>(PROJ, YPOOL, r, lane);
        pool_group<3>(PROJ, YPOOL, r, lane);
      }
      const int ntiles = 16 * NMT;
      for (int t = bid; t < ntiles; t += G) {
        const int h = t / NMT, pm = t % NMT;
        auto epi8 = [&](int row, int col, f32x4 a, f32x4 b) {
          uint4 o; o.x = pk2(a[0], a[1]); o.y = pk2(a[2], a[3]); o.z = pk2(b[0], b[1]); o.w = pk2(b[2], b[3]);
          *(uint4*)(QLAT + (size_t)row * 4096 + h * 256 + col) = o;
        };
        gemm_tile(PROJ + h * 128, NINP, WUK + (size_t)h * 65536, 256, pm * 256, 0, 256, epi8, wave_s);
      }
      int tid2 = wave_s * 64 + lane_id();
      asm volatile("" : "+v"(tid2));
      const int lane2 = tid2 & 63, gw2 = bid * 8 + (tid2 >> 6);
      for (int task = gw2; task < 16 * 16; task += NGW) {
        const int h = task >> 4, ct = task & 15;
        auto epi = [&](int row, int col, f32x4 v) {
          uint2 o; o.x = pk2(v[0], v[1]); o.y = pk2(v[2], v[3]);
          *(uint2*)(QLAT + (size_t)row * 4096 + h * 256 + col) = o;
        };
        tail_tile1(PROJ + (size_t)TAIL0 * NINP + h * 128, NINP, WUK + (size_t)h * 65536, 256, ct, 128, lane2, epi);
      }
    }
    xcd_barrier(xbar, wave_s);

    {
      PHASE_IDS
      unsigned* SC = (unsigned*)shm;
      int* IDX = (int*)((char*)shm + LDS_IDX_OFF);
      int* CAND = (int*)((char*)shm + LDS_CAND_OFF);
      const int nunits = NKEYS / 4;
      unsigned* qctr = (unsigned*)(wsb + OFF_BAR) + 3520 + 64 * l;
      volatile int* QW = (volatile int*)((char*)shm + LDS_XCH_OFF) + 32;
      unsigned* HIST = (unsigned*)CAND;
      {
        u32x4* hz = (u32x4*)HIST + tid * 2;
        unsigned z = 0u;
        asm volatile("" : "+v"(z));
        hz[0] = (u32x4){z, z, z, z}; hz[1] = (u32x4){z, z, z, z};
      }
      int tkt;
      {
        if (wave == 0 && lane == 0) *QW = (int)__hip_atomic_fetch_add(qctr, 1u, __ATOMIC_RELAXED, __HIP_MEMORY_SCOPE_AGENT);
        __syncthreads();
        tkt = __builtin_amdgcn_readfirstlane(*QW);
      }
#pragma unroll 1
      while (tkt < nunits) {
        int nxt = 0;
        if (wave == 0 && lane == 0) nxt = (int)__hip_atomic_fetch_add(qctr, 1u, __ATOMIC_RELAXED, __HIP_MEMORY_SCOPE_AGENT);
        const int u = nunits - 1 - tkt;
        int lane_u_ = lane;
        asm volatile("" : "+v"(lane_u_));
        const int lane = lane_u_;
        const int q0 = u * 4;
        const int nk = q0 + 4;
        const int nit = (nk + 255) >> 8;
        const int ntile = nit * 8;
        for (int rsc = 0; rsc < REP_SC; ++rsc) {
          const int r = lane & 31, kg = lane >> 5, qi = r & 3, head = r >> 2;
          bf16x8 qa[4];
          const bf16_t* qp = PROJ + (size_t)(q0 + qi) * NINP + C_QIDX + head * 64 + kg * 8;
#pragma unroll
          for (int ks = 0; ks < 4; ++ks) qa[ks] = *(const bf16x8*)(qp + ks * 16);
          float wv[4][4];
#pragma unroll
          for (int i = 0; i < 4; ++i)
#pragma unroll
            for (int j = 0; j < 4; ++j) wv[i][j] = bf2f(PROJ[(size_t)(q0 + j) * NINP + C_WIDX + 2 * i + kg]);
          const unsigned klane = (unsigned)lane * 8u;
          bf16x8 kbuf[4][4];
#pragma unroll
          for (int pi = 0; pi < 3; ++pi) {
            const int tp = wave_s + 8 * ((pi < nit) ? pi : nit - 1);
#pragma unroll
            for (int ks = 0; ks < 4; ++ks) kbuf[pi][ks] = *(const bf16x8*)(KIDX + (size_t)(tp * 4 + ks) * 512 + klane);
          }
          for (int base = 0; base < nit; base += 4) {
#pragma unroll
            for (int uu = 0; uu < 4; ++uu) {
              const int i = (base + uu < nit) ? base + uu : nit - 1;
              {
                {
                  const int ip = (base + uu + 3 < nit) ? base + uu + 3 : nit - 1;
                  const int tp = wave_s + 8 * ip;
#pragma unroll
                  for (int ks = 0; ks < 4; ++ks) kbuf[(uu + 3) % 4][ks] = *(const bf16x8*)(KIDX + (size_t)(tp * 4 + ks) * 512 + klane);
                }
                if (base + uu < nit) {
                const int tt = wave_s + 8 * i;
                const int key = tt * 32 + r;
                f32x16 acc;
#pragma unroll
                for (int q = 0; q < 16; ++q) acc[q] = 0.f;
#pragma unroll
                for (int ks = 0; ks < 4; ++ks) acc = __builtin_amdgcn_mfma_f32_32x32x16_bf16(qa[ks], kbuf[uu][ks], acc, 0, 0, 0);
#define RELU_(x) __int_as_float(max(__float_as_int(x), 0))
                const float p0 = wv[0][0] * RELU_(acc[0]) + wv[1][0] * RELU_(acc[4]) + wv[2][0] * RELU_(acc[8]) + wv[3][0] * RELU_(acc[12]);
                const float p1 = wv[0][1] * RELU_(acc[1]) + wv[1][1] * RELU_(acc[5]) + wv[2][1] * RELU_(acc[9]) + wv[3][1] * RELU_(acc[13]);
                const float p2 = wv[0][2] * RELU_(acc[2]) + wv[1][2] * RELU_(acc[6]) + wv[2][2] * RELU_(acc[10]) + wv[3][2] * RELU_(acc[14]);
                const float p3 = wv[0][3] * RELU_(acc[3]) + wv[1][3] * RELU_(acc[7]) + wv[2][3] * RELU_(acc[11]) + wv[3][3] * RELU_(acc[15]);
#undef RELU_
                const auto r02 = __builtin_amdgcn_permlane32_swap(__float_as_uint(p0), __float_as_uint(p2), false, false);
                const auto r13 = __builtin_amdgcn_permlane32_swap(__float_as_uint(p1), __float_as_uint(p3), false, false);
                const float sa = __uint_as_float(r02[0]) + __uint_as_float(r02[1]);
                const float sb = __uint_as_float(r13[0]) + __uint_as_float(r13[1]);
#pragma unroll
                for (int jj = 0; jj < 2; ++jj) {
                  const int j = kg * 2 + jj;
                  const float s = (jj ? sb : sa) + 0.0f;
                  unsigned ub = __float_as_uint(s);
                  ub ^= (unsigned)((int)ub >> 31) | 0x80000000u;
                  if (key > q0 + j) ub = 0u;
                  SC[j * SCLD + key] = ub;
                  if (ub != 0u) {
                    const unsigned bin = ub >> 21;
                    __hip_atomic_fetch_add(HIST + j * 1024 + (bin >> 1), 1u << ((bin & 1u) * 16u), __ATOMIC_RELAXED, __HIP_MEMORY_SCOPE_WORKGROUP);
                  }
                }
                }
              }
            }
          }
        }
        __syncthreads();
        for (int rsel = 0; rsel < REP_SEL; ++rsel) {
          const int j = wave & 3, half = wave >> 2, qpos = q0 + j, nvalid = qpos + 1;
          const bool big = nvalid > 256;
          int* idx = IDX + j * 256;
          int* cand = CAND + (j * 2 + half) * CAND_CAP2;
          int* XCH = (int*)((char*)shm + LDS_XCH_OFF);
          const unsigned* sc1 = SC + j * SCLD;
          const uint4* sc4 = (const uint4*)sc1;
          const int nh = (nit + 1) >> 1;
          const int g0 = half ? nh : 0, g1 = half ? nit : nh;
          unsigned prefix = 0u;
          if (big) {
            const u32x4* hq = (const u32x4*)(HIST + j * 1024) + lane * 4;
            const u32x4 w0 = hq[0], w1 = hq[1], w2 = hq[2], w3 = hq[3];
            unsigned cw[16];
#pragma unroll
            for (int q = 0; q < 4; ++q) { cw[q] = w0[q]; cw[4 + q] = w1[q]; cw[8 + q] = w2[q]; cw[12 + q] = w3[q]; }
            int sl = 0;
#pragma unroll
            for (int q = 0; q < 16; ++q) sl += (int)(cw[q] & 0xffffu) + (int)(cw[q] >> 16);
            int S = sl;
#pragma unroll
            for (int o = 1; o < 64; o <<= 1) {
              const int tv = __builtin_amdgcn_ds_bpermute(((lane + o) & 63) << 2, S);
              if (lane + o < 64) S += tv;
            }
            const int L = __popcll(__ballot(S >= 256)) - 1;
            int run = S - sl, found = -1;
#pragma unroll
            for (int bb = 31; bb >= 0; --bb) {
              run += (bb & 1) ? (int)(cw[bb >> 1] >> 16) : (int)(cw[bb >> 1] & 0xffffu);
              if (run >= 256 && found < 0) found = bb;
            }
            const int fb = __builtin_amdgcn_readlane(found, L);
            prefix = (unsigned)(L * 32 + fb) << 21;
          }
          __syncthreads();
          const unsigned P = prefix >> 21;
          int c = 0, m = 0;
          if (big) {
            for (int it = g0 * 4; it < g1 * 4; it += 4) {
              unsigned x[4];
#pragma unroll
              for (int e = 0; e < 4; ++e) x[e] = sc1[(it + e) * 64 + lane];
#pragma unroll
              for (int e = 0; e < 4; ++e) {
                const unsigned t = x[e] >> 21;
                const bool isA = t > P, isB = t == P;
                const unsigned long long mA = __ballot(isA), mB = __ballot(isB);
                const int oA = __builtin_amdgcn_mbcnt_hi((unsigned)(mA >> 32), __builtin_amdgcn_mbcnt_lo((unsigned)mA, 0u));
                const int oB = __builtin_amdgcn_mbcnt_hi((unsigned)(mB >> 32), __builtin_amdgcn_mbcnt_lo((unsigned)mB, 0u));
                if (isA) idx[half ? (255 - (c + oA)) : (c + oA)] = (it + e) * 64 + lane;
                if (isB && (m + oB) < CAND_CAP2) cand[m + oB] = (it + e) * 64 + lane;
                c += __popcll(mA);
                m += __popcll(mB);
              }
            }
          }
          if (lane == 0) { XCH[16 + wave * 2] = c; XCH[16 + wave * 2 + 1] = m; }
          __syncthreads();
          if (half == 0) {
            if (!big) {
              for (int i = lane; i < 256; i += 64) idx[i] = (i < nvalid) ? i : 0;
            } else {
              const int cB = XCH[16 + (wave + 4) * 2], mB = XCH[16 + (wave + 4) * 2 + 1];
              const int mA = m, mt = mA + mB;
              const int* candB = CAND + (j * 2 + 1) * CAND_CAP2;
              if (mA <= CAND_CAP2 && mB <= CAND_CAP2) {
                const int need = 256 - c - cB;
                unsigned T = prefix;
                auto fine = [&](auto KMtag) {
                  constexpr int KM = decltype(KMtag)::value;
                  unsigned cv[KM];
                  int ci[KM];
#pragma unroll
                  for (int k = 0; k < KM; ++k) {
                    const int i = k * 64 + lane;
                    ci[k] = (i < mA) ? cand[i] : ((i < mt) ? candB[i - mA] : 0);
                    cv[k] = (i < mt) ? sc1[ci[k]] : 0u;
                  }
                  for (int bit = 20; bit >= 0; --bit) {
                    const unsigned cd = T | (1u << bit);
                    int cnt = 0;
#pragma unroll
                    for (int k = 0; k < KM; ++k) cnt += __popcll(__ballot(cv[k] >= cd));
                    if (cnt >= need) T = cd;
                  }
                  int pos = c;
#pragma unroll
                  for (int k = 0; k < KM; ++k) {
                    const bool sel = cv[k] > T;
                    const unsigned long long mk = __ballot(sel);
                    const int off = __builtin_amdgcn_mbcnt_hi((unsigned)(mk >> 32), __builtin_amdgcn_mbcnt_lo((unsigned)mk, 0u));
                    if (sel) idx[pos + off] = ci[k];
                    pos += __popcll(mk);
                  }
                  const int lim = 256 - cB;
#pragma unroll
                  for (int k = 0; k < KM; ++k) {
                    const bool sel = cv[k] == T;
                    const unsigned long long mk = __ballot(sel);
                    const int off = __builtin_amdgcn_mbcnt_hi((unsigned)(mk >> 32), __builtin_amdgcn_mbcnt_lo((unsigned)mk, 0u));
                    if (sel && (pos + off) < lim) idx[pos + off] = ci[k];
                    pos += __popcll(mk);
                  }
                };
                if (mt <= 256) fine(std::integral_constant<int, 4>{});
                else fine(std::integral_constant<int, (2 * CAND_CAP2) / 64>{});
              } else {
                unsigned pf = 0u;
                for (int bit = 31; bit >= 0; --bit) {
                  const unsigned cd = pf | (1u << bit);
                  int cnt = 0;
                  for (int it = 0; it < nit; ++it) {
                    const uint4 v = sc4[it * 64 + lane];
                    cnt += __popcll(__ballot(v.x >= cd)) + __popcll(__ballot(v.y >= cd)) + __popcll(__ballot(v.z >= cd)) + __popcll(__ballot(v.w >= cd));
                  }
                  if (cnt >= 256) pf = cd;
                }
                const unsigned T = pf;
                int c2 = 0;
                const int nit64 = nit * 4;
                for (int it = 0; it < nit64; ++it) {
                  const unsigned x = sc1[it * 64 + lane];
                  const bool sel = x > T;
                  const unsigned long long mask = __ballot(sel);
                  const int off = __builtin_amdgcn_mbcnt_hi((unsigned)(mask >> 32), __builtin_amdgcn_mbcnt_lo((unsigned)mask, 0u));
                  if (sel) idx[c2 + off] = it * 64 + lane;
                  c2 += __popcll(mask);
                }
                for (int it = 0; it < nit64 && c2 < 256; ++it) {
                  const unsigned x = sc1[it * 64 + lane];
                  const bool sel = x == T;
                  const unsigned long long mask = __ballot(sel);
                  const int off = __builtin_amdgcn_mbcnt_hi((unsigned)(mask >> 32), __builtin_amdgcn_mbcnt_lo((unsigned)mask, 0u));
                  if (sel && (c2 + off) < 256) idx[c2 + off] = it * 64 + lane;
                  c2 += __popcll(mask);
                }
              }
            }
          }
          if (rsel + 1 < REP_SEL) __syncthreads();
        }
        __syncthreads();
        {
          u32x4* hz = (u32x4*)HIST + (wave * 64 + lane) * 2;
          unsigned z = 0u;
          asm volatile("" : "+v"(z));
          hz[0] = (u32x4){z, z, z, z}; hz[1] = (u32x4){z, z, z, z};
        }
        for (int ratt = 0; ratt < REP_ATT; ++ratt) {
          if (ratt) __syncthreads();
          const int j = wave & 3, half = wave >> 2, qpos = q0 + j;
          const int nsel = (qpos + 1) < 256 ? (qpos + 1) : 256;
          const int* idx = IDX + j * 256;
          bf16_t* ST = (bf16_t*)((char*)shm + wave * (32 * ST_LD * 2));
          float* XF = (float*)ST;
          const int fr = lane & 15, fq = lane >> 4;
          bf16x8 qb[8];
          const bf16_t* qlp = QLAT + (size_t)qpos * 4096 + fr * 256 + fq * 8;
#pragma unroll
          for (int ks = 0; ks < 8; ++ks) qb[ks] = __builtin_nontemporal_load((const bf16x8*)(qlp + ks * 32));
          f32x4 o[16];
#pragma unroll
          for (int i = 0; i < 16; ++i) o[i] = (f32x4){0.f, 0.f, 0.f, 0.f};
          float mrun = -INFINITY, lrun = 0.f;
          const int nchunk = (nsel + 31) >> 5, nfirst = (nchunk + 1) >> 1;
          const int cb = half ? nfirst : 0, ce = half ? nchunk : nfirst;
          const unsigned st_base = (unsigned)(size_t)(__attribute__((address_space(3))) char*)ST;
          const unsigned tr_addr = st_base + (unsigned)(((fq * 4 + (fr >> 2)) * ST_LD + (fr & 3) * 4) * 2);
          bf16x8 ar[2][8];
          {
            const int c0 = (cb < ce) ? cb : 0;
#pragma unroll
            for (int tt = 0; tt < 2; ++tt) {
              const bf16_t* kr = CKV + (size_t)idx[c0 * 32 + tt * 16 + fr] * 256 + fq * 8;
#pragma unroll
              for (int ks = 0; ks < 8; ++ks) ar[tt][ks] = *(const bf16x8*)(kr + ks * 32);
            }
          }
          for (int ch = cb; ch < ce; ++ch) {
            f32x4 s[2];
#pragma unroll
            for (int tt = 0; tt < 2; ++tt) {
              s[tt] = (f32x4){0.f, 0.f, 0.f, 0.f};
#pragma unroll
              for (int ks = 0; ks < 8; ++ks) s[tt] = __builtin_amdgcn_mfma_f32_16x16x32_bf16(ar[tt][ks], qb[ks], s[tt], 0, 0, 0);
            }
#pragma unroll
            for (int tt = 0; tt < 2; ++tt)
#pragma unroll
              for (int ks = 0; ks < 8; ++ks) *(bf16x8*)(ST + (tt * 16 + fr) * ST_LD + ks * 32 + fq * 8) = ar[tt][ks];
            asm volatile("s_waitcnt lgkmcnt(0)" ::: "memory");
            __builtin_amdgcn_wave_barrier();
            {
              const int cn = (ch + 1 < ce) ? ch + 1 : ch;
#pragma unroll
              for (int tt = 0; tt < 2; ++tt) {
                const bf16_t* kr = CKV + (size_t)idx[cn * 32 + tt * 16 + fr] * 256 + fq * 8;
#pragma unroll
                for (int ks = 0; ks < 8; ++ks) ar[tt][ks] = *(const bf16x8*)(kr + ks * 32);
              }
            }
            if (nsel < 256) {
#pragma unroll
              for (int tt = 0; tt < 2; ++tt)
#pragma unroll
                for (int e = 0; e < 4; ++e)
                  if (ch * 32 + tt * 16 + fq * 4 + e >= nsel) s[tt][e] = -INFINITY;
            }
            float mx = fmaxf(fmaxf(fmaxf(s[0][0], s[0][1]), fmaxf(s[0][2], s[0][3])), fmaxf(fmaxf(s[1][0], s[1][1]), fmaxf(s[1][2], s[1][3])));
            mx = fmaxf(mx, shx(mx, 16, lane));
            mx = fmaxf(mx, shx(mx, 32, lane));
            const float mnew = fmaxf(mrun, mx);
            const float alpha = __builtin_amdgcn_exp2f(mrun - mnew);
            float ps = 0.f;
            float pv[8];
#pragma unroll
            for (int tt = 0; tt < 2; ++tt)
#pragma unroll
              for (int e = 0; e < 4; ++e) {
                const float pe = __builtin_amdgcn_exp2f(s[tt][e] - mnew);
                pv[tt * 4 + e] = pe;
                ps += pe;
              }
            ps += shx(ps, 16, lane);
            ps += shx(ps, 32, lane);
            lrun = lrun * alpha + ps;
            mrun = mnew;
            union { bf16x8 v; unsigned u[4]; } pb;
            pb.u[0] = pk2(pv[0], pv[1]); pb.u[1] = pk2(pv[2], pv[3]); pb.u[2] = pk2(pv[4], pv[5]); pb.u[3] = pk2(pv[6], pv[7]);
#pragma unroll
            for (int rt = 0; rt < 16; ++rt) o[rt] *= alpha;
#pragma unroll
            for (int rb = 0; rb < 4; ++rb) {
              union { bf16x8 v; u16x4 h[2]; } va[4];
              asm volatile(
                  "ds_read_b64_tr_b16 %0, %8 offset:%9\n\t"
                  "ds_read_b64_tr_b16 %1, %8 offset:%10\n\t"
                  "ds_read_b64_tr_b16 %2, %8 offset:%11\n\t"
                  "ds_read_b64_tr_b16 %3, %8 offset:%12\n\t"
                  "ds_read_b64_tr_b16 %4, %8 offset:%13\n\t"
                  "ds_read_b64_tr_b16 %5, %8 offset:%14\n\t"
                  "ds_read_b64_tr_b16 %6, %8 offset:%15\n\t"
                  "ds_read_b64_tr_b16 %7, %8 offset:%16\n\t"
                  "s_waitcnt lgkmcnt(0)"
                  : "=&v"(va[0].h[0]), "=&v"(va[0].h[1]), "=&v"(va[1].h[0]), "=&v"(va[1].h[1]),
                    "=&v"(va[2].h[0]), "=&v"(va[2].h[1]), "=&v"(va[3].h[0]), "=&v"(va[3].h[1])
                  : "v"(tr_addr),
                    "i"((rb * 4 + 0) * 32), "i"((rb * 4 + 0) * 32 + 16 * ST_LD * 2),
                    "i"((rb * 4 + 1) * 32), "i"((rb * 4 + 1) * 32 + 16 * ST_LD * 2),
                    "i"((rb * 4 + 2) * 32), "i"((rb * 4 + 2) * 32 + 16 * ST_LD * 2),
                    "i"((rb * 4 + 3) * 32), "i"((rb * 4 + 3) * 32 + 16 * ST_LD * 2)
                  : "memory");
#pragma unroll
              for (int q = 0; q < 4; ++q)
                o[rb * 4 + q] = __builtin_amdgcn_mfma_f32_16x16x32_bf16(va[q].v, pb.v, o[rb * 4 + q], 0, 0, 0);
            }
            asm volatile("s_waitcnt lgkmcnt(0)" ::: "memory");
            __builtin_amdgcn_wave_barrier();
          }
          if (half == 1) {
            XF[lane] = mrun;
            XF[64 + lane] = lrun;
#pragma unroll
            for (int rt = 0; rt < 16; ++rt)
#pragma unroll
              for (int e = 0; e < 4; ++e) XF[(2 + rt * 4 + e) * 64 + lane] = o[rt][e];
          }
          __syncthreads();
          if (half == 0) {
            const float* XP = (const float*)((char*)shm + (wave + 4) * (32 * ST_LD * 2));
            const float m1 = XP[lane], l1 = XP[64 + lane];
            const float mm = fmaxf(mrun, m1);
            const float a0 = __builtin_amdgcn_exp2f(mrun - mm), a1 = __builtin_amdgcn_exp2f(m1 - mm);
            const float invl = 1.0f / (lrun * a0 + l1 * a1);
            const float w0 = a0 * invl, w1 = a1 * invl;
            bf16_t* op = OLAT + (size_t)qpos * 4096 + fr * 256 + fq * 4;
#pragma unroll
            for (int rt = 0; rt < 16; ++rt) {
              float r[4];
#pragma unroll
              for (int e = 0; e < 4; ++e) r[e] = o[rt][e] * w0 + XP[(2 + rt * 4 + e) * 64 + lane] * w1;
              uint2 w; w.x = pk2(r[0], r[1]); w.y = pk2(r[2], r[3]);
              __builtin_nontemporal_store((u32x2){w.x, w.y}, (u32x2*)(op + rt * 16));
            }
          }
        }
        if (wave == 0 && lane == 0) *QW = nxt;
        __syncthreads();
        tkt = __builtin_amdgcn_readfirstlane(*QW);
      }
      {
        const float* psc = p.in[10] + (size_t)l * 1024;
        const int ntiles = 4 * NMT;
        for (int t = bid; t < ntiles; t += G) {
          const int g = t / NMT, pm = t % NMT;
          auto epi8 = [&](int row, int col, f32x4 a, f32x4 b) {
            const float4 sa = *(const float4*)(psc + g * 256 + col), sb = *(const float4*)(psc + g * 256 + col + 4);
            uint4 o; o.x = pk2(a[0] * sa.x, a[1] * sa.y); o.y = pk2(a[2] * sa.z, a[3] * sa.w); o.z = pk2(b[0] * sb.x, b[1] * sb.y); o.w = pk2(b[2] * sb.z, b[3] * sb.w);
            *(uint4*)(YP2 + (size_t)row * 1024 + g * 256 + col) = o;
          };
          gemm_tile(YPOOL + g * 256, 1024, WPOOL + (size_t)g * 65536, 256, pm * 256, 0, 256, epi8, wave_s);
        }
        int tid2 = wave_s * 64 + lane_id();
        asm volatile("" : "+v"(tid2));
        const int lane2 = tid2 & 63, gw2 = bid * 8 + (tid2 >> 6);
        for (int task = gw2; task < 4 * 16; task += NGW) {
          const int g = task >> 4, ct = task & 15;
          auto epi = [&](int row, int col, f32x4 v) {
            const float4 sc = *(const float4*)(psc + g * 256 + col);
            uint2 o; o.x = pk2(v[0] * sc.x, v[1] * sc.y); o.y = pk2(v[2] * sc.z, v[3] * sc.w);
            *(uint2*)(YP2 + (size_t)row * 1024 + g * 256 + col) = o;
          };
          tail_tile1(YPOOL + (size_t)TAIL0 * 1024 + g * 256, 1024, WPOOL + (size_t)g * 65536, 256, ct, 256, lane2, epi);
        }
      }
    }
    xcd_barrier(xbar, wave_s);

    {
      PHASE_PTRS
      auto epib = [&](int row, int col, f32x4 v) {
        const uint2 raw = *(const uint2*)(PROJ + (size_t)row * NINP + C_GB + col);
        f32x4 o;
        o[0] = sigmoidf(bf2f(raw.x & 0xffff)) * v[0]; o[1] = sigmoidf(bf2f(raw.x >> 16)) * v[1];
        o[2] = sigmoidf(bf2f(raw.y & 0xffff)) * v[2]; o[3] = sigmoidf(bf2f(raw.y >> 16)) * v[3];
        *(f32x4*)(MB + (size_t)row * D + col) = o;
      };
      auto epib8 = [&](int row, int col, f32x4 a, f32x4 b) {
        const uint4 raw = *(const uint4*)(PROJ + (size_t)row * NINP + C_GB + col);
        f32x4 oa, ob;
        oa[0] = sigmoidf(bf2f(raw.x & 0xffff)) * a[0]; oa[1] = sigmoidf(bf2f(raw.x >> 16)) * a[1];
        oa[2] = sigmoidf(bf2f(raw.y & 0xffff)) * a[2]; oa[3] = sigmoidf(bf2f(raw.y >> 16)) * a[3];
        ob[0] = sigmoidf(bf2f(raw.z & 0xffff)) * b[0]; ob[1] = sigmoidf(bf2f(raw.z >> 16)) * b[1];
        ob[2] = sigmoidf(bf2f(raw.w & 0xffff)) * b[2]; ob[3] = sigmoidf(bf2f(raw.w >> 16)) * b[3];
        f32x4* mp = (f32x4*)(MB + (size_t)row * D + col);
        mp[0] = oa; mp[1] = ob;
      };
      const int n1 = 16 * NMT, n2 = NMT * 8;
      for (int t = bid; t < n1 + n2; t += G) {
        if (t < n1) {
          const int h = t / NMT, pm = t % NMT;
          auto epi8 = [&](int row, int col, f32x4 a, f32x4 b) {
            if (col < 128) {
              uint4 o; o.x = pk2(a[0], a[1]); o.y = pk2(a[2], a[3]); o.z = pk2(b[0], b[1]); o.w = pk2(b[2], b[3]);
              *(uint4*)(OB + (size_t)row * D + h * 128 + col) = o;
            }
          };
          gemm_tile(OLAT + h * 256, 4096, WUV + (size_t)h * 65536, 256, pm * 256, 0, 256, epi8, wave_s);
        } else {
          int pm, pn; tile_map(t - n1, NMT, 8, pm, pn);
          gemm_tile(YP2, 1024, WPO, 1024, pm * 256, pn * 256, 1024, epib8, wave_s);
        }
      }
      int tid2 = wave_s * 64 + lane_id();
      asm volatile("" : "+v"(tid2));
      const int lane2 = tid2 & 63, gw2 = bid * 8 + (tid2 >> 6);
      for (int task = gw2; task < 16 * 8; task += NGW) {
        const int h = task >> 3, ct = task & 7;
        auto epi = [&](int row, int col, f32x4 v) {
          uint2 o; o.x = pk2(v[0], v[1]); o.y = pk2(v[2], v[3]);
          *(uint2*)(OB + (size_t)row * D + h * 128 + col) = o;
        };
        tail_tile1(OLAT + (size_t)TAIL0 * 4096 + h * 256, 4096, WUV + (size_t)h * 65536, 256, ct, 256, lane2, epi);
      }
      tail_gemm8(YP2 + (size_t)TAIL0 * 1024, 1024, WPO, 1024, D / 16, 1024, epib, wave_s);
    }
    xcd_barrier(xbar, wave_s);

    {
      PHASE_PTRS
      auto epi = [&](int row, int col, f32x4 v) {
        const uint2 raw = *(const uint2*)(PROJ + (size_t)row * NINP + C_GA + col);
        const f32x4 mb = *(const f32x4*)(MB + (size_t)row * D + col);
        uint2 o;
        o.x = pk2(sigmoidf(bf2f(raw.x & 0xffff)) * v[0] + mb[0], sigmoidf(bf2f(raw.x >> 16)) * v[1] + mb[1]);
        o.y = pk2(sigmoidf(bf2f(raw.y & 0xffff)) * v[2] + mb[2], sigmoidf(bf2f(raw.y >> 16)) * v[3] + mb[3]);
        *(uint2*)(MERGED + (size_t)row * D + col) = o;
      };
      auto epi8 = [&](int row, int col, f32x4 a, f32x4 b) {
        const uint4 raw = *(const uint4*)(PROJ + (size_t)row * NINP + C_GA + col);
        const f32x4* mp = (const f32x4*)(MB + (size_t)row * D + col);
        const f32x4 ma = mp[0], mb = mp[1];
        uint4 o;
        o.x = pk2(sigmoidf(bf2f(raw.x & 0xffff)) * a[0] + ma[0], sigmoidf(bf2f(raw.x >> 16)) * a[1] + ma[1]);
        o.y = pk2(sigmoidf(bf2f(raw.y & 0xffff)) * a[2] + ma[2], sigmoidf(bf2f(raw.y >> 16)) * a[3] + ma[3]);
        o.z = pk2(sigmoidf(bf2f(raw.z & 0xffff)) * b[0] + mb[0], sigmoidf(bf2f(raw.z >> 16)) * b[1] + mb[1]);
        o.w = pk2(sigmoidf(bf2f(raw.w & 0xffff)) * b[2] + mb[2], sigmoidf(bf2f(raw.w >> 16)) * b[3] + mb[3]);
        *(uint4*)(MERGED + (size_t)row * D + col) = o;
      };
      for (int t = bid; t < NMT * 8; t += G) {
        int pm, pn; tile_map(t, NMT, 8, pm, pn);
        gemm_tile(OB, D, WAO, D, pm * 256, pn * 256, D, epi8, wave_s);
      }
      tail_gemm8(OB + (size_t)TAIL0 * D, D, WAO, D, D / 16, D, epi, wave_s);
    }
    xcd_barrier(xbar, wave_s);

    {
      PHASE_PTRS
      auto epi = [&](int row, int col, f32x4 v) {
        f32x4* hp = (f32x4*)(HRES + (size_t)row * D + col);
        *hp = *hp + v;
      };
      auto epi8 = [&](int row, int col, f32x4 a, f32x4 b) {
        f32x4* hp = (f32x4*)(HRES + (size_t)row * D + col);
        const f32x4 ha = hp[0], hb = hp[1];
        hp[0] = ha + a; hp[1] = hb + b;
      };
      for (int t = bid; t < NMT * 8; t += G) {
        int pm, pn; tile_map(t, NMT, 8, pm, pn);
        gemm_tile(MERGED, D, WOUT, D, pm * 256, pn * 256, D, epi8, wave_s);
      }
      tail_gemm8(MERGED + (size_t)TAIL0 * D, D, WOUT, D, D / 16, D, epi, wave_s);
    }
    xcd_barrier(xbar, wave_s);

    {
      PHASE_IDS
      rmsnorm_rows(HRES, p.in[13] + (size_t)l * D, HN, gw, NGW, lane);
    }
    xcd_barrier(xbar, wave_s);

    for (int rep = 0; rep < REP_P9; ++rep) {
      PHASE_PTRS
      auto epi = [&](int row, int col, f32x4 v) {
        float a0 = fmaxf(v[0], 0.f), a1 = fmaxf(v[1], 0.f), a2 = fmaxf(v[2], 0.f), a3 = fmaxf(v[3], 0.f);
        uint2 o; o.x = pk2(a0 * a0, a1 * a1); o.y = pk2(a2 * a2, a3 * a3);
        *(uint2*)(UB + (size_t)row * DFF + col) = o;
      };
      auto epi8 = [&](int row, int col, f32x4 a, f32x4 b) {
        const float a0 = fmaxf(a[0], 0.f), a1 = fmaxf(a[1], 0.f), a2 = fmaxf(a[2], 0.f), a3 = fmaxf(a[3], 0.f);
        const float b0 = fmaxf(b[0], 0.f), b1 = fmaxf(b[1], 0.f), b2 = fmaxf(b[2], 0.f), b3 = fmaxf(b[3], 0.f);
        uint4 o; o.x = pk2(a0 * a0, a1 * a1); o.y = pk2(a2 * a2, a3 * a3); o.z = pk2(b0 * b0, b1 * b1); o.w = pk2(b2 * b2, b3 * b3);
        *(uint4*)(UB + (size_t)row * DFF + col) = o;
      };
      const int nN = DFF / 256, ntiles = NMT * nN;
      for (int t = bid; t < ntiles; t += G) {
        int pm, pn; tile_map(t, NMT, nN, pm, pn);
        gemm_tile(HN, D, WMI, D, pm * 256, pn * 256, D, epi8, wave_s);
      }
      tail_gemm8(HN + (size_t)TAIL0 * D, D, WMI, D, DFF / 16, D, epi, wave_s);
    }
    xcd_barrier(xbar, wave_s);

    {
      PHASE_PTRS
      auto epi = [&](int row, int col, f32x4 v) {
        f32x4* hp = (f32x4*)(HRES + (size_t)row * D + col);
        *hp = *hp + v;
      };
      auto epi8 = [&](int row, int col, f32x4 a, f32x4 b) {
        f32x4* hp = (f32x4*)(HRES + (size_t)row * D + col);
        const f32x4 ha = hp[0], hb = hp[1];
        hp[0] = ha + a; hp[1] = hb + b;
      };
      for (int t = bid; t < NMT * 8; t += G) {
        int pm, pn; tile_map(t, NMT, 8, pm, pn);
        gemm_tile(UB, DFF, WMO, DFF, pm * 256, pn * 256, DFF, epi8, wave_s);
      }
      tail_gemm8(UB + (size_t)TAIL0 * DFF, DFF, WMO, DFF, D / 16, DFF, epi, wave_s);
    }
    xcd_barrier(xbar, wave_s);
  }

  {
    BLOCK_IDS
    PHASE_IDS
    const float* g = p.in[16];
    for (int r0 = gw; r0 < SEQ; r0 += NGW) {
      const int r = r0 + NMETA;
      float4 v[8];
      float s = 0.f;
#pragma unroll
      for (int j = 0; j < 8; ++j) {
        v[j] = *(const float4*)(HRES + (size_t)r * D + j * 256 + lane * 4);
        s += v[j].x * v[j].x + v[j].y * v[j].y + v[j].z * v[j].z + v[j].w * v[j].w;
      }
      s = wave_sum(s, lane);
      const float rs = rsqrtf(s * (1.0f / D) + 1e-6f);
#pragma unroll
      for (int j = 0; j < 8; ++j) {
        const float4 gg = *(const float4*)(g + j * 256 + lane * 4);
        __builtin_nontemporal_store((f32x4){v[j].x * rs * gg.x, v[j].y * rs * gg.y, v[j].z * rs * gg.z, v[j].w * rs * gg.w}, (f32x4*)(p.out + (size_t)r0 * D + j * 256 + lane * 4));
      }
    }
  }
}

extern "C" void kernel_launch(void* const* d_in, const int* in_sizes, int n_in, void* d_out, int out_size,
                              void* d_ws, size_t ws_size, hipStream_t stream) {
  static int grid_blocks = 0;
  if (!grid_blocks) {
    int dev = 0, cus = 0, per_cu = 0;
    (void)hipGetDevice(&dev);
    (void)hipDeviceGetAttribute(&cus, hipDeviceAttributeMultiprocessorCount, dev);
    (void)hipFuncSetAttribute((const void*)fwd, hipFuncAttributeMaxDynamicSharedMemorySize, LDS_BYTES);
    (void)hipOccupancyMaxActiveBlocksPerMultiprocessor(&per_cu, (const void*)fwd, 512, LDS_BYTES);
    (void)hipGetLastError();
    grid_blocks = cus > 0 ? cus : 256;
    if (ws_size < WS_END) { fprintf(stderr, "workspace too small: %zu < %zu\n", ws_size, (size_t)WS_END); grid_blocks = -1; }
  }
  if (grid_blocks < 0) return;
  Params p{};
  for (int i = 0; i < 17; ++i) p.in[i] = (const float*)d_in[i];
  p.out = (float*)d_out;
  p.ws = (unsigned char*)d_ws;
  (void)hipMemsetAsync((unsigned char*)d_ws + OFF_BAR, 0, BAR_BYTES, stream);
  void* args[] = {&p};
  hipError_t e = hipLaunchCooperativeKernel((void*)fwd, dim3(grid_blocks), dim3(512), args, LDS_BYTES, stream);
  if (e != hipSuccess) fprintf(stderr, "cooperative launch failed: %s (grid %d)\n", hipGetErrorString(e), grid_blocks);
}
```

```cpp
#include <hip/hip_runtime.h>
#include <hip/hip_bf16.h>
#include <hip/hip_cooperative_groups.h>
#include <cstdio>
#include <type_traits>
namespace cg = cooperative_groups;

typedef unsigned short bf16_t;
typedef short bf16x8 __attribute__((ext_vector_type(8)));
typedef float f32x4 __attribute__((ext_vector_type(4)));
typedef float f32x16 __attribute__((ext_vector_type(16)));
typedef unsigned short u16x4 __attribute__((ext_vector_type(4)));
typedef unsigned u32x4 __attribute__((ext_vector_type(4)));

constexpr int D = 2048, SEQ = 8192, NMETA = 16, NKEYS = SEQ + NMETA, MP = 8448, DEPTH = 4;
constexpr int NIN = 8008, NINP = 8192, DFF = 8192;
constexpr int C_CKV = 2048, C_QIDX = 2304, C_KIDX = 2816, C_WIDX = 2880, C_PIN = 2888, C_GA = 3912, C_GB = 5960;
constexpr int NMT = 32;
constexpr int TAIL0 = 8192;

constexpr size_t SZ_HRES = (size_t)MP * D * 4, SZ_HN = (size_t)MP * D * 2, SZ_PROJ = (size_t)MP * NINP * 2;
constexpr size_t OFF_HRES = 0;
constexpr size_t OFF_HN = OFF_HRES + SZ_HRES;
constexpr size_t OFF_PROJ = OFF_HN + SZ_HN;
constexpr size_t OFF_CKV = OFF_PROJ + SZ_PROJ;
constexpr size_t OFF_KIDX = OFF_CKV + (size_t)MP * 256 * 2;
constexpr size_t OFF_YPOOL = OFF_KIDX + (size_t)MP * 64 * 2;
constexpr size_t OFF_YP2 = OFF_YPOOL + (size_t)MP * 1024 * 2;
constexpr size_t OFF_QLAT = OFF_YP2 + (size_t)MP * 1024 * 2;
constexpr size_t OFF_OLAT = OFF_QLAT + (size_t)MP * 4096 * 2;
constexpr size_t OFF_O = OFF_OLAT + (size_t)MP * 4096 * 2;
constexpr size_t OFF_MB = OFF_O + (size_t)MP * D * 2;
constexpr size_t OFF_MERGED = OFF_MB + (size_t)MP * D * 4;
constexpr size_t OFF_WIN = OFF_MERGED + (size_t)MP * D * 2;
constexpr size_t OFF_WUK = OFF_WIN + (size_t)NINP * D * 2;
constexpr size_t OFF_WUV = OFF_WUK + (size_t)16 * 256 * 256 * 2;
constexpr size_t OFF_WAO = OFF_WUV + (size_t)16 * 256 * 256 * 2;
constexpr size_t OFF_WPOOL = OFF_WAO + (size_t)D * D * 2;
constexpr size_t OFF_WPO = OFF_WPOOL + (size_t)4 * 256 * 256 * 2;
constexpr size_t OFF_WOUT = OFF_WPO + (size_t)D * 1024 * 2;
constexpr size_t OFF_WMI = OFF_WOUT + (size_t)D * D * 2;
constexpr size_t OFF_WMO = OFF_WMI + (size_t)DFF * D * 2;
constexpr size_t OFF_BAR = OFF_WMO + (size_t)D * DFF * 2;
constexpr size_t BAR_BYTES = 16384;
constexpr size_t WS_END = OFF_BAR + BAR_BYTES;

constexpr int SCLD = 8448;
constexpr int ST_LD = 272;
constexpr int LDS_SC_BYTES = 4 * SCLD * 4;
constexpr int LDS_IDX_OFF = (8 * 32 * ST_LD * 2 > LDS_SC_BYTES) ? 8 * 32 * ST_LD * 2 : LDS_SC_BYTES;
constexpr int CAND_CAP = 1024;
constexpr int LDS_CAND_OFF = LDS_IDX_OFF + 4 * 256 * 4;
constexpr int LDS_XB_OFF = LDS_CAND_OFF + 4 * CAND_CAP * 4;
constexpr int LDS_XCH_OFF = LDS_XB_OFF + 16;
constexpr int CAND_CAP2 = CAND_CAP / 2;
constexpr int LDS_BYTES = LDS_XCH_OFF + 144;

#ifndef REP_P1
#define REP_P1 1
#endif
#ifndef REP_P4
#define REP_P4 1
#endif
#ifndef REP_SC
#define REP_SC 1
#endif
#ifndef REP_SEL
#define REP_SEL 1
#endif
#ifndef REP_ATT
#define REP_ATT 1
#endif
#ifndef REP_P9
#define REP_P9 1
#endif
struct Params {
  const float* in[17];
  float* out;
  unsigned char* ws;
};

__device__ __forceinline__ unsigned short f2bf(float f) {
  unsigned u = __float_as_uint(f);
  u += 0x7FFFu + ((u >> 16) & 1u);
  return (unsigned short)(u >> 16);
}
__device__ __forceinline__ float bf2f(unsigned short h) { return __uint_as_float(((unsigned)h) << 16); }
typedef float f32x2_t __attribute__((ext_vector_type(2)));
typedef __bf16 bf16x2_t __attribute__((ext_vector_type(2)));
__device__ __forceinline__ unsigned pk2(float a, float b) { const f32x2_t f = {a, b}; return __builtin_bit_cast(unsigned, __builtin_convertvector(f, bf16x2_t)); }
__device__ __forceinline__ float shx(float v, int o, int lane) { return __int_as_float(__builtin_amdgcn_ds_bpermute((lane ^ o) << 2, __float_as_int(v))); }
__device__ __forceinline__ int shxi(int v, int o, int lane) { return __builtin_amdgcn_ds_bpermute((lane ^ o) << 2, v); }
__device__ __forceinline__ float wave_sum(float v, int lane) {
#pragma unroll
  for (int o = 1; o < 64; o <<= 1) v += shx(v, o, lane);
  return v;
}
__device__ __forceinline__ int lane_id() { return (int)__builtin_amdgcn_mbcnt_hi(~0u, __builtin_amdgcn_mbcnt_lo(~0u, 0u)); }
__device__ __forceinline__ float sigmoidf(float x) { return __builtin_amdgcn_rcpf(1.0f + __builtin_amdgcn_exp2f(-1.4426950408889634f * x)); }

constexpr int BM = 256, BK = 64, HALF = 128, HT = HALF * BK;
__device__ __forceinline__ int lds_byte(int r, int c) {
  int st = (r >> 4) * 2 + (c >> 5), rr = r & 15, cc = c & 31, ob = rr * 64 + cc * 2;
  return st * 1024 + (ob ^ (((ob >> 9) & 1) << 5));
}
__device__ __forceinline__ void stage_rc(int b, int& R, int& C) {
  int st = b / 1024, sb = b % 1024, swz = sb ^ (((sb >> 9) & 1) << 5);
  R = (st >> 1) * 16 + swz / 64;
  C = (st & 1) * 32 + (swz % 64) / 2;
}

template <class Epi>
__device__ __forceinline__ void gemm_tile(const bf16_t* __restrict__ A, const int lda, const bf16_t* __restrict__ Bt, const int ldb,
                                          const int brow, const int bcol, const int K, const Epi& epi, const int wave_s) {
  extern __shared__ __attribute__((aligned(16))) bf16_t shm[];
#define SA(b, h) (shm + ((b) * 2 + (h)) * HT)
#define SB(b, h) (shm + (4 + (b) * 2 + (h)) * HT)
#define STAGE_A(P, br, kt)                                                                                                   \
  do {                                                                                                                       \
    const bf16_t* _g = A + (long)(br) * lda + (long)(kt) * BK;                                                               \
    __builtin_amdgcn_global_load_lds((const unsigned*)(_g + aoff0), (unsigned*)((char*)(P) + sb0), 16, 0, 0);               \
    __builtin_amdgcn_global_load_lds((const unsigned*)(_g + aoff1), (unsigned*)((char*)(P) + sb1), 16, 0, 0);               \
  } while (0)
#define STAGE_B(P, br, kt)                                                                                                   \
  do {                                                                                                                       \
    const bf16_t* _g = Bt + (long)(br) * ldb + (long)(kt) * BK;                                                              \
    __builtin_amdgcn_global_load_lds((const unsigned*)(_g + boff0), (unsigned*)((char*)(P) + sb0), 16, 0, 0);               \
    __builtin_amdgcn_global_load_lds((const unsigned*)(_g + boff1), (unsigned*)((char*)(P) + sb1), 16, 0, 0);               \
  } while (0)
#define LDA(dst, b, h)                                                                                                       \
  for (int m = 0; m < 4; ++m)                                                                                                \
    for (int k = 0; k < 2; ++k) dst[m][k] = *reinterpret_cast<const bf16x8*>((char*)SA(b, h) + lds_byte(wr * 64 + m * 16 + fr, k * 32 + fq * 8))
#define LDB(dst, b, h)                                                                                                       \
  for (int n = 0; n < 2; ++n)                                                                                                \
    for (int k = 0; k < 2; ++k) dst[n][k] = *reinterpret_cast<const bf16x8*>((char*)SB(b, h) + lds_byte(wc * 32 + n * 16 + fr, k * 32 + fq * 8))
#define MMA(ai, bj, At_, Bt_)                                                                                                \
  do {                                                                                                                       \
    __builtin_amdgcn_s_setprio(1);                                                                                           \
    for (int m = 0; m < 4; ++m)                                                                                              \
      for (int n = 0; n < 2; ++n)                                                                                            \
        for (int k = 0; k < 2; ++k)                                                                                          \
          acc[ai][bj][m][n] = __builtin_amdgcn_mfma_f32_16x16x32_bf16(Bt_[n][k], At_[m][k], acc[ai][bj][m][n], 0, 0, 0);    \
    __builtin_amdgcn_s_setprio(0);                                                                                           \
  } while (0)
#define WAIT_V(n) asm volatile("s_waitcnt vmcnt(" #n ")" ::: "memory")
#define WAIT_L(n) asm volatile("s_waitcnt lgkmcnt(" #n ")" ::: "memory")
#define BAR __builtin_amdgcn_s_barrier()
#define SCHED __builtin_amdgcn_sched_barrier(0)

  int tx = wave_s * 64 + lane_id();
  asm volatile("" : "+v"(tx));
  const int wid = tx >> 6, lane = tx & 63, wr = wid >> 2, wc = wid & 3, fr = lane & 15, fq = lane >> 4;
  const int sb0 = tx * 16, sb1 = sb0 + 8192;
  int r0, c0, r1, c1;
  stage_rc(sb0, r0, c0);
  stage_rc(sb1, r1, c1);
  const unsigned aoff0 = (unsigned)(r0 * lda + c0), aoff1 = (unsigned)(r1 * lda + c1);
  const int rp0 = (r0 & ~31) | (8 * ((r0 & 15) >> 2) + 4 * ((r0 >> 4) & 1) + (r0 & 3));
  const int rp1 = (r1 & ~31) | (8 * ((r1 & 15) >> 2) + 4 * ((r1 >> 4) & 1) + (r1 & 3));
  const unsigned boff0 = (unsigned)(rp0 * ldb + c0), boff1 = (unsigned)(rp1 * ldb + c1);
  f32x4 acc[2][2][4][2];
#pragma unroll
  for (int a = 0; a < 2; ++a)
#pragma unroll
    for (int b = 0; b < 2; ++b)
#pragma unroll
      for (int m = 0; m < 4; ++m)
#pragma unroll
        for (int n = 0; n < 2; ++n) acc[a][b][m][n] = (f32x4){0.f, 0.f, 0.f, 0.f};
  bf16x8 At[4][2], B0[2][2], B1[2][2];
  const int nt = K / BK;
  STAGE_B(SB(0, 0), bcol, 0);
  STAGE_A(SA(0, 0), brow, 0);
  STAGE_B(SB(0, 1), bcol + HALF, 0);
  STAGE_A(SA(0, 1), brow + HALF, 0);
  if (wr == 1) BAR;
  WAIT_V(4);
  BAR;
  STAGE_B(SB(1, 0), bcol, 1);
  STAGE_A(SA(1, 0), brow, 1);
  STAGE_B(SB(1, 1), bcol + HALF, 1);
  WAIT_V(6);
  BAR;
  for (int t = 0; t < nt - 2; t += 2) {
    LDB(B0, 0, 0); SCHED; LDA(At, 0, 0); STAGE_A(SA(1, 1), brow + HALF, t + 1);
    WAIT_L(8); BAR; WAIT_L(0); MMA(0, 0, At, B0); BAR; SCHED;
    LDB(B1, 0, 1); STAGE_B(SB(0, 0), bcol, t + 2);
    BAR; WAIT_L(0); MMA(0, 1, At, B1); BAR;
    LDA(At, 0, 1); STAGE_A(SA(0, 0), brow, t + 2);
    BAR; WAIT_L(0); MMA(1, 0, At, B0); BAR; SCHED;
    STAGE_B(SB(0, 1), bcol + HALF, t + 2);
    WAIT_V(6); BAR; MMA(1, 1, At, B1); BAR;
    LDB(B0, 1, 0); SCHED; LDA(At, 1, 0); STAGE_A(SA(0, 1), brow + HALF, t + 2);
    WAIT_L(8); BAR; WAIT_L(0); MMA(0, 0, At, B0); BAR; SCHED;
    LDB(B1, 1, 1); STAGE_B(SB(1, 0), bcol, t + 3);
    BAR; WAIT_L(0); MMA(0, 1, At, B1); BAR;
    LDA(At, 1, 1); STAGE_A(SA(1, 0), brow, t + 3);
    BAR; WAIT_L(0); MMA(1, 0, At, B0); BAR; SCHED;
    STAGE_B(SB(1, 1), bcol + HALF, t + 3);
    WAIT_V(6); BAR; MMA(1, 1, At, B1); BAR;
  }
  {
    LDB(B0, 0, 0); LDA(At, 0, 0); STAGE_A(SA(1, 1), brow + HALF, nt - 1);
    BAR; WAIT_L(0); MMA(0, 0, At, B0); BAR;
    LDB(B1, 0, 1); BAR; WAIT_L(0); MMA(0, 1, At, B1); BAR;
    LDA(At, 0, 1); WAIT_V(4); BAR; WAIT_L(0); MMA(1, 0, At, B0); MMA(1, 1, At, B1); BAR;
  }
  {
    LDB(B0, 1, 0); LDA(At, 1, 0); WAIT_V(2); BAR; WAIT_L(0); MMA(0, 0, At, B0); BAR;
    LDB(B1, 1, 1); WAIT_V(0); BAR; WAIT_L(0); MMA(0, 1, At, B1); BAR;
    LDA(At, 1, 1); BAR; WAIT_L(0); MMA(1, 0, At, B0); MMA(1, 1, At, B1); BAR;
  }
  if (wr == 0) BAR;
#pragma unroll
  for (int ai = 0; ai < 2; ++ai)
#pragma unroll
    for (int m = 0; m < 4; ++m)
#pragma unroll
      for (int bj = 0; bj < 2; ++bj)
        epi(brow + ai * HALF + wr * 64 + m * 16 + fr, bcol + bj * HALF + wc * 32 + fq * 8, acc[ai][bj][m][0], acc[ai][bj][m][1]);
#undef SA
#undef SB
#undef STAGE_A
#undef STAGE_B
#undef LDA
#undef LDB
#undef MMA
}


template <class Epi>
__device__ __forceinline__ void tail_gemm8(const bf16_t* __restrict__ A, const int lda, const bf16_t* __restrict__ Bt, const int ldb,
                                           const int nct, const int K, const Epi& epi, const int wave_s) {
  extern __shared__ __attribute__((aligned(16))) bf16_t shm[];
  float* red = (float*)shm;
  int tx = wave_s * 64 + lane_id(), bid_ = blockIdx.x;
  asm volatile("" : "+v"(tx), "+s"(bid_));
  const int wave = tx >> 6, lane = tx & 63, fr = lane & 15, fq = lane >> 4;
  const int kw = K >> 3;
  for (int ct = bid_; ct < nct; ct += gridDim.x) {
    const bf16_t* ap = A + (size_t)fr * lda + wave * kw + fq * 8;
    const bf16_t* bp = Bt + (size_t)(ct * 16 + fr) * ldb + wave * kw + fq * 8;
    f32x4 acc = (f32x4){0.f, 0.f, 0.f, 0.f};
#pragma unroll 8
    for (int k = 0; k < kw; k += 32) {
      const bf16x8 a = *(const bf16x8*)(ap + k);
      const bf16x8 b = *(const bf16x8*)(bp + k);
      acc = __builtin_amdgcn_mfma_f32_16x16x32_bf16(b, a, acc, 0, 0, 0);
    }
    *(f32x4*)(red + (wave * 64 + lane) * 4) = acc;
    __syncthreads();
    if (wave == 0) {
      f32x4 sum = acc;
#pragma unroll
      for (int w = 1; w < 8; ++w) sum += *(const f32x4*)(red + (w * 64 + lane) * 4);
      epi(TAIL0 + fr, ct * 16 + fq * 4, sum);
    }
    __syncthreads();
  }
}
template <class Epi>
__device__ __forceinline__ void tail_tile1(const bf16_t* __restrict__ A, const int lda, const bf16_t* __restrict__ Bt, const int ldb,
                                           const int ct, const int K, const int lane, const Epi& epi) {
  const int fr = lane & 15, fq = lane >> 4;
  const bf16_t* ap = A + (size_t)fr * lda + fq * 8;
  const bf16_t* bp = Bt + (size_t)(ct * 16 + fr) * ldb + fq * 8;
  f32x4 acc = (f32x4){0.f, 0.f, 0.f, 0.f};
#pragma unroll 8
  for (int k = 0; k < K; k += 32) {
    const bf16x8 a = *(const bf16x8*)(ap + k);
    const bf16x8 b = *(const bf16x8*)(bp + k);
    acc = __builtin_amdgcn_mfma_f32_16x16x32_bf16(b, a, acc, 0, 0, 0);
  }
  epi(TAIL0 + fr, ct * 16 + fq * 4, acc);
}

__device__ __forceinline__ void tile_map(int wgid, int nM, int nN, int& pm, int& pn) {
  const int nwg = nM * nN, q = nwg / 8, r = nwg % 8, xcd = wgid % 8, off = wgid / 8;
  wgid = (xcd < r ? xcd * (q + 1) : r * (q + 1) + (xcd - r) * q) + off;
  const int nig = 8 * nN, gid = wgid / nig, fm = gid * 8, gsz = (nM - fm) < 8 ? (nM - fm) : 8;
  pm = fm + ((wgid % nig) % gsz);
  pn = (wgid % nig) / gsz;
}


typedef unsigned u32x2 __attribute__((ext_vector_type(2)));
template <int GRP>
__device__ __forceinline__ void pool_group(const bf16_t* __restrict__ PROJ, bf16_t* __restrict__ YPOOL, const int r, const int lane) {
  constexpr int W = 2 << GRP;
  u32x2 raw[W];
#pragma unroll
  for (int i = 0; i < W; ++i) {
    const int t = (r - i) < 0 ? 0 : (r - i);
    raw[i] = *(const u32x2*)(PROJ + (size_t)t * NINP + C_PIN + GRP * 256 + lane * 4);
  }
  float s0 = 0.f, s1 = 0.f, s2 = 0.f, s3 = 0.f;
#pragma unroll
  for (int i = W - 1; i >= 0; --i) {
    if (r - i >= 0) {
      s0 += bf2f(raw[i].x & 0xffff); s1 += bf2f(raw[i].x >> 16); s2 += bf2f(raw[i].y & 0xffff); s3 += bf2f(raw[i].y >> 16);
    }
  }
  const float c0 = bf2f(raw[0].x & 0xffff), c1 = bf2f(raw[0].x >> 16), c2 = bf2f(raw[0].y & 0xffff), c3 = bf2f(raw[0].y >> 16);
  const int cntw = (r + 1) < W ? (r + 1) : W;
  const float inv = 1.0f / (float)cntw;
  uint2 o; o.x = pk2(s0 * inv - c0, s1 * inv - c1); o.y = pk2(s2 * inv - c2, s3 * inv - c3);
  *(uint2*)(YPOOL + (size_t)r * 1024 + GRP * 256 + lane * 4) = o;
}


__device__ __forceinline__ void rmsnorm_rows(const float* __restrict__ HRES, const float* __restrict__ g, bf16_t* __restrict__ HN,
                                             const int gw, const int NGW, const int lane) {
  for (int r = gw; r < NKEYS; r += 2 * NGW) {
    const int r2 = (r + NGW < NKEYS) ? r + NGW : r;
    f32x4 va[8], vb[8];
#pragma unroll
    for (int j = 0; j < 8; ++j) {
      va[j] = *(const f32x4*)(HRES + (size_t)r * D + j * 256 + lane * 4);
      vb[j] = *(const f32x4*)(HRES + (size_t)r2 * D + j * 256 + lane * 4);
    }
    float sa = 0.f, sb = 0.f;
#pragma unroll
    for (int j = 0; j < 8; ++j) {
      sa += va[j][0] * va[j][0] + va[j][1] * va[j][1] + va[j][2] * va[j][2] + va[j][3] * va[j][3];
      sb += vb[j][0] * vb[j][0] + vb[j][1] * vb[j][1] + vb[j][2] * vb[j][2] + vb[j][3] * vb[j][3];
    }
#pragma unroll
    for (int o = 1; o < 64; o <<= 1) { sa += shx(sa, o, lane); sb += shx(sb, o, lane); }
    const float ra = rsqrtf(sa * (1.0f / D) + 1e-6f), rb = rsqrtf(sb * (1.0f / D) + 1e-6f);
#pragma unroll
    for (int j = 0; j < 8; ++j) {
      const f32x4 gg = *(const f32x4*)(g + j * 256 + lane * 4);
      uint2 oa, ob;
      oa.x = pk2(va[j][0] * ra * gg[0], va[j][1] * ra * gg[1]); oa.y = pk2(va[j][2] * ra * gg[2], va[j][3] * ra * gg[3]);
      ob.x = pk2(vb[j][0] * rb * gg[0], vb[j][1] * rb * gg[1]); ob.y = pk2(vb[j][2] * rb * gg[2], vb[j][3] * rb * gg[3]);
      *(uint2*)(HN + (size_t)r * D + j * 256 + lane * 4) = oa;
      *(uint2*)(HN + (size_t)r2 * D + j * 256 + lane * 4) = ob;
    }
  }
}

__device__ __forceinline__ void wconv_T(const float* __restrict__ W, int K, int N, int Npad, bf16_t* __restrict__ WT, int ldt,
                                        int nbatch, size_t strideW, size_t strideWT, float scale, const int wave_s) {
  extern __shared__ __attribute__((aligned(16))) bf16_t shm[];
  float* tile = (float*)shm;
  const int nkb = K / 64, nnb = Npad / 256, per = nkb * nnb, items = per * nbatch;
  int t = wave_s * 64 + lane_id(), bid_ = blockIdx.x;
  asm volatile("" : "+v"(t), "+s"(bid_));
  for (int item = bid_; item < items; item += gridDim.x) {
    const int b = item / per, it = item % per, kb = it % nkb, nb = it / nkb, k0 = kb * 64, n0 = nb * 256;
    const float* Wb = W + (size_t)b * strideW;
    bf16_t* WTb = WT + (size_t)b * strideWT;
    float4 v[8];
#pragma unroll
    for (int i = 0; i < 8; ++i) {
      const int kk = (t >> 4) + 32 * (i & 1), n4 = (t & 15) * 4 + (i >> 1) * 64;
      v[i] = make_float4(0.f, 0.f, 0.f, 0.f);
      if (n0 + n4 < N) {
        const f32x4 w4 = __builtin_nontemporal_load((const f32x4*)(Wb + (size_t)(k0 + kk) * N + n0 + n4));
        v[i] = make_float4(w4[0], w4[1], w4[2], w4[3]);
      }
    }
#pragma unroll
    for (int i = 0; i < 8; ++i) {
      const int kk = (t >> 4) + 32 * (i & 1), c4 = (t & 15) * 4;
      float* tp = tile + (i >> 1) * (64 * 65) + kk * 65 + c4;
      tp[0] = v[i].x; tp[1] = v[i].y; tp[2] = v[i].z; tp[3] = v[i].w;
    }
    __syncthreads();
    {
      const int n = t >> 3, kc = (t & 7) * 8;
#pragma unroll
      for (int sub = 0; sub < 4; ++sub) {
        const float* tp = tile + sub * (64 * 65) + kc * 65 + n;
        uint4 o;
        o.x = pk2(tp[0 * 65] * scale, tp[1 * 65] * scale);
        o.y = pk2(tp[2 * 65] * scale, tp[3 * 65] * scale);
        o.z = pk2(tp[4 * 65] * scale, tp[5 * 65] * scale);
        o.w = pk2(tp[6 * 65] * scale, tp[7 * 65] * scale);
        *(uint4*)(WTb + (size_t)(n0 + sub * 64 + n) * ldt + k0 + kc) = o;
      }
    }
    __syncthreads();
  }
}


#define XB_TMO      128
#define XB_XCNT(j)  (256  + 64 * (j))
#define XB_XSUB(j)  (1280 + 64 * (j))
#define XB_XGEN(j)  (2304 + 64 * (j))
#define XB_TOP      3328
#define XB_TOPGEN   3392
#define XCD_BAR_WORDS 3456
#define XB_SPIN_CAP (1u << 18)
#define LAS __attribute__((address_space(3)))
__device__ __forceinline__ unsigned xb_ld(unsigned* p)              { return __hip_atomic_load(p, __ATOMIC_RELAXED, __HIP_MEMORY_SCOPE_AGENT); }
__device__ __forceinline__ unsigned xb_add(unsigned* p, unsigned v) { return __hip_atomic_fetch_add(p, v, __ATOMIC_RELAXED, __HIP_MEMORY_SCOPE_AGENT); }
__device__ __forceinline__ unsigned xb_xcc_id() { return (unsigned)__builtin_amdgcn_s_getreg((3 << 11) | 20) & 0xFu; }
#define XB_SPIN(cond, bar) do { unsigned _sp = 0; while (cond) { __builtin_amdgcn_s_sleep(1); \
    if ((++_sp & 255u) == 0u) { if (xb_ld(&(bar)[XB_TMO])) break; if (_sp > XB_SPIN_CAP) { atomicAdd(&(bar)[XB_TMO], 1u); break; } } } } while (0)
struct XcdBarrier { unsigned* bar; unsigned x; volatile LAS unsigned* st; };
__device__ __forceinline__ XcdBarrier xcd_barrier_post(unsigned* bar, volatile LAS unsigned* st) {
    XcdBarrier b; b.bar = bar; b.x = xb_xcc_id(); b.st = st;
    if (threadIdx.x == 0) (void)xb_add(&bar[XB_XCNT(b.x)], 1u);
    return b;
}
__device__ __forceinline__ void xcd_barrier_complete(unsigned* bar, unsigned x, unsigned& nloc, unsigned& nx) {
    const unsigned G = gridDim.x * gridDim.y * gridDim.z;
    unsigned sum, cnt, mine, sp = 0u;
    for (;;) {
        sum = 0u; cnt = 0u; mine = 0u;
#pragma unroll
        for (unsigned j = 0; j < 16; ++j) { const unsigned c = xb_ld(&bar[XB_XCNT(j)]); sum += c; cnt += (c > 0u) ? 1u : 0u; mine = (j == x) ? c : mine; }
        if (sum == G) break;
        __builtin_amdgcn_s_sleep(1);
        if ((++sp & 255u) == 0u) { if (xb_ld(&bar[XB_TMO])) break; if (sp > XB_SPIN_CAP) { atomicAdd(&bar[XB_TMO], 1u); break; } }
    }
    nloc = mine > 0u ? mine : 1u; nx = cnt > 0u ? cnt : 1u;
}
__device__ __forceinline__ void xcd_barrier(const XcdBarrier& b, const int wave_s) {
    asm volatile("s_waitcnt vmcnt(0)" ::: "memory");
    __syncthreads();
    if (wave_s == 0 && lane_id() == 0) {
        unsigned* bar = b.bar;
        __builtin_amdgcn_s_waitcnt(0);
        unsigned nloc = b.st[0], nx = b.st[1];
        if (nloc == 0u) { xcd_barrier_complete(bar, b.x, nloc, nx); b.st[0] = nloc; b.st[1] = nx; }
        const unsigned old = xb_add(&bar[XB_XSUB(b.x)], 1u);
        const unsigned gen = old / nloc;
        if (old + 1u == (gen + 1u) * nloc) {
            __builtin_amdgcn_fence(__ATOMIC_RELEASE, "agent");
            asm volatile("s_waitcnt vmcnt(0)" ::: "memory");
            const unsigned og = xb_add(&bar[XB_TOP], 1u);
            const unsigned tg = og / nx;
            if (og + 1u == (tg + 1u) * nx) xb_add(&bar[XB_TOPGEN], 1u);
            else XB_SPIN(xb_ld(&bar[XB_TOPGEN]) == tg, bar);
            __builtin_amdgcn_fence(__ATOMIC_ACQUIRE, "agent");
            xb_add(&bar[XB_XGEN(b.x)], 1u);
            asm volatile("s_waitcnt vmcnt(0)" ::: "memory");
        } else {
            XB_SPIN(xb_ld(&bar[XB_XGEN(b.x)]) == gen, bar);
            __builtin_amdgcn_fence(__ATOMIC_ACQUIRE, "agent");
            asm volatile("s_waitcnt vmcnt(0)" ::: "memory");
        }
    }
    __syncthreads();
}

__global__ void __launch_bounds__(512) fwd(Params p) {
  extern __shared__ __attribute__((aligned(16))) bf16_t shm[];
  cg::grid_group grid = cg::this_grid();
  const int wave_s = __builtin_amdgcn_readfirstlane((int)(threadIdx.x >> 6));
  volatile LAS unsigned* xst = (volatile LAS unsigned*)((LAS char*)shm + LDS_XB_OFF);
  if (threadIdx.x == 0) { xst[0] = 0u; xst[1] = 0u; xst[2] = 0u; xst[3] = 0u; }
  __syncthreads();
  const XcdBarrier xbar = xcd_barrier_post((unsigned*)(p.ws + OFF_BAR), xst);
#define BLOCK_IDS                                   \
  int bid = blockIdx.x, G = gridDim.x;              \
  asm volatile("" : "+s"(bid), "+s"(G));            \
  const int NGW = G * 8; (void)NGW;
#define PHASE_PTRS \
  unsigned long long zo_ = 0; \
  asm volatile("" : "+s"(zo_)); \
  unsigned char* wsb = p.ws + zo_; \
  float* HRES = (float*)(wsb + OFF_HRES); \
  bf16_t* HN = (bf16_t*)(wsb + OFF_HN); \
  bf16_t* PROJ = (bf16_t*)(wsb + OFF_PROJ); \
  bf16_t* CKV = (bf16_t*)(wsb + OFF_CKV); \
  bf16_t* KIDX = (bf16_t*)(wsb + OFF_KIDX); \
  bf16_t* YPOOL = (bf16_t*)(wsb + OFF_YPOOL); \
  bf16_t* YP2 = (bf16_t*)(wsb + OFF_YP2); \
  bf16_t* QLAT = (bf16_t*)(wsb + OFF_QLAT); \
  bf16_t* OLAT = (bf16_t*)(wsb + OFF_OLAT); \
  bf16_t* OB = (bf16_t*)(wsb + OFF_O); \
  float* MB = (float*)(wsb + OFF_MB); \
  bf16_t* MERGED = (bf16_t*)(wsb + OFF_MERGED); \
  bf16_t* WIN = (bf16_t*)(wsb + OFF_WIN); \
  bf16_t* WUK = (bf16_t*)(wsb + OFF_WUK); \
  bf16_t* WUV = (bf16_t*)(wsb + OFF_WUV); \
  bf16_t* WAO = (bf16_t*)(wsb + OFF_WAO); \
  bf16_t* WPOOL = (bf16_t*)(wsb + OFF_WPOOL); \
  bf16_t* WPO = (bf16_t*)(wsb + OFF_WPO); \
  bf16_t* WOUT = (bf16_t*)(wsb + OFF_WOUT); \
  bf16_t* WMI = (bf16_t*)(wsb + OFF_WMI); \
  bf16_t* WMO = (bf16_t*)(wsb + OFF_WMO); \
  bf16_t* UB = PROJ; \
  (void)HRES; (void)HN; (void)CKV; (void)KIDX; (void)YPOOL; (void)YP2; (void)QLAT; (void)OLAT; (void)OB; (void)MB; (void)MERGED; (void)WIN; (void)WUK; (void)WUV; (void)WAO; (void)WPOOL; (void)WPO; (void)WOUT; (void)WMI; (void)WMO; (void)UB;
#define PHASE_IDS                                  \
  int tid = wave_s * 64 + lane_id();               \
  asm volatile("" : "+v"(tid));                    \
  const int wave = tid >> 6, lane = tid & 63, gw = bid * 8 + wave; \
  (void)lane; (void)gw; \
  PHASE_PTRS


  {
  BLOCK_IDS
  PHASE_IDS
  for (int r = gw; r < NKEYS; r += NGW) {
#pragma unroll
    for (int j = 0; j < 8; ++j) {
      const int c = j * 256 + lane * 4;
      float4 v = make_float4(0.f, 0.f, 0.f, 0.f);
      if (r < NMETA) v = *(const float4*)(p.in[1] + (size_t)r * D + c);
      else if (r < NKEYS) v = *(const float4*)(p.in[0] + (size_t)(r - NMETA) * D + c);
      *(float4*)(HRES + (size_t)r * D + c) = v;
    }
  }
  }
  grid.sync();

#pragma unroll 1
  for (int l = 0; l < DEPTH; ++l) {
    BLOCK_IDS
    for (int rep = 0; rep < REP_P1; ++rep) {
      PHASE_IDS
      wconv_T(p.in[15] + (size_t)l * DFF * D, DFF, D, D, WMO, DFF, 1, 0, 0, 1.0f, wave_s);
      wconv_T(p.in[14] + (size_t)l * D * DFF, D, DFF, DFF, WMI, D, 1, 0, 0, 1.0f, wave_s);
      wconv_T(p.in[12] + (size_t)l * D * D, D, D, D, WOUT, D, 1, 0, 0, 1.0f, wave_s);
      wconv_T(p.in[11] + (size_t)l * 1024 * D, 1024, D, D, WPO, 1024, 1, 0, 0, 1.0f, wave_s);
      wconv_T(p.in[9] + (size_t)l * 4 * 65536, 256, 256, 256, WPOOL, 256, 4, (size_t)65536, (size_t)65536, 1.0f, wave_s);
      wconv_T(p.in[8] + (size_t)l * D * D, D, D, D, WAO, D, 1, 0, 0, 1.0f, wave_s);
      wconv_T(p.in[7] + (size_t)l * 16 * 256 * 128, 256, 128, 256, WUV, 256, 16, (size_t)256 * 128, (size_t)65536, 1.0f, wave_s);
      rmsnorm_rows(HRES, p.in[2] + (size_t)l * D, HN, gw, NGW, lane);
      wconv_T(p.in[3] + (size_t)l * D * NIN, D, NIN, NINP, WIN, D, 1, 0, 0, 1.0f, wave_s);
      {
        const float* wuk = p.in[6] + (size_t)l * 16 * 256 * 128;
        const float sc = 0.08838834764831845f * 1.4426950408889634f;
        for (int i = bid * 512 + tid; i < 16 * 256 * 32; i += G * 512) {
          const int row = i >> 5, kc = (i & 31) * 8;
          uint4 o = make_uint4(0u, 0u, 0u, 0u);
          if (kc < 128) {
            const f32x4 a = __builtin_nontemporal_load((const f32x4*)(wuk + (size_t)row * 128 + kc));
            const f32x4 b = __builtin_nontemporal_load((const f32x4*)(wuk + (size_t)row * 128 + kc + 4));
            o.x = pk2(a[0] * sc, a[1] * sc); o.y = pk2(a[2] * sc, a[3] * sc);
            o.z = pk2(b[0] * sc, b[1] * sc); o.w = pk2(b[2] * sc, b[3] * sc);
          }
          *(uint4*)(WUK + (size_t)row * 256 + kc) = o;
        }
      }
    }
    xcd_barrier(xbar, wave_s);

    {
      PHASE_PTRS
      auto epi = [&](int row, int col, f32x4 v) {
        uint2 o; o.x = pk2(v[0], v[1]); o.y = pk2(v[2], v[3]);
        *(uint2*)(PROJ + (size_t)row * NINP + col) = o;
      };
      auto epi8 = [&](int row, int col, f32x4 a, f32x4 b) {
        uint4 o; o.x = pk2(a[0], a[1]); o.y = pk2(a[2], a[3]); o.z = pk2(b[0], b[1]); o.w = pk2(b[2], b[3]);
        *(uint4*)(PROJ + (size_t)row * NINP + col) = o;
      };
      const int nN = NINP / 256, ntiles = NMT * nN;
      for (int t = bid; t < ntiles; t += G) {
        int pm, pn; tile_map(t, NMT, nN, pm, pn);
        gemm_tile(HN, D, WIN, D, pm * 256, pn * 256, D, epi8, wave_s);
      }
      tail_gemm8(HN + (size_t)TAIL0 * D, D, WIN, D, NINP / 16, D, epi, wave_s);
    }
    xcd_barrier(xbar, wave_s);

    {
      PHASE_IDS
      const float* gkv = p.in[4] + (size_t)l * 256;
      const float* gik = p.in[5] + (size_t)l * 64;
      for (int r = gw; r < NKEYS; r += NGW) {
        const bf16_t* pr = PROJ + (size_t)r * NINP;
        {
          const uint2 raw = *(const uint2*)(pr + C_CKV + lane * 4);
          float a0 = bf2f(raw.x & 0xffff), a1 = bf2f(raw.x >> 16), a2 = bf2f(raw.y & 0xffff), a3 = bf2f(raw.y >> 16);
          float s = wave_sum(a0 * a0 + a1 * a1 + a2 * a2 + a3 * a3, lane);
          const float rs = rsqrtf(s * (1.0f / 256.0f) + 1e-6f);
          const float4 gg = *(const float4*)(gkv + lane * 4);
          uint2 o; o.x = pk2(a0 * rs * gg.x, a1 * rs * gg.y); o.y = pk2(a2 * rs * gg.z, a3 * rs * gg.w);
          *(uint2*)(CKV + (size_t)r * 256 + lane * 4) = o;
        }
        {
          const float a = bf2f(pr[C_KIDX + lane]);
          const float s = wave_sum(a * a, lane);
          const float rs = rsqrtf(s * (1.0f / 64.0f) + 1e-6f);
          KIDX[((size_t)((r >> 5) * 4 + (lane >> 4)) * 64 + ((lane >> 3) & 1) * 32 + (r & 31)) * 8 + (lane & 7)] = f2bf(a * rs * gik[lane]);
        }
        pool_group<0>(PROJ, YPOOL, r, lane);
        pool_group<1>(PROJ, YPOOL, r, lane);
        pool_group<2>(PROJ, YPOOL, r, lane);
        pool_group<3>(PROJ, YPOOL, r, lane);
      }
      const int ntiles = 16 * NMT;
      for (int t = bid; t < ntiles; t += G) {
        const int h = t / NMT, pm = t % NMT;
        auto epi8 = [&](int row, int col, f32x4 a, f32x4 b) {
          uint4 o; o.x = pk2(a[0], a[1]); o.y = pk2(a[2], a[3]); o.z = pk2(b[0], b[1]); o.w = pk2(b[2], b[3]);
          *(uint4*)(QLAT + (size_t)row * 4096 + h * 256 + col) = o;
        };
        gemm_tile(PROJ + h * 128, NINP, WUK + (size_t)h * 65536, 256, pm * 256, 0, 256, epi8, wave_s);
      }
      int tid2 = wave_s * 64 + lane_id();
      asm volatile("" : "+v"(tid2));
      const int lane2 = tid2 & 63, gw2 = bid * 8 + (tid2 >> 6);
      for (int task = gw2; task < 16 * 16; task += NGW) {
        const int h = task >> 4, ct = task & 15;
        auto epi = [&](int row, int col, f32x4 v) {
          uint2 o; o.x = pk2(v[0], v[1]); o.y = pk2(v[2], v[3]);
          *(uint2*)(QLAT + (size_t)row * 4096 + h * 256 + col) = o;
        };
        tail_tile1(PROJ + (size_t)TAIL0 * NINP + h * 128, NINP, WUK + (size_t)h * 65536, 256, ct, 128, lane2, epi);
      }
    }
    xcd_barrier(xbar, wave_s);

    {
      PHASE_IDS
      unsigned* SC = (unsigned*)shm;
      int* IDX = (int*)((char*)shm + LDS_IDX_OFF);
      int* CAND = (int*)((char*)shm + LDS_CAND_OFF);
      const int nunits = NKEYS / 4;
      unsigned* qctr = (unsigned*)(wsb + OFF_BAR) + 3520 + 64 * l;
      volatile int* QW = (volatile int*)((char*)shm + LDS_XCH_OFF) + 32;
      unsigned* HIST = (unsigned*)CAND;
      {
        u32x4* hz = (u32x4*)HIST + tid * 2;
        unsigned z = 0u;
        asm volatile("" : "+v"(z));
        hz[0] = (u32x4){z, z, z, z}; hz[1] = (u32x4){z, z, z, z};
      }
      int tkt;
      {
        if (wave == 0 && lane == 0) *QW = (int)__hip_atomic_fetch_add(qctr, 1u, __ATOMIC_RELAXED, __HIP_MEMORY_SCOPE_AGENT);
        __syncthreads();
        tkt = __builtin_amdgcn_readfirstlane(*QW);
      }
#pragma unroll 1
      while (tkt < nunits) {
        int nxt = 0;
        if (wave == 0 && lane == 0) nxt = (int)__hip_atomic_fetch_add(qctr, 1u, __ATOMIC_RELAXED, __HIP_MEMORY_SCOPE_AGENT);
        const int u = nunits - 1 - tkt;
        int lane_u_ = lane;
        asm volatile("" : "+v"(lane_u_));
        const int lane = lane_u_;
        const int q0 = u * 4;
        const int nk = q0 + 4;
        const int nit = (nk + 255) >> 8;
        const int ntile = nit * 8;
        for (int rsc = 0; rsc < REP_SC; ++rsc) {
          const int r = lane & 31, kg = lane >> 5, qi = r & 3, head = r >> 2;
          bf16x8 qa[4];
          const bf16_t* qp = PROJ + (size_t)(q0 + qi) * NINP + C_QIDX + head * 64 + kg * 8;
#pragma unroll
          for (int ks = 0; ks < 4; ++ks) qa[ks] = *(const bf16x8*)(qp + ks * 16);
          float wv[4][4];
#pragma unroll
          for (int i = 0; i < 4; ++i)
#pragma unroll
            for (int j = 0; j < 4; ++j) wv[i][j] = bf2f(PROJ[(size_t)(q0 + j) * NINP + C_WIDX + 2 * i + kg]);
          const unsigned klane = (unsigned)lane * 8u;
          bf16x8 kbuf[4][4];
#pragma unroll
          for (int pi = 0; pi < 3; ++pi) {
            const int tp = wave_s + 8 * ((pi < nit) ? pi : nit - 1);
#pragma unroll
            for (int ks = 0; ks < 4; ++ks) kbuf[pi][ks] = *(const bf16x8*)(KIDX + (size_t)(tp * 4 + ks) * 512 + klane);
          }
          for (int base = 0; base < nit; base += 4) {
#pragma unroll
            for (int uu = 0; uu < 4; ++uu) {
              const int i = (base + uu < nit) ? base + uu : nit - 1;
              {
                {
                  const int ip = (base + uu + 3 < nit) ? base + uu + 3 : nit - 1;
                  const int tp = wave_s + 8 * ip;
#pragma unroll
                  for (int ks = 0; ks < 4; ++ks) kbuf[(uu + 3) % 4][ks] = *(const bf16x8*)(KIDX + (size_t)(tp * 4 + ks) * 512 + klane);
                }
                if (base + uu < nit) {
                const int tt = wave_s + 8 * i;
                const int key = tt * 32 + r;
                f32x16 acc;
#pragma unroll
                for (int q = 0; q < 16; ++q) acc[q] = 0.f;
#pragma unroll
                for (int ks = 0; ks < 4; ++ks) acc = __builtin_amdgcn_mfma_f32_32x32x16_bf16(qa[ks], kbuf[uu][ks], acc, 0, 0, 0);
#define RELU_(x) __int_as_float(max(__float_as_int(x), 0))
                const float p0 = wv[0][0] * RELU_(acc[0]) + wv[1][0] * RELU_(acc[4]) + wv[2][0] * RELU_(acc[8]) + wv[3][0] * RELU_(acc[12]);
                const float p1 = wv[0][1] * RELU_(acc[1]) + wv[1][1] * RELU_(acc[5]) + wv[2][1] * RELU_(acc[9]) + wv[3][1] * RELU_(acc[13]);
                const float p2 = wv[0][2] * RELU_(acc[2]) + wv[1][2] * RELU_(acc[6]) + wv[2][2] * RELU_(acc[10]) + wv[3][2] * RELU_(acc[14]);
                const float p3 = wv[0][3] * RELU_(acc[3]) + wv[1][3] * RELU_(acc[7]) + wv[2][3] * RELU_(acc[11]) + wv[3][3] * RELU_(acc[15]);
#undef RELU_
                const auto r02 = __builtin_amdgcn_permlane32_swap(__float_as_uint(p0), __float_as_uint(p2), false, false);
                const auto r13 = __builtin_amdgcn_permlane32_swap(__float_as_uint(p1), __float_as_uint(p3), false, false);
                const float sa = __uint_as_float(r02[0]) + __uint_as_float(r02[1]);
                const float sb = __uint_as_float(r13[0]) + __uint_as_float(r13[1]);
#pragma unroll
                for (int jj = 0; jj < 2; ++jj) {
                  const int j = kg * 2 + jj;
                  const float s = (jj ? sb : sa) + 0.0f;
                  unsigned ub = __float_as_uint(s);
                  ub ^= (unsigned)((int)ub >> 31) | 0x80000000u;
                  if (key > q0 + j) ub = 0u;
                  SC[j * SCLD + key] = ub;
                  if (ub != 0u) {
                    const unsigned bin = ub >> 21;
                    __hip_atomic_fetch_add(HIST + j * 1024 + (bin >> 1), 1u << ((bin & 1u) * 16u), __ATOMIC_RELAXED, __HIP_MEMORY_SCOPE_WORKGROUP);
                  }
                }
                }
              }
            }
          }
        }
        __syncthreads();
        for (int rsel = 0; rsel < REP_SEL; ++rsel) {
          const int j = wave & 3, half = wave >> 2, qpos = q0 + j, nvalid = qpos + 1;
          const bool big = nvalid > 256;
          int* idx = IDX + j * 256;
          int* cand = CAND + (j * 2 + half) * CAND_CAP2;
          int* XCH = (int*)((char*)shm + LDS_XCH_OFF);
          const unsigned* sc1 = SC + j * SCLD;
          const uint4* sc4 = (const uint4*)sc1;
          const int nh = (nit + 1) >> 1;
          const int g0 = half ? nh : 0, g1 = half ? nit : nh;
          unsigned prefix = 0u;
          if (big) {
            const u32x4* hq = (const u32x4*)(HIST + j * 1024) + lane * 4;
            const u32x4 w0 = hq[0], w1 = hq[1], w2 = hq[2], w3 = hq[3];
            unsigned cw[16];
#pragma unroll
            for (int q = 0; q < 4; ++q) { cw[q] = w0[q]; cw[4 + q] = w1[q]; cw[8 + q] = w2[q]; cw[12 + q] = w3[q]; }
            int sl = 0;
#pragma unroll
            for (int q = 0; q < 16; ++q) sl += (int)(cw[q] & 0xffffu) + (int)(cw[q] >> 16);
            int S = sl;
#pragma unroll
            for (int o = 1; o < 64; o <<= 1) {
              const int tv = __builtin_amdgcn_ds_bpermute(((lane + o) & 63) << 2, S);
              if (lane + o < 64) S += tv;
            }
            const int L = __popcll(__ballot(S >= 256)) - 1;
            int run = S - sl, found = -1;
#pragma unroll
            for (int bb = 31; bb >= 0; --bb) {
              run += (bb & 1) ? (int)(cw[bb >> 1] >> 16) : (int)(cw[bb >> 1] & 0xffffu);
              if (run >= 256 && found < 0) found = bb;
            }
            const int fb = __builtin_amdgcn_readlane(found, L);
            prefix = (unsigned)(L * 32 + fb) << 21;
          }
          __syncthreads();
          const unsigned P = prefix >> 21;
          int c = 0, m = 0;
          if (big) {
            for (int it = g0 * 4; it < g1 * 4; it += 4) {
              unsigned x[4];
#pragma unroll
              for (int e = 0; e < 4; ++e) x[e] = sc1[(it + e) * 64 + lane];
#pragma unroll
              for (int e = 0; e < 4; ++e) {
                const unsigned t = x[e] >> 21;
                const bool isA = t > P, isB = t == P;
                const unsigned long long mA = __ballot(isA), mB = __ballot(isB);
                const int oA = __builtin_amdgcn_mbcnt_hi((unsigned)(mA >> 32), __builtin_amdgcn_mbcnt_lo((unsigned)mA, 0u));
                const int oB = __builtin_amdgcn_mbcnt_hi((unsigned)(mB >> 32), __builtin_amdgcn_mbcnt_lo((unsigned)mB, 0u));
                if (isA) idx[half ? (255 - (c + oA)) : (c + oA)] = (it + e) * 64 + lane;
                if (isB && (m + oB) < CAND_CAP2) cand[m + oB] = (it + e) * 64 + lane;
                c += __popcll(mA);
                m += __popcll(mB);
              }
            }
          }
          if (lane == 0) { XCH[16 + wave * 2] = c; XCH[16 + wave * 2 + 1] = m; }
          __syncthreads();
          if (half == 0) {
            if (!big) {
              for (int i = lane; i < 256; i += 64) idx[i] = (i < nvalid) ? i : 0;
            } else {
              const int cB = XCH[16 + (wave + 4) * 2], mB = XCH[16 + (wave + 4) * 2 + 1];
              const int mA = m, mt = mA + mB;
              const int* candB = CAND + (j * 2 + 1) * CAND_CAP2;
              if (mA <= CAND_CAP2 && mB <= CAND_CAP2) {
                const int need = 256 - c - cB;
                unsigned T = prefix;
                auto fine = [&](auto KMtag) {
                  constexpr int KM = decltype(KMtag)::value;
                  unsigned cv[KM];
                  int ci[KM];
#pragma unroll
                  for (int k = 0; k < KM; ++k) {
                    const int i = k * 64 + lane;
                    ci[k] = (i < mA) ? cand[i] : ((i < mt) ? candB[i - mA] : 0);
                    cv[k] = (i < mt) ? sc1[ci[k]] : 0u;
                  }
                  for (int bit = 20; bit >= 0; --bit) {
                    const unsigned cd = T | (1u << bit);
                    int cnt = 0;
#pragma unroll
                    for (int k = 0; k < KM; ++k) cnt += __popcll(__ballot(cv[k] >= cd));
                    if (cnt >= need) T = cd;
                  }
                  int pos = c;
#pragma unroll
                  for (int k = 0; k < KM; ++k) {
                    const bool sel = cv[k] > T;
                    const unsigned long long mk = __ballot(sel);
                    const int off = __builtin_amdgcn_mbcnt_hi((unsigned)(mk >> 32), __builtin_amdgcn_mbcnt_lo((unsigned)mk, 0u));
                    if (sel) idx[pos + off] = ci[k];
                    pos += __popcll(mk);
                  }
                  const int lim = 256 - cB;
#pragma unroll
                  for (int k = 0; k < KM; ++k) {
                    const bool sel = cv[k] == T;
                    const unsigned long long mk = __ballot(sel);
                    const int off = __builtin_amdgcn_mbcnt_hi((unsigned)(mk >> 32), __builtin_amdgcn_mbcnt_lo((unsigned)mk, 0u));
                    if (sel && (pos + off) < lim) idx[pos + off] = ci[k];
                    pos += __popcll(mk);
                  }
                };
                if (mt <= 256) fine(std::integral_constant<int, 4>{});
                else fine(std::integral_constant<int, (2 * CAND_CAP2) / 64>{});
              } else {
                unsigned pf = 0u;
                for (int bit = 31; bit >= 0; --bit) {
                  const unsigned cd = pf | (1u << bit);
                  int cnt = 0;
                  for (int it = 0; it < nit; ++it) {
                    const uint4 v = sc4[it * 64 + lane];
                    cnt += __popcll(__ballot(v.x >= cd)) + __popcll(__ballot(v.y >= cd)) + __popcll(__ballot(v.z >= cd)) + __popcll(__ballot(v.w >= cd));
                  }
                  if (cnt >= 256) pf = cd;
                }
                const unsigned T = pf;
                int c2 = 0;
                const int nit64 = nit * 4;
                for (int it = 0; it < nit64; ++it) {
                  const unsigned x = sc1[it * 64 + lane];
                  const bool sel = x > T;
                  const unsigned long long mask = __ballot(sel);
                  const int off = __builtin_amdgcn_mbcnt_hi((unsigned)(mask >> 32), __builtin_amdgcn_mbcnt_lo((unsigned)mask, 0u));
                  if (sel) idx[c2 + off] = it * 64 + lane;
                  c2 += __popcll(mask);
                }
                for (int it = 0; it < nit64 && c2 < 256; ++it) {
                  const unsigned x = sc1[it * 64 + lane];
                  const bool sel = x == T;
                  const unsigned long long mask = __ballot(sel);
                  const int off = __builtin_amdgcn_mbcnt_hi((unsigned)(mask >> 32), __builtin_amdgcn_mbcnt_lo((unsigned)mask, 0u));
                  if (sel && (c2 + off) < 256) idx[c2 + off] = it * 64 + lane;
                  c2 += __popcll(mask);
                }
              }
            }
          }
          if (rsel + 1 < REP_SEL) __syncthreads();
        }
        __syncthreads();
        {
          u32x4* hz = (u32x4*)HIST + (wave * 64 + lane) * 2;
          unsigned z = 0u;
          asm volatile("" : "+v"(z));
          hz[0] = (u32x4){z, z, z, z}; hz[1] = (u32x4){z, z, z, z};
        }
        for (int ratt = 0; ratt < REP_ATT; ++ratt) {
          if (ratt) __syncthreads();
          const int j = wave & 3, half = wave >> 2, qpos = q0 + j;
          const int nsel = (qpos + 1) < 256 ? (qpos + 1) : 256;
          const int* idx = IDX + j * 256;
          bf16_t* ST = (bf16_t*)((char*)shm + wave * (32 * ST_LD * 2));
          float* XF = (float*)ST;
          const int fr = lane & 15, fq = lane >> 4;
          bf16x8 qb[8];
          const bf16_t* qlp = QLAT + (size_t)qpos * 4096 + fr * 256 + fq * 8;
#pragma unroll
          for (int ks = 0; ks < 8; ++ks) qb[ks] = *(const bf16x8*)(qlp + ks * 32);
          f32x4 o[16];
#pragma unroll
          for (int i = 0; i < 16; ++i) o[i] = (f32x4){0.f, 0.f, 0.f, 0.f};
          float mrun = -INFINITY, lrun = 0.f;
          const int nchunk = (nsel + 31) >> 5, nfirst = (nchunk + 1) >> 1;
          const int cb = half ? nfirst : 0, ce = half ? nchunk : nfirst;
          const unsigned st_base = (unsigned)(size_t)(__attribute__((address_space(3))) char*)ST;
          const unsigned tr_addr = st_base + (unsigned)(((fq * 4 + (fr >> 2)) * ST_LD + (fr & 3) * 4) * 2);
          bf16x8 ar[2][8];
          {
            const int c0 = (cb < ce) ? cb : 0;
#pragma unroll
            for (int tt = 0; tt < 2; ++tt) {
              const bf16_t* kr = CKV + (size_t)idx[c0 * 32 + tt * 16 + fr] * 256 + fq * 8;
#pragma unroll
              for (int ks = 0; ks < 8; ++ks) ar[tt][ks] = *(const bf16x8*)(kr + ks * 32);
            }
          }
          for (int ch = cb; ch < ce; ++ch) {
            f32x4 s[2];
#pragma unroll
            for (int tt = 0; tt < 2; ++tt) {
              s[tt] = (f32x4){0.f, 0.f, 0.f, 0.f};
#pragma unroll
              for (int ks = 0; ks < 8; ++ks) s[tt] = __builtin_amdgcn_mfma_f32_16x16x32_bf16(ar[tt][ks], qb[ks], s[tt], 0, 0, 0);
            }
#pragma unroll
            for (int tt = 0; tt < 2; ++tt)
#pragma unroll
              for (int ks = 0; ks < 8; ++ks) *(bf16x8*)(ST + (tt * 16 + fr) * ST_LD + ks * 32 + fq * 8) = ar[tt][ks];
            asm volatile("s_waitcnt lgkmcnt(0)" ::: "memory");
            __builtin_amdgcn_wave_barrier();
            {
              const int cn = (ch + 1 < ce) ? ch + 1 : ch;
#pragma unroll
              for (int tt = 0; tt < 2; ++tt) {
                const bf16_t* kr = CKV + (size_t)idx[cn * 32 + tt * 16 + fr] * 256 + fq * 8;
#pragma unroll
                for (int ks = 0; ks < 8; ++ks) ar[tt][ks] = *(const bf16x8*)(kr + ks * 32);
              }
            }
            if (nsel < 256) {
#pragma unroll
              for (int tt = 0; tt < 2; ++tt)
#pragma unroll
                for (int e = 0; e < 4; ++e)
                  if (ch * 32 + tt * 16 + fq * 4 + e >= nsel) s[tt][e] = -INFINITY;
            }
            float mx = fmaxf(fmaxf(fmaxf(s[0][0], s[0][1]), fmaxf(s[0][2], s[0][3])), fmaxf(fmaxf(s[1][0], s[1][1]), fmaxf(s[1][2], s[1][3])));
            mx = fmaxf(mx, shx(mx, 16, lane));
            mx = fmaxf(mx, shx(mx, 32, lane));
            const float mnew = fmaxf(mrun, mx);
            const float alpha = __builtin_amdgcn_exp2f(mrun - mnew);
            float ps = 0.f;
            float pv[8];
#pragma unroll
            for (int tt = 0; tt < 2; ++tt)
#pragma unroll
              for (int e = 0; e < 4; ++e) {
                const float pe = __builtin_amdgcn_exp2f(s[tt][e] - mnew);
                pv[tt * 4 + e] = pe;
                ps += pe;
              }
            ps += shx(ps, 16, lane);
            ps += shx(ps, 32, lane);
            lrun = lrun * alpha + ps;
            mrun = mnew;
            union { bf16x8 v; unsigned u[4]; } pb;
            pb.u[0] = pk2(pv[0], pv[1]); pb.u[1] = pk2(pv[2], pv[3]); pb.u[2] = pk2(pv[4], pv[5]); pb.u[3] = pk2(pv[6], pv[7]);
#pragma unroll
            for (int rt = 0; rt < 16; ++rt) o[rt] *= alpha;
#pragma unroll
            for (int rb = 0; rb < 4; ++rb) {
              union { bf16x8 v; u16x4 h[2]; } va[4];
              asm volatile(
                  "ds_read_b64_tr_b16 %0, %8 offset:%9\n\t"
                  "ds_read_b64_tr_b16 %1, %8 offset:%10\n\t"
                  "ds_read_b64_tr_b16 %2, %8 offset:%11\n\t"
                  "ds_read_b64_tr_b16 %3, %8 offset:%12\n\t"
                  "ds_read_b64_tr_b16 %4, %8 offset:%13\n\t"
                  "ds_read_b64_tr_b16 %5, %8 offset:%14\n\t"
                  "ds_read_b64_tr_b16 %6, %8 offset:%15\n\t"
                  "ds_read_b64_tr_b16 %7, %8 offset:%16\n\t"
                  "s_waitcnt lgkmcnt(0)"
                  : "=&v"(va[0].h[0]), "=&v"(va[0].h[1]), "=&v"(va[1].h[0]), "=&v"(va[1].h[1]),
                    "=&v"(va[2].h[0]), "=&v"(va[2].h[1]), "=&v"(va[3].h[0]), "=&v"(va[3].h[1])
                  : "v"(tr_addr),
                    "i"((rb * 4 + 0) * 32), "i"((rb * 4 + 0) * 32 + 16 * ST_LD * 2),
                    "i"((rb * 4 + 1) * 32), "i"((rb * 4 + 1) * 32 + 16 * ST_LD * 2),
                    "i"((rb * 4 + 2) * 32), "i"((rb * 4 + 2) * 32 + 16 * ST_LD * 2),
                    "i"((rb * 4 + 3) * 32), "i"((rb * 4 + 3) * 32 + 16 * ST_LD * 2)
                  : "memory");
#pragma unroll
              for (int q = 0; q < 4; ++q)
                o[rb * 4 + q] = __builtin_amdgcn_mfma_f32_16x16x32_bf16(va[q].v, pb.v, o[rb * 4 + q], 0, 0, 0);
            }
            asm volatile("s_waitcnt lgkmcnt(0)" ::: "memory");
            __builtin_amdgcn_wave_barrier();
          }
          if (half == 1) {
            XF[lane] = mrun;
            XF[64 + lane] = lrun;
#pragma unroll
            for (int rt = 0; rt < 16; ++rt)
#pragma unroll
              for (int e = 0; e < 4; ++e) XF[(2 + rt * 4 + e) * 64 + lane] = o[rt][e];
          }
          __syncthreads();
          if (half == 0) {
            const float* XP = (const float*)((char*)shm + (wave + 4) * (32 * ST_LD * 2));
            const float m1 = XP[lane], l1 = XP[64 + lane];
            const float mm = fmaxf(mrun, m1);
            const float a0 = __builtin_amdgcn_exp2f(mrun - mm), a1 = __builtin_amdgcn_exp2f(m1 - mm);
            const float invl = 1.0f / (lrun * a0 + l1 * a1);
            const float w0 = a0 * invl, w1 = a1 * invl;
            bf16_t* op = OLAT + (size_t)qpos * 4096 + fr * 256 + fq * 4;
#pragma unroll
            for (int rt = 0; rt < 16; ++rt) {
              float r[4];
#pragma unroll
              for (int e = 0; e < 4; ++e) r[e] = o[rt][e] * w0 + XP[(2 + rt * 4 + e) * 64 + lane] * w1;
              uint2 w; w.x = pk2(r[0], r[1]); w.y = pk2(r[2], r[3]);
              *(uint2*)(op + rt * 16) = w;
            }
          }
        }
        if (wave == 0 && lane == 0) *QW = nxt;
        __syncthreads();
        tkt = __builtin_amdgcn_readfirstlane(*QW);
      }
      {
        const float* psc = p.in[10] + (size_t)l * 1024;
        const int ntiles = 4 * NMT;
        for (int t = bid; t < ntiles; t += G) {
          const int g = t / NMT, pm = t % NMT;
          auto epi8 = [&](int row, int col, f32x4 a, f32x4 b) {
            const float4 sa = *(const float4*)(psc + g * 256 + col), sb = *(const float4*)(psc + g * 256 + col + 4);
            uint4 o; o.x = pk2(a[0] * sa.x, a[1] * sa.y); o.y = pk2(a[2] * sa.z, a[3] * sa.w); o.z = pk2(b[0] * sb.x, b[1] * sb.y); o.w = pk2(b[2] * sb.z, b[3] * sb.w);
            *(uint4*)(YP2 + (size_t)row * 1024 + g * 256 + col) = o;
          };
          gemm_tile(YPOOL + g * 256, 1024, WPOOL + (size_t)g * 65536, 256, pm * 256, 0, 256, epi8, wave_s);
        }
        int tid2 = wave_s * 64 + lane_id();
        asm volatile("" : "+v"(tid2));
        const int lane2 = tid2 & 63, gw2 = bid * 8 + (tid2 >> 6);
        for (int task = gw2; task < 4 * 16; task += NGW) {
          const int g = task >> 4, ct = task & 15;
          auto epi = [&](int row, int col, f32x4 v) {
            const float4 sc = *(const float4*)(psc + g * 256 + col);
            uint2 o; o.x = pk2(v[0] * sc.x, v[1] * sc.y); o.y = pk2(v[2] * sc.z, v[3] * sc.w);
            *(uint2*)(YP2 + (size_t)row * 1024 + g * 256 + col) = o;
          };
          tail_tile1(YPOOL + (size_t)TAIL0 * 1024 + g * 256, 1024, WPOOL + (size_t)g * 65536, 256, ct, 256, lane2, epi);
        }
      }
    }
    xcd_barrier(xbar, wave_s);

    {
      PHASE_PTRS
      auto epib = [&](int row, int col, f32x4 v) {
        const uint2 raw = *(const uint2*)(PROJ + (size_t)row * NINP + C_GB + col);
        f32x4 o;
        o[0] = sigmoidf(bf2f(raw.x & 0xffff)) * v[0]; o[1] = sigmoidf(bf2f(raw.x >> 16)) * v[1];
        o[2] = sigmoidf(bf2f(raw.y & 0xffff)) * v[2]; o[3] = sigmoidf(bf2f(raw.y >> 16)) * v[3];
        *(f32x4*)(MB + (size_t)row * D + col) = o;
      };
      auto epib8 = [&](int row, int col, f32x4 a, f32x4 b) {
        const uint4 raw = *(const uint4*)(PROJ + (size_t)row * NINP + C_GB + col);
        f32x4 oa, ob;
        oa[0] = sigmoidf(bf2f(raw.x & 0xffff)) * a[0]; oa[1] = sigmoidf(bf2f(raw.x >> 16)) * a[1];
        oa[2] = sigmoidf(bf2f(raw.y & 0xffff)) * a[2]; oa[3] = sigmoidf(bf2f(raw.y >> 16)) * a[3];
        ob[0] = sigmoidf(bf2f(raw.z & 0xffff)) * b[0]; ob[1] = sigmoidf(bf2f(raw.z >> 16)) * b[1];
        ob[2] = sigmoidf(bf2f(raw.w & 0xffff)) * b[2]; ob[3] = sigmoidf(bf2f(raw.w >> 16)) * b[3];
        f32x4* mp = (f32x4*)(MB + (size_t)row * D + col);
        mp[0] = oa; mp[1] = ob;
      };
      const int n1 = 16 * NMT, n2 = NMT * 8;
      for (int t = bid; t < n1 + n2; t += G) {
        if (t < n1) {
          const int h = t / NMT, pm = t % NMT;
          auto epi8 = [&](int row, int col, f32x4 a, f32x4 b) {
            if (col < 128) {
              uint4 o; o.x = pk2(a[0], a[1]); o.y = pk2(a[2], a[3]); o.z = pk2(b[0], b[1]); o.w = pk2(b[2], b[3]);
              *(uint4*)(OB + (size_t)row * D + h * 128 + col) = o;
            }
          };
          gemm_tile(OLAT + h * 256, 4096, WUV + (size_t)h * 65536, 256, pm * 256, 0, 256, epi8, wave_s);
        } else {
          int pm, pn; tile_map(t - n1, NMT, 8, pm, pn);
          gemm_tile(YP2, 1024, WPO, 1024, pm * 256, pn * 256, 1024, epib8, wave_s);
        }
      }
      int tid2 = wave_s * 64 + lane_id();
      asm volatile("" : "+v"(tid2));
      const int lane2 = tid2 & 63, gw2 = bid * 8 + (tid2 >> 6);
      for (int task = gw2; task < 16 * 8; task += NGW) {
        const int h = task >> 3, ct = task & 7;
        auto epi = [&](int row, int col, f32x4 v) {
          uint2 o; o.x = pk2(v[0], v[1]); o.y = pk2(v[2], v[3]);
          *(uint2*)(OB + (size_t)row * D + h * 128 + col) = o;
        };
        tail_tile1(OLAT + (size_t)TAIL0 * 4096 + h * 256, 4096, WUV + (size_t)h * 65536, 256, ct, 256, lane2, epi);
      }
      tail_gemm8(YP2 + (size_t)TAIL0 * 1024, 1024, WPO, 1024, D / 16, 1024, epib, wave_s);
    }
    xcd_barrier(xbar, wave_s);

    {
      PHASE_PTRS
      auto epi = [&](int row, int col, f32x4 v) {
        const uint2 raw = *(const uint2*)(PROJ + (size_t)row * NINP + C_GA + col);
        const f32x4 mb = *(const f32x4*)(MB + (size_t)row * D + col);
        uint2 o;
        o.x = pk2(sigmoidf(bf2f(raw.x & 0xffff)) * v[0] + mb[0], sigmoidf(bf2f(raw.x >> 16)) * v[1] + mb[1]);
        o.y = pk2(sigmoidf(bf2f(raw.y & 0xffff)) * v[2] + mb[2], sigmoidf(bf2f(raw.y >> 16)) * v[3] + mb[3]);
        *(uint2*)(MERGED + (size_t)row * D + col) = o;
      };
      auto epi8 = [&](int row, int col, f32x4 a, f32x4 b) {
        const uint4 raw = *(const uint4*)(PROJ + (size_t)row * NINP + C_GA + col);
        const f32x4* mp = (const f32x4*)(MB + (size_t)row * D + col);
        const f32x4 ma = mp[0], mb = mp[1];
        uint4 o;
        o.x = pk2(sigmoidf(bf2f(raw.x & 0xffff)) * a[0] + ma[0], sigmoidf(bf2f(raw.x >> 16)) * a[1] + ma[1]);
        o.y = pk2(sigmoidf(bf2f(raw.y & 0xffff)) * a[2] + ma[2], sigmoidf(bf2f(raw.y >> 16)) * a[3] + ma[3]);
        o.z = pk2(sigmoidf(bf2f(raw.z & 0xffff)) * b[0] + mb[0], sigmoidf(bf2f(raw.z >> 16)) * b[1] + mb[1]);
        o.w = pk2(sigmoidf(bf2f(raw.w & 0xffff)) * b[2] + mb[2], sigmoidf(bf2f(raw.w >> 16)) * b[3] + mb[3]);
        *(uint4*)(MERGED + (size_t)row * D + col) = o;
      };
      for (int t = bid; t < NMT * 8; t += G) {
        int pm, pn; tile_map(t, NMT, 8, pm, pn);
        gemm_tile(OB, D, WAO, D, pm * 256, pn * 256, D, epi8, wave_s);
      }
      tail_gemm8(OB + (size_t)TAIL0 * D, D, WAO, D, D / 16, D, epi, wave_s);
    }
    xcd_barrier(xbar, wave_s);

    {
      PHASE_PTRS
      auto epi = [&](int row, int col, f32x4 v) {
        f32x4* hp = (f32x4*)(HRES + (size_t)row * D + col);
        *hp = *hp + v;
      };
      auto epi8 = [&](int row, int col, f32x4 a, f32x4 b) {
        f32x4* hp = (f32x4*)(HRES + (size_t)row * D + col);
        const f32x4 ha = hp[0], hb = hp[1];
        hp[0] = ha + a; hp[1] = hb + b;
      };
      for (int t = bid; t < NMT * 8; t += G) {
        int pm, pn; tile_map(t, NMT, 8, pm, pn);
        gemm_tile(MERGED, D, WOUT, D, pm * 256, pn * 256, D, epi8, wave_s);
      }
      tail_gemm8(MERGED + (size_t)TAIL0 * D, D, WOUT, D, D / 16, D, epi, wave_s);
    }
    xcd_barrier(xbar, wave_s);

    {
      PHASE_IDS
      rmsnorm_rows(HRES, p.in[13] + (size_t)l * D, HN, gw, NGW, lane);
    }
    xcd_barrier(xbar, wave_s);

    for (int rep = 0; rep < REP_P9; ++rep) {
      PHASE_PTRS
      auto epi = [&](int row, int col, f32x4 v) {
        float a0 = fmaxf(v[0], 0.f), a1 = fmaxf(v[1], 0.f), a2 = fmaxf(v[2], 0.f), a3 = fmaxf(v[3], 0.f);
        uint2 o; o.x = pk2(a0 * a0, a1 * a1); o.y = pk2(a2 * a2, a3 * a3);
        *(uint2*)(UB + (size_t)row * DFF + col) = o;
      };
      auto epi8 = [&](int row, int col, f32x4 a, f32x4 b) {
        const float a0 = fmaxf(a[0], 0.f), a1 = fmaxf(a[1], 0.f), a2 = fmaxf(a[2], 0.f), a3 = fmaxf(a[3], 0.f);
        const float b0 = fmaxf(b[0], 0.f), b1 = fmaxf(b[1], 0.f), b2 = fmaxf(b[2], 0.f), b3 = fmaxf(b[3], 0.f);
        uint4 o; o.x = pk2(a0 * a0, a1 * a1); o.y = pk2(a2 * a2, a3 * a3); o.z = pk2(b0 * b0, b1 * b1); o.w = pk2(b2 * b2, b3 * b3);
        *(uint4*)(UB + (size_t)row * DFF + col) = o;
      };
      const int nN = DFF / 256, ntiles = NMT * nN;
      for (int t = bid; t < ntiles; t += G) {
        int pm, pn; tile_map(t, NMT, nN, pm, pn);
        gemm_tile(HN, D, WMI, D, pm * 256, pn * 256, D, epi8, wave_s);
      }
      tail_gemm8(HN + (size_t)TAIL0 * D, D, WMI, D, DFF / 16, D, epi, wave_s);
    }
    xcd_barrier(xbar, wave_s);

    {
      PHASE_PTRS
      auto epi = [&](int row, int col, f32x4 v) {
        f32x4* hp = (f32x4*)(HRES + (size_t)row * D + col);
        *hp = *hp + v;
      };
      auto epi8 = [&](int row, int col, f32x4 a, f32x4 b) {
        f32x4* hp = (f32x4*)(HRES + (size_t)row * D + col);
        const f32x4 ha = hp[0], hb = hp[1];
        hp[0] = ha + a; hp[1] = hb + b;
      };
      for (int t = bid; t < NMT * 8; t += G) {
        int pm, pn; tile_map(t, NMT, 8, pm, pn);
        gemm_tile(UB, DFF, WMO, DFF, pm * 256, pn * 256, DFF, epi8, wave_s);
      }
      tail_gemm8(UB + (size_t)TAIL0 * DFF, DFF, WMO, DFF, D / 16, DFF, epi, wave_s);
    }
    xcd_barrier(xbar, wave_s);
  }

  {
    BLOCK_IDS
    PHASE_IDS
    const float* g = p.in[16];
    for (int r0 = gw; r0 < SEQ; r0 += NGW) {
      const int r = r0 + NMETA;
      float4 v[8];
      float s = 0.f;
#pragma unroll
      for (int j = 0; j < 8; ++j) {
        v[j] = *(const float4*)(HRES + (size_t)r * D + j * 256 + lane * 4);
        s += v[j].x * v[j].x + v[j].y * v[j].y + v[j].z * v[j].z + v[j].w * v[j].w;
      }
      s = wave_sum(s, lane);
      const float rs = rsqrtf(s * (1.0f / D) + 1e-6f);
#pragma unroll
      for (int j = 0; j < 8; ++j) {
        const float4 gg = *(const float4*)(g + j * 256 + lane * 4);
        __builtin_nontemporal_store((f32x4){v[j].x * rs * gg.x, v[j].y * rs * gg.y, v[j].z * rs * gg.z, v[j].w * rs * gg.w}, (f32x4*)(p.out + (size_t)r0 * D + j * 256 + lane * 4));
      }
    }
  }
}

extern "C" void kernel_launch(void* const* d_in, const int* in_sizes, int n_in, void* d_out, int out_size,
                              void* d_ws, size_t ws_size, hipStream_t stream) {
  static int grid_blocks = 0;
  if (!grid_blocks) {
    int dev = 0, cus = 0, per_cu = 0;
    (void)hipGetDevice(&dev);
    (void)hipDeviceGetAttribute(&cus, hipDeviceAttributeMultiprocessorCount, dev);
    (void)hipFuncSetAttribute((const void*)fwd, hipFuncAttributeMaxDynamicSharedMemorySize, LDS_BYTES);
    (void)hipOccupancyMaxActiveBlocksPerMultiprocessor(&per_cu, (const void*)fwd, 512, LDS_BYTES);
    (void)hipGetLastError();
    grid_blocks = cus > 0 ? cus : 256;
    if (ws_size < WS_END) { fprintf(stderr, "workspace too small: %zu < %zu\n", ws_size, (size_t)WS_END); grid_blocks = -1; }
  }
  if (grid_blocks < 0) return;
  Params p{};
  for (int i = 0; i < 17; ++i) p.in[i] = (const float*)d_in[i];
  p.out = (float*)d_out;
  p.ws = (unsigned char*)d_ws;
  (void)hipMemsetAsync((unsigned char*)d_ws + OFF_BAR, 0, BAR_BYTES, stream);
  void* args[] = {&p};
  hipError_t e = hipLaunchCooperativeKernel((void*)fwd, dim3(grid_blocks), dim3(512), args, LDS_BYTES, stream);
  if (e != hipSuccess) fprintf(stderr, "cooperative launch failed: %s (grid %d)\n", hipGetErrorString(e), grid_blocks);
}
```

```cpp
#include <hip/hip_runtime.h>
#include <hip/hip_bf16.h>
#include <hip/hip_cooperative_groups.h>
#include <cstdio>
#include <type_traits>
namespace cg = cooperative_groups;

typedef unsigned short bf16_t;
typedef short bf16x8 __attribute__((ext_vector_type(8)));
typedef float f32x4 __attribute__((ext_vector_type(4)));
typedef float f32x16 __attribute__((ext_vector_type(16)));
typedef unsigned short u16x4 __attribute__((ext_vector_type(4)));
typedef unsigned u32x4 __attribute__((ext_vector_type(4)));

constexpr int D = 2048, SEQ = 8192, NMETA = 16, NKEYS = SEQ + NMETA, MP = 8448, DEPTH = 4;
constexpr int NIN = 8008, NINP = 8192, DFF = 8192;
constexpr int C_CKV = 2048, C_QIDX = 2304, C_KIDX = 2816, C_WIDX = 2880, C_PIN = 2888, C_GA = 3912, C_GB = 5960;
constexpr int NMT = 32;
constexpr int TAIL0 = 8192;

constexpr size_t SZ_HRES = (size_t)MP * D * 4, SZ_HN = (size_t)MP * D * 2, SZ_PROJ = (size_t)MP * NINP * 2;
constexpr size_t OFF_HRES = 0;
constexpr size_t OFF_HN = OFF_HRES + SZ_HRES;
constexpr size_t OFF_PROJ = OFF_HN + SZ_HN;
constexpr size_t OFF_CKV = OFF_PROJ + SZ_PROJ;
constexpr size_t OFF_KIDX = OFF_CKV + (size_t)MP * 256 * 2;
constexpr size_t OFF_YPOOL = OFF_KIDX + (size_t)MP * 64 * 2;
constexpr size_t OFF_YP2 = OFF_YPOOL + (size_t)MP * 1024 * 2;
constexpr size_t OFF_QLAT = OFF_YP2 + (size_t)MP * 1024 * 2;
constexpr size_t OFF_OLAT = OFF_QLAT + (size_t)MP * 4096 * 2;
constexpr size_t OFF_O = OFF_OLAT + (size_t)MP * 4096 * 2;
constexpr size_t OFF_MB = OFF_O + (size_t)MP * D * 2;
constexpr size_t OFF_MERGED = OFF_MB + (size_t)MP * D * 4;
constexpr size_t OFF_WIN = OFF_MERGED + (size_t)MP * D * 2;
constexpr size_t OFF_WUK = OFF_WIN + (size_t)NINP * D * 2;
constexpr size_t OFF_WUV = OFF_WUK + (size_t)16 * 256 * 256 * 2;
constexpr size_t OFF_WAO = OFF_WUV + (size_t)16 * 256 * 256 * 2;
constexpr size_t OFF_WPOOL = OFF_WAO + (size_t)D * D * 2;
constexpr size_t OFF_WPO = OFF_WPOOL + (size_t)4 * 256 * 256 * 2;
constexpr size_t OFF_WOUT = OFF_WPO + (size_t)D * 1024 * 2;
constexpr size_t OFF_WMI = OFF_WOUT + (size_t)D * D * 2;
constexpr size_t OFF_WMO = OFF_WMI + (size_t)DFF * D * 2;
constexpr size_t OFF_BAR = OFF_WMO + (size_t)D * DFF * 2;
constexpr size_t BAR_BYTES = 16384;
constexpr size_t WS_END = OFF_BAR + BAR_BYTES;

constexpr int SCLD = 8448;
constexpr int ST_LD = 272;
constexpr int LDS_SC_BYTES = 4 * SCLD * 4;
constexpr int LDS_IDX_OFF = (8 * 32 * ST_LD * 2 > LDS_SC_BYTES) ? 8 * 32 * ST_LD * 2 : LDS_SC_BYTES;
constexpr int CAND_CAP = 1024;
constexpr int LDS_CAND_OFF = LDS_IDX_OFF + 4 * 256 * 4;
constexpr int LDS_XB_OFF = LDS_CAND_OFF + 4 * CAND_CAP * 4;
constexpr int LDS_XCH_OFF = LDS_XB_OFF + 16;
constexpr int CAND_CAP2 = CAND_CAP / 2;
constexpr int LDS_BYTES = LDS_XCH_OFF + 144;

#ifndef REP_P1
#define REP_P1 1
#endif
#ifndef REP_P4
#define REP_P4 1
#endif
#ifndef REP_SC
#define REP_SC 1
#endif
#ifndef REP_SEL
#define REP_SEL 1
#endif
#ifndef REP_ATT
#define REP_ATT 1
#endif
#ifndef REP_P9
#define REP_P9 1
#endif
struct Params {
  const float* in[17];
  float* out;
  unsigned char* ws;
};

__device__ __forceinline__ unsigned short f2bf(float f) {
  unsigned u = __float_as_uint(f);
  u += 0x7FFFu + ((u >> 16) & 1u);
  return (unsigned short)(u >> 16);
}
__device__ __forceinline__ float bf2f(unsigned short h) { return __uint_as_float(((unsigned)h) << 16); }
typedef float f32x2_t __attribute__((ext_vector_type(2)));
typedef __bf16 bf16x2_t __attribute__((ext_vector_type(2)));
__device__ __forceinline__ unsigned pk2(float a, float b) { const f32x2_t f = {a, b}; return __builtin_bit_cast(unsigned, __builtin_convertvector(f, bf16x2_t)); }
__device__ __forceinline__ float shx(float v, int o, int lane) { return __int_as_float(__builtin_amdgcn_ds_bpermute((lane ^ o) << 2, __float_as_int(v))); }
__device__ __forceinline__ int shxi(int v, int o, int lane) { return __builtin_amdgcn_ds_bpermute((lane ^ o) << 2, v); }
__device__ __forceinline__ float wave_sum(float v, int lane) {
#pragma unroll
  for (int o = 1; o < 64; o <<= 1) v += shx(v, o, lane);
  return v;
}
__device__ __forceinline__ int lane_id() { return (int)__builtin_amdgcn_mbcnt_hi(~0u, __builtin_amdgcn_mbcnt_lo(~0u, 0u)); }
__device__ __forceinline__ float sigmoidf(float x) { return __builtin_amdgcn_rcpf(1.0f + __builtin_amdgcn_exp2f(-1.4426950408889634f * x)); }

constexpr int BM = 256, BK = 64, HALF = 128, HT = HALF * BK;
__device__ __forceinline__ int lds_byte(int r, int c) {
  int st = (r >> 4) * 2 + (c >> 5), rr = r & 15, cc = c & 31, ob = rr * 64 + cc * 2;
  return st * 1024 + (ob ^ (((ob >> 9) & 1) << 5));
}
__device__ __forceinline__ void stage_rc(int b, int& R, int& C) {
  int st = b / 1024, sb = b % 1024, swz = sb ^ (((sb >> 9) & 1) << 5);
  R = (st >> 1) * 16 + swz / 64;
  C = (st & 1) * 32 + (swz % 64) / 2;
}

template <class Epi>
__device__ __forceinline__ void gemm_tile(const bf16_t* __restrict__ A, const int lda, const bf16_t* __restrict__ Bt, const int ldb,
                                          const int brow, const int bcol, const int K, const Epi& epi, const int wave_s) {
  extern __shared__ __attribute__((aligned(16))) bf16_t shm[];
#define SA(b, h) (shm + ((b) * 2 + (h)) * HT)
#define SB(b, h) (shm + (4 + (b) * 2 + (h)) * HT)
#define STAGE_A(P, br, kt)                                                                                                   \
  do {                                                                                                                       \
    const bf16_t* _g = A + (long)(br) * lda + (long)(kt) * BK;                                                               \
    __builtin_amdgcn_global_load_lds((const unsigned*)(_g + aoff0), (unsigned*)((char*)(P) + sb0), 16, 0, 0);               \
    __builtin_amdgcn_global_load_lds((const unsigned*)(_g + aoff1), (unsigned*)((char*)(P) + sb1), 16, 0, 0);               \
  } while (0)
#define STAGE_B(P, br, kt)                                                                                                   \
  do {                                                                                                                       \
    const bf16_t* _g = Bt + (long)(br) * ldb + (long)(kt) * BK;                                                              \
    __builtin_amdgcn_global_load_lds((const unsigned*)(_g + boff0), (unsigned*)((char*)(P) + sb0), 16, 0, 0);               \
    __builtin_amdgcn_global_load_lds((const unsigned*)(_g + boff1), (unsigned*)((char*)(P) + sb1), 16, 0, 0);               \
  } while (0)
#define LDA(dst, b, h)                                                                                                       \
  for (int m = 0; m < 4; ++m)                                                                                                \
    for (int k = 0; k < 2; ++k) dst[m][k] = *reinterpret_cast<const bf16x8*>((char*)SA(b, h) + lds_byte(wr * 64 + m * 16 + fr, k * 32 + fq * 8))
#define LDB(dst, b, h)                                                                                                       \
  for (int n = 0; n < 2; ++n)                                                                                                \
    for (int k = 0; k < 2; ++k) dst[n][k] = *reinterpret_cast<const bf16x8*>((char*)SB(b, h) + lds_byte(wc * 32 + n * 16 + fr, k * 32 + fq * 8))
#define MMA(ai, bj, At_, Bt_)                                                                                                \
  do {                                                                                                                       \
    __builtin_amdgcn_s_setprio(1);                                                                                           \
    for (int m = 0; m < 4; ++m)                                                                                              \
      for (int n = 0; n < 2; ++n)                                                                                            \
        for (int k = 0; k < 2; ++k)                                                                                          \
          acc[ai][bj][m][n] = __builtin_amdgcn_mfma_f32_16x16x32_bf16(Bt_[n][k], At_[m][k], acc[ai][bj][m][n], 0, 0, 0);    \
    __builtin_amdgcn_s_setprio(0);                                                                                           \
  } while (0)
#define WAIT_V(n) asm volatile("s_waitcnt vmcnt(" #n ")" ::: "memory")
#define WAIT_L(n) asm volatile("s_waitcnt lgkmcnt(" #n ")" ::: "memory")
#define BAR __builtin_amdgcn_s_barrier()
#define SCHED __builtin_amdgcn_sched_barrier(0)

  int tx = wave_s * 64 + lane_id();
  asm volatile("" : "+v"(tx));
  const int wid = tx >> 6, lane = tx & 63, wr = wid >> 2, wc = wid & 3, fr = lane & 15, fq = lane >> 4;
  const int sb0 = tx * 16, sb1 = sb0 + 8192;
  int r0, c0, r1, c1;
  stage_rc(sb0, r0, c0);
  stage_rc(sb1, r1, c1);
  const unsigned aoff0 = (unsigned)(r0 * lda + c0), aoff1 = (unsigned)(r1 * lda + c1);
  const int rp0 = (r0 & ~31) | (8 * ((r0 & 15) >> 2) + 4 * ((r0 >> 4) & 1) + (r0 & 3));
  const int rp1 = (r1 & ~31) | (8 * ((r1 & 15) >> 2) + 4 * ((r1 >> 4) & 1) + (r1 & 3));
  const unsigned boff0 = (unsigned)(rp0 * ldb + c0), boff1 = (unsigned)(rp1 * ldb + c1);
  f32x4 acc[2][2][4][2];
#pragma unroll
  for (int a = 0; a < 2; ++a)
#pragma unroll
    for (int b = 0; b < 2; ++b)
#pragma unroll
      for (int m = 0; m < 4; ++m)
#pragma unroll
        for (int n = 0; n < 2; ++n) acc[a][b][m][n] = (f32x4){0.f, 0.f, 0.f, 0.f};
  bf16x8 At[4][2], B0[2][2], B1[2][2];
  const int nt = K / BK;
  STAGE_B(SB(0, 0), bcol, 0);
  STAGE_A(SA(0, 0), brow, 0);
  STAGE_B(SB(0, 1), bcol + HALF, 0);
  STAGE_A(SA(0, 1), brow + HALF, 0);
  if (wr == 1) BAR;
  WAIT_V(4);
  BAR;
  STAGE_B(SB(1, 0), bcol, 1);
  STAGE_A(SA(1, 0), brow, 1);
  STAGE_B(SB(1, 1), bcol + HALF, 1);
  WAIT_V(6);
  BAR;
  for (int t = 0; t < nt - 2; t += 2) {
    LDB(B0, 0, 0); SCHED; LDA(At, 0, 0); STAGE_A(SA(1, 1), brow + HALF, t + 1);
    WAIT_L(8); BAR; WAIT_L(0); MMA(0, 0, At, B0); BAR; SCHED;
    LDB(B1, 0, 1); STAGE_B(SB(0, 0), bcol, t + 2);
    BAR; WAIT_L(0); MMA(0, 1, At, B1); BAR;
    LDA(At, 0, 1); STAGE_A(SA(0, 0), brow, t + 2);
    BAR; WAIT_L(0); MMA(1, 0, At, B0); BAR; SCHED;
    STAGE_B(SB(0, 1), bcol + HALF, t + 2);
    WAIT_V(6); BAR; MMA(1, 1, At, B1); BAR;
    LDB(B0, 1, 0); SCHED; LDA(At, 1, 0); STAGE_A(SA(0, 1), brow + HALF, t + 2);
    WAIT_L(8); BAR; WAIT_L(0); MMA(0, 0, At, B0); BAR; SCHED;
    LDB(B1, 1, 1); STAGE_B(SB(1, 0), bcol, t + 3);
    BAR; WAIT_L(0); MMA(0, 1, At, B1); BAR;
    LDA(At, 1, 1); STAGE_A(SA(1, 0), brow, t + 3);
    BAR; WAIT_L(0); MMA(1, 0, At, B0); BAR; SCHED;
    STAGE_B(SB(1, 1), bcol + HALF, t + 3);
    WAIT_V(6); BAR; MMA(1, 1, At, B1); BAR;
  }
  {
    LDB(B0, 0, 0); LDA(At, 0, 0); STAGE_A(SA(1, 1), brow + HALF, nt - 1);
    BAR; WAIT_L(0); MMA(0, 0, At, B0); BAR;
    LDB(B1, 0, 1); BAR; WAIT_L(0); MMA(0, 1, At, B1); BAR;
    LDA(At, 0, 1); WAIT_V(4); BAR; WAIT_L(0); MMA(1, 0, At, B0); MMA(1, 1, At, B1); BAR;
  }
  {
    LDB(B0, 1, 0); LDA(At, 1, 0); WAIT_V(2); BAR; WAIT_L(0); MMA(0, 0, At, B0); BAR;
    LDB(B1, 1, 1); WAIT_V(0); BAR; WAIT_L(0); MMA(0, 1, At, B1); BAR;
    LDA(At, 1, 1); BAR; WAIT_L(0); MMA(1, 0, At, B0); MMA(1, 1, At, B1); BAR;
  }
  if (wr == 0) BAR;
#pragma unroll
  for (int ai = 0; ai < 2; ++ai)
#pragma unroll
    for (int m = 0; m < 4; ++m)
#pragma unroll
      for (int bj = 0; bj < 2; ++bj)
        epi(brow + ai * HALF + wr * 64 + m * 16 + fr, bcol + bj * HALF + wc * 32 + fq * 8, acc[ai][bj][m][0], acc[ai][bj][m][1]);
#undef SA
#undef SB
#undef STAGE_A
#undef STAGE_B
#undef LDA
#undef LDB
#undef MMA
}


template <class Epi>
__device__ __forceinline__ void tail_gemm8(const bf16_t* __restrict__ A, const int lda, const bf16_t* __restrict__ Bt, const int ldb,
                                           const int nct, const int K, const Epi& epi, const int wave_s) {
  extern __shared__ __attribute__((aligned(16))) bf16_t shm[];
  float* red = (float*)shm;
  int tx = wave_s * 64 + lane_id(), bid_ = blockIdx.x;
  asm volatile("" : "+v"(tx), "+s"(bid_));
  const int wave = tx >> 6, lane = tx & 63, fr = lane & 15, fq = lane >> 4;
  const int kw = K >> 3;
  for (int ct = bid_; ct < nct; ct += gridDim.x) {
    const bf16_t* ap = A + (size_t)fr * lda + wave * kw + fq * 8;
    const bf16_t* bp = Bt + (size_t)(ct * 16 + fr) * ldb + wave * kw + fq * 8;
    f32x4 acc = (f32x4){0.f, 0.f, 0.f, 0.f};
#pragma unroll 8
    for (int k = 0; k < kw; k += 32) {
      const bf16x8 a = *(const bf16x8*)(ap + k);
      const bf16x8 b = *(const bf16x8*)(bp + k);
      acc = __builtin_amdgcn_mfma_f32_16x16x32_bf16(b, a, acc, 0, 0, 0);
    }
    *(f32x4*)(red + (wave * 64 + lane) * 4) = acc;
    __syncthreads();
    if (wave == 0) {
      f32x4 sum = acc;
#pragma unroll
      for (int w = 1; w < 8; ++w) sum += *(const f32x4*)(red + (w * 64 + lane) * 4);
      epi(TAIL0 + fr, ct * 16 + fq * 4, sum);
    }
    __syncthreads();
  }
}
template <class Epi>
__device__ __forceinline__ void tail_tile1(const bf16_t* __restrict__ A, const int lda, const bf16_t* __restrict__ Bt, const int ldb,
                                           const int ct, const int K, const int lane, const Epi& epi) {
  const int fr = lane & 15, fq = lane >> 4;
  const bf16_t* ap = A + (size_t)fr * lda + fq * 8;
  const bf16_t* bp = Bt + (size_t)(ct * 16 + fr) * ldb + fq * 8;
  f32x4 acc = (f32x4){0.f, 0.f, 0.f, 0.f};
#pragma unroll 8
  for (int k = 0; k < K; k += 32) {
    const bf16x8 a = *(const bf16x8*)(ap + k);
    const bf16x8 b = *(const bf16x8*)(bp + k);
    acc = __builtin_amdgcn_mfma_f32_16x16x32_bf16(b, a, acc, 0, 0, 0);
  }
  epi(TAIL0 + fr, ct * 16 + fq * 4, acc);
}

__device__ __forceinline__ void tile_map(int wgid, int nM, int nN, int& pm, int& pn) {
  const int nwg = nM * nN, q = nwg / 8, r = nwg % 8, xcd = wgid % 8, off = wgid / 8;
  wgid = (xcd < r ? xcd * (q + 1) : r * (q + 1) + (xcd - r) * q) + off;
  const int nig = 8 * nN, gid = wgid / nig, fm = gid * 8, gsz = (nM - fm) < 8 ? (nM - fm) : 8;
  pm = fm + ((wgid % nig) % gsz);
  pn = (wgid % nig) / gsz;
}


typedef unsigned u32x2 __attribute__((ext_vector_type(2)));
template <int GRP>
__device__ __forceinline__ void pool_group(const bf16_t* __restrict__ PROJ, bf16_t* __restrict__ YPOOL, const int r, const int lane) {
  constexpr int W = 2 << GRP;
  u32x2 raw[W];
#pragma unroll
  for (int i = 0; i < W; ++i) {
    const int t = (r - i) < 0 ? 0 : (r - i);
    raw[i] = *(const u32x2*)(PROJ + (size_t)t * NINP + C_PIN + GRP * 256 + lane * 4);
  }
  float s0 = 0.f, s1 = 0.f, s2 = 0.f, s3 = 0.f;
#pragma unroll
  for (int i = W - 1; i >= 0; --i) {
    if (r - i >= 0) {
      s0 += bf2f(raw[i].x & 0xffff); s1 += bf2f(raw[i].x >> 16); s2 += bf2f(raw[i].y & 0xffff); s3 += bf2f(raw[i].y >> 16);
    }
  }
  const float c0 = bf2f(raw[0].x & 0xffff), c1 = bf2f(raw[0].x >> 16), c2 = bf2f(raw[0].y & 0xffff), c3 = bf2f(raw[0].y >> 16);
  const int cntw = (r + 1) < W ? (r + 1) : W;
  const float inv = 1.0f / (float)cntw;
  uint2 o; o.x = pk2(s0 * inv - c0, s1 * inv - c1); o.y = pk2(s2 * inv - c2, s3 * inv - c3);
  *(uint2*)(YPOOL + (size_t)r * 1024 + GRP * 256 + lane * 4) = o;
}


__device__ __forceinline__ void rmsnorm_rows(const float* __restrict__ HRES, const float* __restrict__ g, bf16_t* __restrict__ HN,
                                             const int gw, const int NGW, const int lane) {
  for (int r = gw; r < NKEYS; r += 2 * NGW) {
    const int r2 = (r + NGW < NKEYS) ? r + NGW : r;
    f32x4 va[8], vb[8];
#pragma unroll
    for (int j = 0; j < 8; ++j) {
      va[j] = *(const f32x4*)(HRES + (size_t)r * D + j * 256 + lane * 4);
      vb[j] = *(const f32x4*)(HRES + (size_t)r2 * D + j * 256 + lane * 4);
    }
    float sa = 0.f, sb = 0.f;
#pragma unroll
    for (int j = 0; j < 8; ++j) {
      sa += va[j][0] * va[j][0] + va[j][1] * va[j][1] + va[j][2] * va[j][2] + va[j][3] * va[j][3];
      sb += vb[j][0] * vb[j][0] + vb[j][1] * vb[j][1] + vb[j][2] * vb[j][2] + vb[j][3] * vb[j][3];
    }
#pragma unroll
    for (int o = 1; o < 64; o <<= 1) { sa += shx(sa, o, lane); sb += shx(sb, o, lane); }
    const float ra = rsqrtf(sa * (1.0f / D) + 1e-6f), rb = rsqrtf(sb * (1.0f / D) + 1e-6f);
#pragma unroll
    for (int j = 0; j < 8; ++j) {
      const f32x4 gg = *(const f32x4*)(g + j * 256 + lane * 4);
      uint2 oa, ob;
      oa.x = pk2(va[j][0] * ra * gg[0], va[j][1] * ra * gg[1]); oa.y = pk2(va[j][2] * ra * gg[2], va[j][3] * ra * gg[3]);
      ob.x = pk2(vb[j][0] * rb * gg[0], vb[j][1] * rb * gg[1]); ob.y = pk2(vb[j][2] * rb * gg[2], vb[j][3] * rb * gg[3]);
      *(uint2*)(HN + (size_t)r * D + j * 256 + lane * 4) = oa;
      *(uint2*)(HN + (size_t)r2 * D + j * 256 + lane * 4) = ob;
    }
  }
}

__device__ __forceinline__ void wconv_T(const float* __restrict__ W, int K, int N, int Npad, bf16_t* __restrict__ WT, int ldt,
                                        int nbatch, size_t strideW, size_t strideWT, float scale, const int wave_s) {
  extern __shared__ __attribute__((aligned(16))) bf16_t shm[];
  float* tile = (float*)shm;
  const int nkb = K / 64, nnb = Npad / 256, per = nkb * nnb, items = per * nbatch;
  int t = wave_s * 64 + lane_id(), bid_ = blockIdx.x;
  asm volatile("" : "+v"(t), "+s"(bid_));
  for (int item = bid_; item < items; item += gridDim.x) {
    const int b = item / per, it = item % per, kb = it % nkb, nb = it / nkb, k0 = kb * 64, n0 = nb * 256;
    const float* Wb = W + (size_t)b * strideW;
    bf16_t* WTb = WT + (size_t)b * strideWT;
    float4 v[8];
#pragma unroll
    for (int i = 0; i < 8; ++i) {
      const int kk = (t >> 4) + 32 * (i & 1), n4 = (t & 15) * 4 + (i >> 1) * 64;
      v[i] = make_float4(0.f, 0.f, 0.f, 0.f);
      if (n0 + n4 < N) {
        const f32x4 w4 = __builtin_nontemporal_load((const f32x4*)(Wb + (size_t)(k0 + kk) * N + n0 + n4));
        v[i] = make_float4(w4[0], w4[1], w4[2], w4[3]);
      }
    }
#pragma unroll
    for (int i = 0; i < 8; ++i) {
      const int kk = (t >> 4) + 32 * (i & 1), c4 = (t & 15) * 4;
      float* tp = tile + (i >> 1) * (64 * 65) + kk * 65 + c4;
      tp[0] = v[i].x; tp[1] = v[i].y; tp[2] = v[i].z; tp[3] = v[i].w;
    }
    __syncthreads();
    {
      const int n = t >> 3, kc = (t & 7) * 8;
#pragma unroll
      for (int sub = 0; sub < 4; ++sub) {
        const float* tp = tile + sub * (64 * 65) + kc * 65 + n;
        uint4 o;
        o.x = pk2(tp[0 * 65] * scale, tp[1 * 65] * scale);
        o.y = pk2(tp[2 * 65] * scale, tp[3 * 65] * scale);
        o.z = pk2(tp[4 * 65] * scale, tp[5 * 65] * scale);
        o.w = pk2(tp[6 * 65] * scale, tp[7 * 65] * scale);
        *(uint4*)(WTb + (size_t)(n0 + sub * 64 + n) * ldt + k0 + kc) = o;
      }
    }
    __syncthreads();
  }
}


#define XB_TMO      128
#define XB_XCNT(j)  (256  + 64 * (j))
#define XB_XSUB(j)  (1280 + 64 * (j))
#define XB_XGEN(j)  (2304 + 64 * (j))
#define XB_TOP      3328
#define XB_TOPGEN   3392
#define XCD_BAR_WORDS 3456
#define XB_SPIN_CAP (1u << 18)
#define LAS __attribute__((address_space(3)))
__device__ __forceinline__ unsigned xb_ld(unsigned* p)              { return __hip_atomic_load(p, __ATOMIC_RELAXED, __HIP_MEMORY_SCOPE_AGENT); }
__device__ __forceinline__ unsigned xb_add(unsigned* p, unsigned v) { return __hip_atomic_fetch_add(p, v, __ATOMIC_RELAXED, __HIP_MEMORY_SCOPE_AGENT); }
__device__ __forceinline__ unsigned xb_xcc_id() { return (unsigned)__builtin_amdgcn_s_getreg((3 << 11) | 20) & 0xFu; }
#define XB_SPIN(cond, bar) do { unsigned _sp = 0; while (cond) { __builtin_amdgcn_s_sleep(1); \
    if ((++_sp & 255u) == 0u) { if (xb_ld(&(bar)[XB_TMO])) break; if (_sp > XB_SPIN_CAP) { atomicAdd(&(bar)[XB_TMO], 1u); break; } } } } while (0)
struct XcdBarrier { unsigned* bar; unsigned x; volatile LAS unsigned* st; };
__device__ __forceinline__ XcdBarrier xcd_barrier_post(unsigned* bar, volatile LAS unsigned* st) {
    XcdBarrier b; b.bar = bar; b.x = xb_xcc_id(); b.st = st;
    if (threadIdx.x == 0) (void)xb_add(&bar[XB_XCNT(b.x)], 1u);
    return b;
}
__device__ __forceinline__ void xcd_barrier_complete(unsigned* bar, unsigned x, unsigned& nloc, unsigned& nx) {
    const unsigned G = gridDim.x * gridDim.y * gridDim.z;
    unsigned sum, cnt, mine, sp = 0u;
    for (;;) {
        sum = 0u; cnt = 0u; mine = 0u;
#pragma unroll
        for (unsigned j = 0; j < 16; ++j) { const unsigned c = xb_ld(&bar[XB_XCNT(j)]); sum += c; cnt += (c > 0u) ? 1u : 0u; mine = (j == x) ? c : mine; }
        if (sum == G) break;
        __builtin_amdgcn_s_sleep(1);
        if ((++sp & 255u) == 0u) { if (xb_ld(&bar[XB_TMO])) break; if (sp > XB_SPIN_CAP) { atomicAdd(&bar[XB_TMO], 1u); break; } }
    }
    nloc = mine > 0u ? mine : 1u; nx = cnt > 0u ? cnt : 1u;
}
__device__ __forceinline__ void xcd_barrier(const XcdBarrier& b, const int wave_s) {
    asm volatile("s_waitcnt vmcnt(0)" ::: "memory");
    __syncthreads();
    if (wave_s == 0 && lane_id() == 0) {
        unsigned* bar = b.bar;
        __builtin_amdgcn_s_waitcnt(0);
        unsigned nloc = b.st[0], nx = b.st[1];
        if (nloc == 0u) { xcd_barrier_complete(bar, b.x, nloc, nx); b.st[0] = nloc; b.st[1] = nx; }
        const unsigned old = xb_add(&bar[XB_XSUB(b.x)], 1u);
        const unsigned gen = old / nloc;
        if (old + 1u == (gen + 1u) * nloc) {
            __builtin_amdgcn_fence(__ATOMIC_RELEASE, "agent");
            asm volatile("s_waitcnt vmcnt(0)" ::: "memory");
            const unsigned og = xb_add(&bar[XB_TOP], 1u);
            const unsigned tg = og / nx;
            if (og + 1u == (tg + 1u) * nx) xb_add(&bar[XB_TOPGEN], 1u);
            else XB_SPIN(xb_ld(&bar[XB_TOPGEN]) == tg, bar);
            __builtin_amdgcn_fence(__ATOMIC_ACQUIRE, "agent");
            xb_add(&bar[XB_XGEN(b.x)], 1u);
            asm volatile("s_waitcnt vmcnt(0)" ::: "memory");
        } else {
            XB_SPIN(xb_ld(&bar[XB_XGEN(b.x)]) == gen, bar);
            __builtin_amdgcn_fence(__ATOMIC_ACQUIRE, "agent");
            asm volatile("s_waitcnt vmcnt(0)" ::: "memory");
        }
    }
    __syncthreads();
}

__global__ void __launch_bounds__(512) fwd(Params p) {
  extern __shared__ __attribute__((aligned(16))) bf16_t shm[];
  cg::grid_group grid = cg::this_grid();
  const int wave_s = __builtin_amdgcn_readfirstlane((int)(threadIdx.x >> 6));
  volatile LAS unsigned* xst = (volatile LAS unsigned*)((LAS char*)shm + LDS_XB_OFF);
  if (threadIdx.x == 0) { xst[0] = 0u; xst[1] = 0u; xst[2] = 0u; xst[3] = 0u; }
  __syncthreads();
  const XcdBarrier xbar = xcd_barrier_post((unsigned*)(p.ws + OFF_BAR), xst);
#define BLOCK_IDS                                   \
  int bid = blockIdx.x, G = gridDim.x;              \
  asm volatile("" : "+s"(bid), "+s"(G));            \
  const int NGW = G * 8; (void)NGW;
#define PHASE_PTRS \
  unsigned long long zo_ = 0; \
  asm volatile("" : "+s"(zo_)); \
  unsigned char* wsb = p.ws + zo_; \
  float* HRES = (float*)(wsb + OFF_HRES); \
  bf16_t* HN = (bf16_t*)(wsb + OFF_HN); \
  bf16_t* PROJ = (bf16_t*)(wsb + OFF_PROJ); \
  bf16_t* CKV = (bf16_t*)(wsb + OFF_CKV); \
  bf16_t* KIDX = (bf16_t*)(wsb + OFF_KIDX); \
  bf16_t* YPOOL = (bf16_t*)(wsb + OFF_YPOOL); \
  bf16_t* YP2 = (bf16_t*)(wsb + OFF_YP2); \
  bf16_t* QLAT = (bf16_t*)(wsb + OFF_QLAT); \
  bf16_t* OLAT = (bf16_t*)(wsb + OFF_OLAT); \
  bf16_t* OB = (bf16_t*)(wsb + OFF_O); \
  float* MB = (float*)(wsb + OFF_MB); \
  bf16_t* MERGED = (bf16_t*)(wsb + OFF_MERGED); \
  bf16_t* WIN = (bf16_t*)(wsb + OFF_WIN); \
  bf16_t* WUK = (bf16_t*)(wsb + OFF_WUK); \
  bf16_t* WUV = (bf16_t*)(wsb + OFF_WUV); \
  bf16_t* WAO = (bf16_t*)(wsb + OFF_WAO); \
  bf16_t* WPOOL = (bf16_t*)(wsb + OFF_WPOOL); \
  bf16_t* WPO = (bf16_t*)(wsb + OFF_WPO); \
  bf16_t* WOUT = (bf16_t*)(wsb + OFF_WOUT); \
  bf16_t* WMI = (bf16_t*)(wsb + OFF_WMI); \
  bf16_t* WMO = (bf16_t*)(wsb + OFF_WMO); \
  bf16_t* UB = PROJ; \
  (void)HRES; (void)HN; (void)CKV; (void)KIDX; (void)YPOOL; (void)YP2; (void)QLAT; (void)OLAT; (void)OB; (void)MB; (void)MERGED; (void)WIN; (void)WUK; (void)WUV; (void)WAO; (void)WPOOL; (void)WPO; (void)WOUT; (void)WMI; (void)WMO; (void)UB;
#define PHASE_IDS                                  \
  int tid = wave_s * 64 + lane_id();               \
  asm volatile("" : "+v"(tid));                    \
  const int wave = tid >> 6, lane = tid & 63, gw = bid * 8 + wave; \
  (void)lane; (void)gw; \
  PHASE_PTRS


#pragma unroll 1
  for (int l = 0; l < DEPTH; ++l) {
    BLOCK_IDS
    for (int rep = 0; rep < REP_P1; ++rep) {
      PHASE_IDS
      if (l == 0) {
        const float* g0 = p.in[2];
        for (int r = gw; r < NKEYS; r += NGW) {
          const float* src = (r < NMETA) ? p.in[1] + (size_t)r * D : p.in[0] + (size_t)(r - NMETA) * D;
          f32x4 v[8];
          float sq = 0.f;
#pragma unroll
          for (int j = 0; j < 8; ++j) {
            v[j] = __builtin_nontemporal_load((const f32x4*)(src + j * 256 + lane * 4));
            sq += v[j][0] * v[j][0] + v[j][1] * v[j][1] + v[j][2] * v[j][2] + v[j][3] * v[j][3];
          }
#pragma unroll
          for (int o = 1; o < 64; o <<= 1) sq += shx(sq, o, lane);
          const float rs = rsqrtf(sq * (1.0f / D) + 1e-6f);
#pragma unroll
          for (int j = 0; j < 8; ++j) {
            *(f32x4*)(HRES + (size_t)r * D + j * 256 + lane * 4) = v[j];
            const f32x4 gg = *(const f32x4*)(g0 + j * 256 + lane * 4);
            uint2 o2;
            o2.x = pk2(v[j][0] * rs * gg[0], v[j][1] * rs * gg[1]); o2.y = pk2(v[j][2] * rs * gg[2], v[j][3] * rs * gg[3]);
            *(uint2*)(HN + (size_t)r * D + j * 256 + lane * 4) = o2;
          }
        }
      } else {
        rmsnorm_rows(HRES, p.in[2] + (size_t)l * D, HN, gw, NGW, lane);
      }
      wconv_T(p.in[3] + (size_t)l * D * NIN, D, NIN, NINP, WIN, D, 1, 0, 0, 1.0f, wave_s);
      wconv_T(p.in[7] + (size_t)l * 16 * 256 * 128, 256, 128, 256, WUV, 256, 16, (size_t)256 * 128, (size_t)65536, 1.0f, wave_s);
      wconv_T(p.in[8] + (size_t)l * D * D, D, D, D, WAO, D, 1, 0, 0, 1.0f, wave_s);
      wconv_T(p.in[9] + (size_t)l * 4 * 65536, 256, 256, 256, WPOOL, 256, 4, (size_t)65536, (size_t)65536, 1.0f, wave_s);
      wconv_T(p.in[11] + (size_t)l * 1024 * D, 1024, D, D, WPO, 1024, 1, 0, 0, 1.0f, wave_s);
      wconv_T(p.in[12] + (size_t)l * D * D, D, D, D, WOUT, D, 1, 0, 0, 1.0f, wave_s);
      wconv_T(p.in[14] + (size_t)l * D * DFF, D, DFF, DFF, WMI, D, 1, 0, 0, 1.0f, wave_s);
      wconv_T(p.in[15] + (size_t)l * DFF * D, DFF, D, D, WMO, DFF, 1, 0, 0, 1.0f, wave_s);
      {
        const float* wuk = p.in[6] + (size_t)l * 16 * 256 * 128;
        const float sc = 0.08838834764831845f * 1.4426950408889634f;
        for (int i = bid * 512 + tid; i < 16 * 256 * 32; i += G * 512) {
          const int row = i >> 5, kc = (i & 31) * 8;
          uint4 o = make_uint4(0u, 0u, 0u, 0u);
          if (kc < 128) {
            const f32x4 a = __builtin_nontemporal_load((const f32x4*)(wuk + (size_t)row * 128 + kc));
            const f32x4 b = __builtin_nontemporal_load((const f32x4*)(wuk + (size_t)row * 128 + kc + 4));
            o.x = pk2(a[0] * sc, a[1] * sc); o.y = pk2(a[2] * sc, a[3] * sc);
            o.z = pk2(b[0] * sc, b[1] * sc); o.w = pk2(b[2] * sc, b[3] * sc);
          }
          *(uint4*)(WUK + (size_t)row * 256 + kc) = o;
        }
      }
    }
    if (l == 0) grid.sync();
    else xcd_barrier(xbar, wave_s);

    {
      PHASE_PTRS
      auto epi = [&](int row, int col, f32x4 v) {
        uint2 o; o.x = pk2(v[0], v[1]); o.y = pk2(v[2], v[3]);
        *(uint2*)(PROJ + (size_t)row * NINP + col) = o;
      };
      auto epi8 = [&](int row, int col, f32x4 a, f32x4 b) {
        uint4 o; o.x = pk2(a[0], a[1]); o.y = pk2(a[2], a[3]); o.z = pk2(b[0], b[1]); o.w = pk2(b[2], b[3]);
        *(uint4*)(PROJ + (size_t)row * NINP + col) = o;
      };
      const int nN = NINP / 256, ntiles = NMT * nN;
      for (int t = bid; t < ntiles; t += G) {
        int pm, pn; tile_map(t, NMT, nN, pm, pn);
        gemm_tile(HN, D, WIN, D, pm * 256, pn * 256, D, epi8, wave_s);
      }
      tail_gemm8(HN + (size_t)TAIL0 * D, D, WIN, D, NINP / 16, D, epi, wave_s);
    }
    xcd_barrier(xbar, wave_s);

    {
      PHASE_IDS
      const float* gkv = p.in[4] + (size_t)l * 256;
      const float* gik = p.in[5] + (size_t)l * 64;
      for (int r = gw; r < NKEYS; r += NGW) {
        const bf16_t* pr = PROJ + (size_t)r * NINP;
        {
          const uint2 raw = *(const uint2*)(pr + C_CKV + lane * 4);
          float a0 = bf2f(raw.x & 0xffff), a1 = bf2f(raw.x >> 16), a2 = bf2f(raw.y & 0xffff), a3 = bf2f(raw.y >> 16);
          float s = wave_sum(a0 * a0 + a1 * a1 + a2 * a2 + a3 * a3, lane);
          const float rs = rsqrtf(s * (1.0f / 256.0f) + 1e-6f);
          const float4 gg = *(const float4*)(gkv + lane * 4);
          uint2 o; o.x = pk2(a0 * rs * gg.x, a1 * rs * gg.y); o.y = pk2(a2 * rs * gg.z, a3 * rs * gg.w);
          *(uint2*)(CKV + (size_t)r * 256 + lane * 4) = o;
        }
        {
          const float a = bf2f(pr[C_KIDX + lane]);
          const float s = wave_sum(a * a, lane);
          const float rs = rsqrtf(s * (1.0f / 64.0f) + 1e-6f);
          KIDX[((size_t)((r >> 5) * 4 + (lane >> 4)) * 64 + ((lane >> 3) & 1) * 32 + (r & 31)) * 8 + (lane & 7)] = f2bf(a * rs * gik[lane]);
        }
        pool_group<0>(PROJ, YPOOL, r, lane);
        pool_group<1>(PROJ, YPOOL, r, lane);
        pool_group<2>(PROJ, YPOOL, r, lane);
        pool_group<3>(PROJ, YPOOL, r, lane);
      }
      const int ntiles = 16 * NMT;
      for (int t = bid; t < ntiles; t += G) {
        const int h = t / NMT, pm = t % NMT;
        auto epi8 = [&](int row, int col, f32x4 a, f32x4 b) {
          uint4 o; o.x = pk2(a[0], a[1]); o.y = pk2(a[2], a[3]); o.z = pk2(b[0], b[1]); o.w = pk2(b[2], b[3]);
          *(uint4*)(QLAT + (size_t)row * 4096 + h * 256 + col) = o;
        };
        gemm_tile(PROJ + h * 128, NINP, WUK + (size_t)h * 65536, 256, pm * 256, 0, 256, epi8, wave_s);
      }
      int tid2 = wave_s * 64 + lane_id();
      asm volatile("" : "+v"(tid2));
      const int lane2 = tid2 & 63, gw2 = bid * 8 + (tid2 >> 6);
      for (int task = gw2; task < 16 * 16; task += NGW) {
        const int h = task >> 4, ct = task & 15;
        auto epi = [&](int row, int col, f32x4 v) {
          uint2 o; o.x = pk2(v[0], v[1]); o.y = pk2(v[2], v[3]);
          *(uint2*)(QLAT + (size_t)row * 4096 + h * 256 + col) = o;
        };
        tail_tile1(PROJ + (size_t)TAIL0 * NINP + h * 128, NINP, WUK + (size_t)h * 65536, 256, ct, 128, lane2, epi);
      }
    }
    xcd_barrier(xbar, wave_s);

    {
      PHASE_IDS
      unsigned* SC = (unsigned*)shm;
      int* IDX = (int*)((char*)shm + LDS_IDX_OFF);
      int* CAND = (int*)((char*)shm + LDS_CAND_OFF);
      const int nunits = NKEYS / 4;
      unsigned* qctr = (unsigned*)(wsb + OFF_BAR) + 3520 + 64 * l;
      volatile int* QW = (volatile int*)((char*)shm + LDS_XCH_OFF) + 32;
      unsigned* HIST = (unsigned*)CAND;
      {
        u32x4* hz = (u32x4*)HIST + tid * 2;
        unsigned z = 0u;
        asm volatile("" : "+v"(z));
        hz[0] = (u32x4){z, z, z, z}; hz[1] = (u32x4){z, z, z, z};
      }
      int tkt;
      {
        if (wave == 0 && lane == 0) *QW = (int)__hip_atomic_fetch_add(qctr, 1u, __ATOMIC_RELAXED, __HIP_MEMORY_SCOPE_AGENT);
        __syncthreads();
        tkt = __builtin_amdgcn_readfirstlane(*QW);
      }
#pragma unroll 1
      while (tkt < nunits) {
        int nxt = 0;
        if (wave == 0 && lane == 0) nxt = (int)__hip_atomic_fetch_add(qctr, 1u, __ATOMIC_RELAXED, __HIP_MEMORY_SCOPE_AGENT);
        const int u = nunits - 1 - tkt;
        int lane_u_ = lane;
        asm volatile("" : "+v"(lane_u_));
        const int lane = lane_u_;
        const int q0 = u * 4;
        const int nk = q0 + 4;
        const int nit = (nk + 255) >> 8;
        const int ntile = nit * 8;
        for (int rsc = 0; rsc < REP_SC; ++rsc) {
          const int r = lane & 31, kg = lane >> 5, qi = r & 3, head = r >> 2;
          bf16x8 qa[4];
          const bf16_t* qp = PROJ + (size_t)(q0 + qi) * NINP + C_QIDX + head * 64 + kg * 8;
#pragma unroll
          for (int ks = 0; ks < 4; ++ks) qa[ks] = *(const bf16x8*)(qp + ks * 16);
          float wv[4][4];
#pragma unroll
          for (int i = 0; i < 4; ++i)
#pragma unroll
            for (int j = 0; j < 4; ++j) wv[i][j] = bf2f(PROJ[(size_t)(q0 + j) * NINP + C_WIDX + 2 * i + kg]);
          const unsigned klane = (unsigned)lane * 8u;
          bf16x8 kbuf[4][4];
#pragma unroll
          for (int pi = 0; pi < 3; ++pi) {
            const int tp = wave_s + 8 * ((pi < nit) ? pi : nit - 1);
#pragma unroll
            for (int ks = 0; ks < 4; ++ks) kbuf[pi][ks] = *(const bf16x8*)(KIDX + (size_t)(tp * 4 + ks) * 512 + klane);
          }
          for (int base = 0; base < nit; base += 4) {
#pragma unroll
            for (int uu = 0; uu < 4; ++uu) {
              const int i = (base + uu < nit) ? base + uu : nit - 1;
              {
                {
                  const int ip = (base + uu + 3 < nit) ? base + uu + 3 : nit - 1;
                  const int tp = wave_s + 8 * ip;
#pragma unroll
                  for (int ks = 0; ks < 4; ++ks) kbuf[(uu + 3) % 4][ks] = *(const bf16x8*)(KIDX + (size_t)(tp * 4 + ks) * 512 + klane);
                }
                if (base + uu < nit) {
                const int tt = wave_s + 8 * i;
                const int key = tt * 32 + r;
                f32x16 acc;
#pragma unroll
                for (int q = 0; q < 16; ++q) acc[q] = 0.f;
#pragma unroll
                for (int ks = 0; ks < 4; ++ks) acc = __builtin_amdgcn_mfma_f32_32x32x16_bf16(qa[ks], kbuf[uu][ks], acc, 0, 0, 0);
#define RELU_(x) __int_as_float(max(__float_as_int(x), 0))
                const float p0 = wv[0][0] * RELU_(acc[0]) + wv[1][0] * RELU_(acc[4]) + wv[2][0] * RELU_(acc[8]) + wv[3][0] * RELU_(acc[12]);
                const float p1 = wv[0][1] * RELU_(acc[1]) + wv[1][1] * RELU_(acc[5]) + wv[2][1] * RELU_(acc[9]) + wv[3][1] * RELU_(acc[13]);
                const float p2 = wv[0][2] * RELU_(acc[2]) + wv[1][2] * RELU_(acc[6]) + wv[2][2] * RELU_(acc[10]) + wv[3][2] * RELU_(acc[14]);
                const float p3 = wv[0][3] * RELU_(acc[3]) + wv[1][3] * RELU_(acc[7]) + wv[2][3] * RELU_(acc[11]) + wv[3][3] * RELU_(acc[15]);
#undef RELU_
                const auto r02 = __builtin_amdgcn_permlane32_swap(__float_as_uint(p0), __float_as_uint(p2), false, false);
                const auto r13 = __builtin_amdgcn_permlane32_swap(__float_as_uint(p1), __float_as_uint(p3), false, false);
                const float sa = __uint_as_float(r02[0]) + __uint_as_float(r02[1]);
                const float sb = __uint_as_float(r13[0]) + __uint_as_float(r13[1]);
#pragma unroll
                for (int jj = 0; jj < 2; ++jj) {
                  const int j = kg * 2 + jj;
                  const float s = (jj ? sb : sa) + 0.0f;
                  unsigned ub = __float_as_uint(s);
                  ub ^= (unsigned)((int)ub >> 31) | 0x80000000u;
                  if (key > q0 + j) ub = 0u;
                  SC[j * SCLD + key] = ub;
                  if (ub != 0u) {
                    const unsigned bin = ub >> 21;
                    __hip_atomic_fetch_add(HIST + j * 1024 + (bin >> 1), 1u << ((bin & 1u) * 16u), __ATOMIC_RELAXED, __HIP_MEMORY_SCOPE_WORKGROUP);
                  }
                }
                }
              }
            }
          }
        }
        __syncthreads();
        for (int rsel = 0; rsel < REP_SEL; ++rsel) {
          const int j = wave & 3, half = wave >> 2, qpos = q0 + j, nvalid = qpos + 1;
          const bool big = nvalid > 256;
          int* idx = IDX + j * 256;
          int* cand = CAND + (j * 2 + half) * CAND_CAP2;
          int* XCH = (int*)((char*)shm + LDS_XCH_OFF);
          const unsigned* sc1 = SC + j * SCLD;
          const uint4* sc4 = (const uint4*)sc1;
          const int nh = (nit + 1) >> 1;
          const int g0 = half ? nh : 0, g1 = half ? nit : nh;
          unsigned prefix = 0u;
          if (big) {
            const u32x4* hq = (const u32x4*)(HIST + j * 1024) + lane * 4;
            const u32x4 w0 = hq[0], w1 = hq[1], w2 = hq[2], w3 = hq[3];
            unsigned cw[16];
#pragma unroll
            for (int q = 0; q < 4; ++q) { cw[q] = w0[q]; cw[4 + q] = w1[q]; cw[8 + q] = w2[q]; cw[12 + q] = w3[q]; }
            int sl = 0;
#pragma unroll
            for (int q = 0; q < 16; ++q) sl += (int)(cw[q] & 0xffffu) + (int)(cw[q] >> 16);
            int S = sl;
#pragma unroll
            for (int o = 1; o < 64; o <<= 1) {
              const int tv = __builtin_amdgcn_ds_bpermute(((lane + o) & 63) << 2, S);
              if (lane + o < 64) S += tv;
            }
            const int L = __popcll(__ballot(S >= 256)) - 1;
            int run = S - sl, found = -1;
#pragma unroll
            for (int bb = 31; bb >= 0; --bb) {
              run += (bb & 1) ? (int)(cw[bb >> 1] >> 16) : (int)(cw[bb >> 1] & 0xffffu);
              if (run >= 256 && found < 0) found = bb;
            }
            const int fb = __builtin_amdgcn_readlane(found, L);
            prefix = (unsigned)(L * 32 + fb) << 21;
          }
          __syncthreads();
          const unsigned P = prefix >> 21;
          int c = 0, m = 0;
          if (big) {
            for (int it = g0 * 4; it < g1 * 4; it += 4) {
              unsigned x[4];
#pragma unroll
              for (int e = 0; e < 4; ++e) x[e] = sc1[(it + e) * 64 + lane];
#pragma unroll
              for (int e = 0; e < 4; ++e) {
                const unsigned t = x[e] >> 21;
                const bool isA = t > P, isB = t == P;
                const unsigned long long mA = __ballot(isA), mB = __ballot(isB);
                const int oA = __builtin_amdgcn_mbcnt_hi((unsigned)(mA >> 32), __builtin_amdgcn_mbcnt_lo((unsigned)mA, 0u));
                const int oB = __builtin_amdgcn_mbcnt_hi((unsigned)(mB >> 32), __builtin_amdgcn_mbcnt_lo((unsigned)mB, 0u));
                if (isA) idx[half ? (255 - (c + oA)) : (c + oA)] = (it + e) * 64 + lane;
                if (isB && (m + oB) < CAND_CAP2) cand[m + oB] = (it + e) * 64 + lane;
                c += __popcll(mA);
                m += __popcll(mB);
              }
            }
          }
          if (lane == 0) { XCH[16 + wave * 2] = c; XCH[16 + wave * 2 + 1] = m; }
          __syncthreads();
          if (half == 0) {
            if (!big) {
              for (int i = lane; i < 256; i += 64) idx[i] = (i < nvalid) ? i : 0;
            } else {
              const int cB = XCH[16 + (wave + 4) * 2], mB = XCH[16 + (wave + 4) * 2 + 1];
              const int mA = m, mt = mA + mB;
              const int* candB = CAND + (j * 2 + 1) * CAND_CAP2;
              if (mA <= CAND_CAP2 && mB <= CAND_CAP2) {
                const int need = 256 - c - cB;
                unsigned T = prefix;
                auto fine = [&](auto KMtag) {
                  constexpr int KM = decltype(KMtag)::value;
                  unsigned cv[KM];
                  int ci[KM];
#pragma unroll
                  for (int k = 0; k < KM; ++k) {
                    const int i = k * 64 + lane;
                    ci[k] = (i < mA) ? cand[i] : ((i < mt) ? candB[i - mA] : 0);
                    cv[k] = (i < mt) ? sc1[ci[k]] : 0u;
                  }
                  for (int bit = 20; bit >= 0; --bit) {
                    const unsigned cd = T | (1u << bit);
                    int cnt = 0;
#pragma unroll
                    for (int k = 0; k < KM; ++k) cnt += __popcll(__ballot(cv[k] >= cd));
                    if (cnt >= need) T = cd;
                  }
                  int pos = c;
#pragma unroll
                  for (int k = 0; k < KM; ++k) {
                    const bool sel = cv[k] > T;
                    const unsigned long long mk = __ballot(sel);
                    const int off = __builtin_amdgcn_mbcnt_hi((unsigned)(mk >> 32), __builtin_amdgcn_mbcnt_lo((unsigned)mk, 0u));
                    if (sel) idx[pos + off] = ci[k];
                    pos += __popcll(mk);
                  }
                  const int lim = 256 - cB;
#pragma unroll
                  for (int k = 0; k < KM; ++k) {
                    const bool sel = cv[k] == T;
                    const unsigned long long mk = __ballot(sel);
                    const int off = __builtin_amdgcn_mbcnt_hi((unsigned)(mk >> 32), __builtin_amdgcn_mbcnt_lo((unsigned)mk, 0u));
                    if (sel && (pos + off) < lim) idx[pos + off] = ci[k];
                    pos += __popcll(mk);
                  }
                };
                if (mt <= 256) fine(std::integral_constant<int, 4>{});
                else fine(std::integral_constant<int, (2 * CAND_CAP2) / 64>{});
              } else {
                unsigned pf = 0u;
                for (int bit = 31; bit >= 0; --bit) {
                  const unsigned cd = pf | (1u << bit);
                  int cnt = 0;
                  for (int it = 0; it < nit; ++it) {
                    const uint4 v = sc4[it * 64 + lane];
                    cnt += __popcll(__ballot(v.x >= cd)) + __popcll(__ballot(v.y >= cd)) + __popcll(__ballot(v.z >= cd)) + __popcll(__ballot(v.w >= cd));
                  }
                  if (cnt >= 256) pf = cd;
                }
                const unsigned T = pf;
                int c2 = 0;
                const int nit64 = nit * 4;
                for (int it = 0; it < nit64; ++it) {
                  const unsigned x = sc1[it * 64 + lane];
                  const bool sel = x > T;
                  const unsigned long long mask = __ballot(sel);
                  const int off = __builtin_amdgcn_mbcnt_hi((unsigned)(mask >> 32), __builtin_amdgcn_mbcnt_lo((unsigned)mask, 0u));
                  if (sel) idx[c2 + off] = it * 64 + lane;
                  c2 += __popcll(mask);
                }
                for (int it = 0; it < nit64 && c2 < 256; ++it) {
                  const unsigned x = sc1[it * 64 + lane];
                  const bool sel = x == T;
                  const unsigned long long mask = __ballot(sel);
                  const int off = __builtin_amdgcn_mbcnt_hi((unsigned)(mask >> 32), __builtin_amdgcn_mbcnt_lo((unsigned)mask, 0u));
                  if (sel && (c2 + off) < 256) idx[c2 + off] = it * 64 + lane;
                  c2 += __popcll(mask);
                }
              }
            }
          }
          if (rsel + 1 < REP_SEL) __syncthreads();
        }
        __syncthreads();
        {
          u32x4* hz = (u32x4*)HIST + (wave * 64 + lane) * 2;
          unsigned z = 0u;
          asm volatile("" : "+v"(z));
          hz[0] = (u32x4){z, z, z, z}; hz[1] = (u32x4){z, z, z, z};
        }
        for (int ratt = 0; ratt < REP_ATT; ++ratt) {
          if (ratt) __syncthreads();
          const int j = wave & 3, half = wave >> 2, qpos = q0 + j;
          const int nsel = (qpos + 1) < 256 ? (qpos + 1) : 256;
          const int* idx = IDX + j * 256;
          bf16_t* ST = (bf16_t*)((char*)shm + wave * (32 * ST_LD * 2));
          float* XF = (float*)ST;
          const int fr = lane & 15, fq = lane >> 4;
          bf16x8 qb[8];
          const bf16_t* qlp = QLAT + (size_t)qpos * 4096 + fr * 256 + fq * 8;
#pragma unroll
          for (int ks = 0; ks < 8; ++ks) qb[ks] = *(const bf16x8*)(qlp + ks * 32);
          f32x4 o[16];
#pragma unroll
          for (int i = 0; i < 16; ++i) o[i] = (f32x4){0.f, 0.f, 0.f, 0.f};
          float mrun = -INFINITY, lrun = 0.f;
          const int nchunk = (nsel + 31) >> 5, nfirst = (nchunk + 1) >> 1;
          const int cb = half ? nfirst : 0, ce = half ? nchunk : nfirst;
          const unsigned st_base = (unsigned)(size_t)(__attribute__((address_space(3))) char*)ST;
          const unsigned tr_addr = st_base + (unsigned)(((fq * 4 + (fr >> 2)) * ST_LD + (fr & 3) * 4) * 2);
          bf16x8 ar[2][8];
          {
            const int c0 = (cb < ce) ? cb : 0;
#pragma unroll
            for (int tt = 0; tt < 2; ++tt) {
              const bf16_t* kr = CKV + (size_t)idx[c0 * 32 + tt * 16 + fr] * 256 + fq * 8;
#pragma unroll
              for (int ks = 0; ks < 8; ++ks) ar[tt][ks] = *(const bf16x8*)(kr + ks * 32);
            }
          }
          for (int ch = cb; ch < ce; ++ch) {
            f32x4 s[2];
#pragma unroll
            for (int tt = 0; tt < 2; ++tt) {
              s[tt] = (f32x4){0.f, 0.f, 0.f, 0.f};
#pragma unroll
              for (int ks = 0; ks < 8; ++ks) s[tt] = __builtin_amdgcn_mfma_f32_16x16x32_bf16(ar[tt][ks], qb[ks], s[tt], 0, 0, 0);
            }
#pragma unroll
            for (int tt = 0; tt < 2; ++tt)
#pragma unroll
              for (int ks = 0; ks < 8; ++ks) *(bf16x8*)(ST + (tt * 16 + fr) * ST_LD + ks * 32 + fq * 8) = ar[tt][ks];
            asm volatile("s_waitcnt lgkmcnt(0)" ::: "memory");
            __builtin_amdgcn_wave_barrier();
            {
              const int cn = (ch + 1 < ce) ? ch + 1 : ch;
#pragma unroll
              for (int tt = 0; tt < 2; ++tt) {
                const bf16_t* kr = CKV + (size_t)idx[cn * 32 + tt * 16 + fr] * 256 + fq * 8;
#pragma unroll
                for (int ks = 0; ks < 8; ++ks) ar[tt][ks] = *(const bf16x8*)(kr + ks * 32);
              }
            }
            if (nsel < 256) {
#pragma unroll
              for (int tt = 0; tt < 2; ++tt)
#pragma unroll
                for (int e = 0; e < 4; ++e)
                  if (ch * 32 + tt * 16 + fq * 4 + e >= nsel) s[tt][e] = -INFINITY;
            }
            float mx = fmaxf(fmaxf(fmaxf(s[0][0], s[0][1]), fmaxf(s[0][2], s[0][3])), fmaxf(fmaxf(s[1][0], s[1][1]), fmaxf(s[1][2], s[1][3])));
            mx = fmaxf(mx, shx(mx, 16, lane));
            mx = fmaxf(mx, shx(mx, 32, lane));
            const float mnew = fmaxf(mrun, mx);
            const float alpha = __builtin_amdgcn_exp2f(mrun - mnew);
            float ps = 0.f;
            float pv[8];
#pragma unroll
            for (int tt = 0; tt < 2; ++tt)
#pragma unroll
              for (int e = 0; e < 4; ++e) {
                const float pe = __builtin_amdgcn_exp2f(s[tt][e] - mnew);
                pv[tt * 4 + e] = pe;
                ps += pe;
              }
            ps += shx(ps, 16, lane);
            ps += shx(ps, 32, lane);
            lrun = lrun * alpha + ps;
            mrun = mnew;
            union { bf16x8 v; unsigned u[4]; } pb;
            pb.u[0] = pk2(pv[0], pv[1]); pb.u[1] = pk2(pv[2], pv[3]); pb.u[2] = pk2(pv[4], pv[5]); pb.u[3] = pk2(pv[6], pv[7]);
#pragma unroll
            for (int rt = 0; rt < 16; ++rt) o[rt] *= alpha;
#pragma unroll
            for (int rb = 0; rb < 4; ++rb) {
              union { bf16x8 v; u16x4 h[2]; } va[4];
              asm volatile(
                  "ds_read_b64_tr_b16 %0, %8 offset:%9\n\t"
                  "ds_read_b64_tr_b16 %1, %8 offset:%10\n\t"
                  "ds_read_b64_tr_b16 %2, %8 offset:%11\n\t"
                  "ds_read_b64_tr_b16 %3, %8 offset:%12\n\t"
                  "ds_read_b64_tr_b16 %4, %8 offset:%13\n\t"
                  "ds_read_b64_tr_b16 %5, %8 offset:%14\n\t"
                  "ds_read_b64_tr_b16 %6, %8 offset:%15\n\t"
                  "ds_read_b64_tr_b16 %7, %8 offset:%16\n\t"
                  "s_waitcnt lgkmcnt(0)"
                  : "=&v"(va[0].h[0]), "=&v"(va[0].h[1]), "=&v"(va[1].h[0]), "=&v"(va[1].h[1]),
                    "=&v"(va[2].h[0]), "=&v"(va[2].h[1]), "=&v"(va[3].h[0]), "=&v"(va[3].h[1])
                  : "v"(tr_addr),
                    "i"((rb * 4 + 0) * 32), "i"((rb * 4 + 0) * 32 + 16 * ST_LD * 2),
                    "i"((rb * 4 + 1) * 32), "i"((rb * 4 + 1) * 32 + 16 * ST_LD * 2),
                    "i"((rb * 4 + 2) * 32), "i"((rb * 4 + 2) * 32 + 16 * ST_LD * 2),
                    "i"((rb * 4 + 3) * 32), "i"((rb * 4 + 3) * 32 + 16 * ST_LD * 2)
                  : "memory");
#pragma unroll
              for (int q = 0; q < 4; ++q)
                o[rb * 4 + q] = __builtin_amdgcn_mfma_f32_16x16x32_bf16(va[q].v, pb.v, o[rb * 4 + q], 0, 0, 0);
            }
            asm volatile("s_waitcnt lgkmcnt(0)" ::: "memory");
            __builtin_amdgcn_wave_barrier();
          }
          if (half == 1) {
            XF[lane] = mrun;
            XF[64 + lane] = lrun;
#pragma unroll
            for (int rt = 0; rt < 16; ++rt)
#pragma unroll
              for (int e = 0; e < 4; ++e) XF[(2 + rt * 4 + e) * 64 + lane] = o[rt][e];
          }
          __syncthreads();
          if (half == 0) {
            const float* XP = (const float*)((char*)shm + (wave + 4) * (32 * ST_LD * 2));
            const float m1 = XP[lane], l1 = XP[64 + lane];
            const float mm = fmaxf(mrun, m1);
            const float a0 = __builtin_amdgcn_exp2f(mrun - mm), a1 = __builtin_amdgcn_exp2f(m1 - mm);
            const float invl = 1.0f / (lrun * a0 + l1 * a1);
            const float w0 = a0 * invl, w1 = a1 * invl;
            bf16_t* op = OLAT + (size_t)qpos * 4096 + fr * 256 + fq * 4;
#pragma unroll
            for (int rt = 0; rt < 16; ++rt) {
              float r[4];
#pragma unroll
              for (int e = 0; e < 4; ++e) r[e] = o[rt][e] * w0 + XP[(2 + rt * 4 + e) * 64 + lane] * w1;
              uint2 w; w.x = pk2(r[0], r[1]); w.y = pk2(r[2], r[3]);
              *(uint2*)(op + rt * 16) = w;
            }
          }
        }
        if (wave == 0 && lane == 0) *QW = nxt;
        __syncthreads();
        tkt = __builtin_amdgcn_readfirstlane(*QW);
      }
      {
        const float* psc = p.in[10] + (size_t)l * 1024;
        const int ntiles = 4 * NMT;
        for (int t = bid; t < ntiles; t += G) {
          const int g = t / NMT, pm = t % NMT;
          auto epi8 = [&](int row, int col, f32x4 a, f32x4 b) {
            const float4 sa = *(const float4*)(psc + g * 256 + col), sb = *(const float4*)(psc + g * 256 + col + 4);
            uint4 o; o.x = pk2(a[0] * sa.x, a[1] * sa.y); o.y = pk2(a[2] * sa.z, a[3] * sa.w); o.z = pk2(b[0] * sb.x, b[1] * sb.y); o.w = pk2(b[2] * sb.z, b[3] * sb.w);
            *(uint4*)(YP2 + (size_t)row * 1024 + g * 256 + col) = o;
          };
          gemm_tile(YPOOL + g * 256, 1024, WPOOL + (size_t)g * 65536, 256, pm * 256, 0, 256, epi8, wave_s);
        }
        int tid2 = wave_s * 64 + lane_id();
        asm volatile("" : "+v"(tid2));
        const int lane2 = tid2 & 63, gw2 = bid * 8 + (tid2 >> 6);
        for (int task = gw2; task < 4 * 16; task += NGW) {
          const int g = task >> 4, ct = task & 15;
          auto epi = [&](int row, int col, f32x4 v) {
            const float4 sc = *(const float4*)(psc + g * 256 + col);
            uint2 o; o.x = pk2(v[0] * sc.x, v[1] * sc.y); o.y = pk2(v[2] * sc.z, v[3] * sc.w);
            *(uint2*)(YP2 + (size_t)row * 1024 + g * 256 + col) = o;
          };
          tail_tile1(YPOOL + (size_t)TAIL0 * 1024 + g * 256, 1024, WPOOL + (size_t)g * 65536, 256, ct, 256, lane2, epi);
        }
      }
    }
    xcd_barrier(xbar, wave_s);

    {
      PHASE_PTRS
      auto epib = [&](int row, int col, f32x4 v) {
        const uint2 raw = *(const uint2*)(PROJ + (size_t)row * NINP + C_GB + col);
        f32x4 o;
        o[0] = sigmoidf(bf2f(raw.x & 0xffff)) * v[0]; o[1] = sigmoidf(bf2f(raw.x >> 16)) * v[1];
        o[2] = sigmoidf(bf2f(raw.y & 0xffff)) * v[2]; o[3] = sigmoidf(bf2f(raw.y >> 16)) * v[3];
        *(f32x4*)(MB + (size_t)row * D + col) = o;
      };
      auto epib8 = [&](int row, int col, f32x4 a, f32x4 b) {
        const uint4 raw = *(const uint4*)(PROJ + (size_t)row * NINP + C_GB + col);
        f32x4 oa, ob;
        oa[0] = sigmoidf(bf2f(raw.x & 0xffff)) * a[0]; oa[1] = sigmoidf(bf2f(raw.x >> 16)) * a[1];
        oa[2] = sigmoidf(bf2f(raw.y & 0xffff)) * a[2]; oa[3] = sigmoidf(bf2f(raw.y >> 16)) * a[3];
        ob[0] = sigmoidf(bf2f(raw.z & 0xffff)) * b[0]; ob[1] = sigmoidf(bf2f(raw.z >> 16)) * b[1];
        ob[2] = sigmoidf(bf2f(raw.w & 0xffff)) * b[2]; ob[3] = sigmoidf(bf2f(raw.w >> 16)) * b[3];
        f32x4* mp = (f32x4*)(MB + (size_t)row * D + col);
        mp[0] = oa; mp[1] = ob;
      };
      const int n1 = 16 * NMT, n2 = NMT * 8;
      for (int t = bid; t < n1 + n2; t += G) {
        if (t < n1) {
          const int h = t / NMT, pm = t % NMT;
          auto epi8 = [&](int row, int col, f32x4 a, f32x4 b) {
            if (col < 128) {
              uint4 o; o.x = pk2(a[0], a[1]); o.y = pk2(a[2], a[3]); o.z = pk2(b[0], b[1]); o.w = pk2(b[2], b[3]);
              *(uint4*)(OB + (size_t)row * D + h * 128 + col) = o;
            }
          };
          gemm_tile(OLAT + h * 256, 4096, WUV + (size_t)h * 65536, 256, pm * 256, 0, 256, epi8, wave_s);
        } else {
          int pm, pn; tile_map(t - n1, NMT, 8, pm, pn);
          gemm_tile(YP2, 1024, WPO, 1024, pm * 256, pn * 256, 1024, epib8, wave_s);
        }
      }
      int tid2 = wave_s * 64 + lane_id();
      asm volatile("" : "+v"(tid2));
      const int lane2 = tid2 & 63, gw2 = bid * 8 + (tid2 >> 6);
      for (int task = gw2; task < 16 * 8; task += NGW) {
        const int h = task >> 3, ct = task & 7;
        auto epi = [&](int row, int col, f32x4 v) {
          uint2 o; o.x = pk2(v[0], v[1]); o.y = pk2(v[2], v[3]);
          *(uint2*)(OB + (size_t)row * D + h * 128 + col) = o;
        };
        tail_tile1(OLAT + (size_t)TAIL0 * 4096 + h * 256, 4096, WUV + (size_t)h * 65536, 256, ct, 256, lane2, epi);
      }
      tail_gemm8(YP2 + (size_t)TAIL0 * 1024, 1024, WPO, 1024, D / 16, 1024, epib, wave_s);
    }
    xcd_barrier(xbar, wave_s);

    {
      PHASE_PTRS
      auto epi = [&](int row, int col, f32x4 v) {
        const uint2 raw = *(const uint2*)(PROJ + (size_t)row * NINP + C_GA + col);
        const f32x4 mb = *(const f32x4*)(MB + (size_t)row * D + col);
        uint2 o;
        o.x = pk2(sigmoidf(bf2f(raw.x & 0xffff)) * v[0] + mb[0], sigmoidf(bf2f(raw.x >> 16)) * v[1] + mb[1]);
        o.y = pk2(sigmoidf(bf2f(raw.y & 0xffff)) * v[2] + mb[2], sigmoidf(bf2f(raw.y >> 16)) * v[3] + mb[3]);
        *(uint2*)(MERGED + (size_t)row * D + col) = o;
      };
      auto epi8 = [&](int row, int col, f32x4 a, f32x4 b) {
        const uint4 raw = *(const uint4*)(PROJ + (size_t)row * NINP + C_GA + col);
        const f32x4* mp = (const f32x4*)(MB + (size_t)row * D + col);
        const f32x4 ma = mp[0], mb = mp[1];
        uint4 o;
        o.x = pk2(sigmoidf(bf2f(raw.x & 0xffff)) * a[0] + ma[0], sigmoidf(bf2f(raw.x >> 16)) * a[1] + ma[1]);
        o.y = pk2(sigmoidf(bf2f(raw.y & 0xffff)) * a[2] + ma[2], sigmoidf(bf2f(raw.y >> 16)) * a[3] + ma[3]);
        o.z = pk2(sigmoidf(bf2f(raw.z & 0xffff)) * b[0] + mb[0], sigmoidf(bf2f(raw.z >> 16)) * b[1] + mb[1]);
        o.w = pk2(sigmoidf(bf2f(raw.w & 0xffff)) * b[2] + mb[2], sigmoidf(bf2f(raw.w >> 16)) * b[3] + mb[3]);
        *(uint4*)(MERGED + (size_t)row * D + col) = o;
      };
      for (int t = bid; t < NMT * 8; t += G) {
        int pm, pn; tile_map(t, NMT, 8, pm, pn);
        gemm_tile(OB, D, WAO, D, pm * 256, pn * 256, D, epi8, wave_s);
      }
      tail_gemm8(OB + (size_t)TAIL0 * D, D, WAO, D, D / 16, D, epi, wave_s);
    }
    xcd_barrier(xbar, wave_s);

    {
      PHASE_PTRS
      auto epi = [&](int row, int col, f32x4 v) {
        f32x4* hp = (f32x4*)(HRES + (size_t)row * D + col);
        *hp = *hp + v;
      };
      auto epi8 = [&](int row, int col, f32x4 a, f32x4 b) {
        f32x4* hp = (f32x4*)(HRES + (size_t)row * D + col);
        const f32x4 ha = hp[0], hb = hp[1];
        hp[0] = ha + a; hp[1] = hb + b;
      };
      for (int t = bid; t < NMT * 8; t += G) {
        int pm, pn; tile_map(t, NMT, 8, pm, pn);
        gemm_tile(MERGED, D, WOUT, D, pm * 256, pn * 256, D, epi8, wave_s);
      }
      tail_gemm8(MERGED + (size_t)TAIL0 * D, D, WOUT, D, D / 16, D, epi, wave_s);
    }
    xcd_barrier(xbar, wave_s);

    {
      PHASE_IDS
      rmsnorm_rows(HRES, p.in[13] + (size_t)l * D, HN, gw, NGW, lane);
    }
    xcd_barrier(xbar, wave_s);

    for (int rep = 0; rep < REP_P9; ++rep) {
      PHASE_PTRS
      auto epi = [&](int row, int col, f32x4 v) {
        float a0 = fmaxf(v[0], 0.f), a1 = fmaxf(v[1], 0.f), a2 = fmaxf(v[2], 0.f), a3 = fmaxf(v[3], 0.f);
        uint2 o; o.x = pk2(a0 * a0, a1 * a1); o.y = pk2(a2 * a2, a3 * a3);
        *(uint2*)(UB + (size_t)row * DFF + col) = o;
      };
      auto epi8 = [&](int row, int col, f32x4 a, f32x4 b) {
        const float a0 = fmaxf(a[0], 0.f), a1 = fmaxf(a[1], 0.f), a2 = fmaxf(a[2], 0.f), a3 = fmaxf(a[3], 0.f);
        const float b0 = fmaxf(b[0], 0.f), b1 = fmaxf(b[1], 0.f), b2 = fmaxf(b[2], 0.f), b3 = fmaxf(b[3], 0.f);
        uint4 o; o.x = pk2(a0 * a0, a1 * a1); o.y = pk2(a2 * a2, a3 * a3); o.z = pk2(b0 * b0, b1 * b1); o.w = pk2(b2 * b2, b3 * b3);
        *(uint4*)(UB + (size_t)row * DFF + col) = o;
      };
      const int nN = DFF / 256, ntiles = NMT * nN;
      for (int t = bid; t < ntiles; t += G) {
        int pm, pn; tile_map(t, NMT, nN, pm, pn);
        gemm_tile(HN, D, WMI, D, pm * 256, pn * 256, D, epi8, wave_s);
      }
      tail_gemm8(HN + (size_t)TAIL0 * D, D, WMI, D, DFF / 16, D, epi, wave_s);
    }
    xcd_barrier(xbar, wave_s);

    {
      PHASE_PTRS
      auto epi = [&](int row, int col, f32x4 v) {
        f32x4* hp = (f32x4*)(HRES + (size_t)row * D + col);
        *hp = *hp + v;
      };
      auto epi8 = [&](int row, int col, f32x4 a, f32x4 b) {
        f32x4* hp = (f32x4*)(HRES + (size_t)row * D + col);
        const f32x4 ha = hp[0], hb = hp[1];
        hp[0] = ha + a; hp[1] = hb + b;
      };
      for (int t = bid; t < NMT * 8; t += G) {
        int pm, pn; tile_map(t, NMT, 8, pm, pn);
        gemm_tile(UB, DFF, WMO, DFF, pm * 256, pn * 256, DFF, epi8, wave_s);
      }
      tail_gemm8(UB + (size_t)TAIL0 * DFF, DFF, WMO, DFF, D / 16, DFF, epi, wave_s);
    }
    xcd_barrier(xbar, wave_s);
  }

  {
    BLOCK_IDS
    PHASE_IDS
    const float* g = p.in[16];
    for (int r0 = gw; r0 < SEQ; r0 += NGW) {
      const int r = r0 + NMETA;
      float4 v[8];
      float s = 0.f;
#pragma unroll
      for (int j = 0; j < 8; ++j) {
        v[j] = *(const float4*)(HRES + (size_t)r * D + j * 256 + lane * 4);
        s += v[j].x * v[j].x + v[j].y * v[j].y + v[j].z * v[j].z + v[j].w * v[j].w;
      }
      s = wave_sum(s, lane);
      const float rs = rsqrtf(s * (1.0f / D) + 1e-6f);
#pragma unroll
      for (int j = 0; j < 8; ++j) {
        const float4 gg = *(const float4*)(g + j * 256 + lane * 4);
        __builtin_nontemporal_store((f32x4){v[j].x * rs * gg.x, v[j].y * rs * gg.y, v[j].z * rs * gg.z, v[j].w * rs * gg.w}, (f32x4*)(p.out + (size_t)r0 * D + j * 256 + lane * 4));
      }
    }
  }
}

extern "C" void kernel_launch(void* const* d_in, const int* in_sizes, int n_in, void* d_out, int out_size,
                              void* d_ws, size_t ws_size, hipStream_t stream) {
  static int grid_blocks = 0;
  if (!grid_blocks) {
    int dev = 0, cus = 0, per_cu = 0;
    (void)hipGetDevice(&dev);
    (void)hipDeviceGetAttribute(&cus, hipDeviceAttributeMultiprocessorCount, dev);
    (void)hipFuncSetAttribute((const void*)fwd, hipFuncAttributeMaxDynamicSharedMemorySize, LDS_BYTES);
    (void)hipOccupancyMaxActiveBlocksPerMultiprocessor(&per_cu, (const void*)fwd, 512, LDS_BYTES);
    (void)hipGetLastError();
    grid_blocks = cus > 0 ? cus : 256;
    if (ws_size < WS_END) { fprintf(stderr, "workspace too small: %zu < %zu\n", ws_size, (size_t)WS_END); grid_blocks = -1; }
  }
  if (grid_blocks < 0) return;
  Params p{};
  for (int i = 0; i < 17; ++i) p.in[i] = (const float*)d_in[i];
  p.out = (float*)d_out;
  p.ws = (unsigned char*)d_ws;
  (void)hipMemsetAsync((unsigned char*)d_ws + OFF_BAR, 0, BAR_BYTES, stream);
  void* args[] = {&p};
  hipError_t e = hipLaunchCooperativeKernel((void*)fwd, dim3(grid_blocks), dim3(512), args, LDS_BYTES, stream);
  if (e != hipSuccess) fprintf(stderr, "cooperative launch failed: %s (grid %d)\n", hipGetErrorString(e), grid_blocks);
}
```

```cpp
#include <hip/hip_runtime.h>
#include <hip/hip_bf16.h>
#include <hip/hip_cooperative_groups.h>
#include <cstdio>
#include <type_traits>
namespace cg = cooperative_groups;

typedef unsigned short bf16_t;
typedef short bf16x8 __attribute__((ext_vector_type(8)));
typedef float f32x4 __attribute__((ext_vector_type(4)));
typedef float f32x16 __attribute__((ext_vector_type(16)));
typedef unsigned short u16x4 __attribute__((ext_vector_type(4)));
typedef unsigned u32x4 __attribute__((ext_vector_type(4)));

constexpr int D = 2048, SEQ = 8192, NMETA = 16, NKEYS = SEQ + NMETA, MP = 8448, DEPTH = 4;
constexpr int NIN = 8008, NINP = 8192, DFF = 8192;
constexpr int C_CKV = 2048, C_QIDX = 2304, C_KIDX = 2816, C_WIDX = 2880, C_PIN = 2888, C_GA = 3912, C_GB = 5960;
constexpr int NMT = 32;
constexpr int TAIL0 = 8192;

constexpr size_t SZ_HRES = (size_t)MP * D * 4, SZ_HN = (size_t)MP * D * 2, SZ_PROJ = (size_t)MP * NINP * 2;
constexpr size_t OFF_HRES = 0;
constexpr size_t OFF_HN = OFF_HRES + SZ_HRES;
constexpr size_t OFF_PROJ = OFF_HN + SZ_HN;
constexpr size_t OFF_CKV = OFF_PROJ + SZ_PROJ;
constexpr size_t OFF_KIDX = OFF_CKV + (size_t)MP * 256 * 2;
constexpr size_t OFF_YPOOL = OFF_KIDX + (size_t)MP * 64 * 2;
constexpr size_t OFF_YP2 = OFF_YPOOL + (size_t)MP * 1024 * 2;
constexpr size_t OFF_QLAT = OFF_YP2 + (size_t)MP * 1024 * 2;
constexpr size_t OFF_OLAT = OFF_QLAT + (size_t)MP * 4096 * 2;
constexpr size_t OFF_O = OFF_OLAT + (size_t)MP * 4096 * 2;
constexpr size_t OFF_MB = OFF_O + (size_t)MP * D * 2;
constexpr size_t OFF_MERGED = OFF_MB + (size_t)MP * D * 4;
constexpr size_t OFF_WIN = OFF_MERGED + (size_t)MP * D * 2;
constexpr size_t OFF_WUK = OFF_WIN + (size_t)NINP * D * 2;
constexpr size_t OFF_WUV = OFF_WUK + (size_t)16 * 256 * 256 * 2;
constexpr size_t OFF_WAO = OFF_WUV + (size_t)16 * 256 * 256 * 2;
constexpr size_t OFF_WPOOL = OFF_WAO + (size_t)D * D * 2;
constexpr size_t OFF_WPO = OFF_WPOOL + (size_t)4 * 256 * 256 * 2;
constexpr size_t OFF_WOUT = OFF_WPO + (size_t)D * 1024 * 2;
constexpr size_t OFF_WMI = OFF_WOUT + (size_t)D * D * 2;
constexpr size_t OFF_WMO = OFF_WMI + (size_t)DFF * D * 2;
constexpr size_t OFF_BAR = OFF_WMO + (size_t)D * DFF * 2;
constexpr size_t BAR_BYTES = 16384;
constexpr size_t WS_END = OFF_BAR + BAR_BYTES;

constexpr int SCLD = 8448;
constexpr int ST_LD = 272;
constexpr int LDS_SC_BYTES = 4 * SCLD * 4;
constexpr int LDS_IDX_OFF = (8 * 32 * ST_LD * 2 > LDS_SC_BYTES) ? 8 * 32 * ST_LD * 2 : LDS_SC_BYTES;
constexpr int CAND_CAP = 1024;
constexpr int LDS_CAND_OFF = LDS_IDX_OFF + 4 * 256 * 4;
constexpr int LDS_XB_OFF = LDS_CAND_OFF + 4 * CAND_CAP * 4;
constexpr int LDS_XCH_OFF = LDS_XB_OFF + 16;
constexpr int CAND_CAP2 = CAND_CAP / 2;
constexpr int LDS_BYTES = LDS_XCH_OFF + 144;

#ifndef REP_P1
#define REP_P1 1
#endif
#ifndef REP_P4
#define REP_P4 1
#endif
#ifndef REP_SC
#define REP_SC 1
#endif
#ifndef REP_SEL
#define REP_SEL 1
#endif
#ifndef REP_ATT
#define REP_ATT 1
#endif
#ifndef REP_P9
#define REP_P9 1
#endif
struct Params {
  const float* in[17];
  float* out;
  unsigned char* ws;
};

__device__ __forceinline__ unsigned short f2bf(float f) {
  unsigned u = __float_as_uint(f);
  u += 0x7FFFu + ((u >> 16) & 1u);
  return (unsigned short)(u >> 16);
}
__device__ __forceinline__ float bf2f(unsigned short h) { return __uint_as_float(((unsigned)h) << 16); }
typedef float f32x2_t __attribute__((ext_vector_type(2)));
typedef __bf16 bf16x2_t __attribute__((ext_vector_type(2)));
__device__ __forceinline__ unsigned pk2(float a, float b) { const f32x2_t f = {a, b}; return __builtin_bit_cast(unsigned, __builtin_convertvector(f, bf16x2_t)); }
__device__ __forceinline__ float shx(float v, int o, int lane) { return __int_as_float(__builtin_amdgcn_ds_bpermute((lane ^ o) << 2, __float_as_int(v))); }
__device__ __forceinline__ int shxi(int v, int o, int lane) { return __builtin_amdgcn_ds_bpermute((lane ^ o) << 2, v); }
__device__ __forceinline__ float wave_sum(float v, int lane) {
#pragma unroll
  for (int o = 1; o < 64; o <<= 1) v += shx(v, o, lane);
  return v;
}
__device__ __forceinline__ int lane_id() { return (int)__builtin_amdgcn_mbcnt_hi(~0u, __builtin_amdgcn_mbcnt_lo(~0u, 0u)); }
__device__ __forceinline__ float sigmoidf(float x) { return __builtin_amdgcn_rcpf(1.0f + __builtin_amdgcn_exp2f(-1.4426950408889634f * x)); }

constexpr int BM = 256, BK = 64, HALF = 128, HT = HALF * BK;
__device__ __forceinline__ int lds_byte(int r, int c) {
  int st = (r >> 4) * 2 + (c >> 5), rr = r & 15, cc = c & 31, ob = rr * 64 + cc * 2;
  return st * 1024 + (ob ^ (((ob >> 9) & 1) << 5));
}
__device__ __forceinline__ void stage_rc(int b, int& R, int& C) {
  int st = b / 1024, sb = b % 1024, swz = sb ^ (((sb >> 9) & 1) << 5);
  R = (st >> 1) * 16 + swz / 64;
  C = (st & 1) * 32 + (swz % 64) / 2;
}

template <class Epi>
__device__ __forceinline__ void gemm_tile(const bf16_t* __restrict__ A, const int lda, const bf16_t* __restrict__ Bt, const int ldb,
                                          const int brow, const int bcol, const int K, const Epi& epi, const int wave_s) {
  extern __shared__ __attribute__((aligned(16))) bf16_t shm[];
#define SA(b, h) (shm + ((b) * 2 + (h)) * HT)
#define SB(b, h) (shm + (4 + (b) * 2 + (h)) * HT)
#define STAGE_A(P, br, kt)                                                                                                   \
  do {                                                                                                                       \
    const bf16_t* _g = A + (long)(br) * lda + (long)(kt) * BK;                                                               \
    __builtin_amdgcn_global_load_lds((const unsigned*)(_g + aoff0), (unsigned*)((char*)(P) + sb0), 16, 0, 0);               \
    __builtin_amdgcn_global_load_lds((const unsigned*)(_g + aoff1), (unsigned*)((char*)(P) + sb1), 16, 0, 0);               \
  } while (0)
#define STAGE_B(P, br, kt)                                                                                                   \
  do {                                                                                                                       \
    const bf16_t* _g = Bt + (long)(br) * ldb + (long)(kt) * BK;                                                              \
    __builtin_amdgcn_global_load_lds((const unsigned*)(_g + boff0), (unsigned*)((char*)(P) + sb0), 16, 0, 0);               \
    __builtin_amdgcn_global_load_lds((const unsigned*)(_g + boff1), (unsigned*)((char*)(P) + sb1), 16, 0, 0);               \
  } while (0)
#define LDA(dst, b, h)                                                                                                       \
  for (int m = 0; m < 4; ++m)                                                                                                \
    for (int k = 0; k < 2; ++k) dst[m][k] = *reinterpret_cast<const bf16x8*>((char*)SA(b, h) + lds_byte(wr * 64 + m * 16 + fr, k * 32 + fq * 8))
#define LDB(dst, b, h)                                                                                                       \
  for (int n = 0; n < 2; ++n)                                                                                                \
    for (int k = 0; k < 2; ++k) dst[n][k] = *reinterpret_cast<const bf16x8*>((char*)SB(b, h) + lds_byte(wc * 32 + n * 16 + fr, k * 32 + fq * 8))
#define MMA(ai, bj, At_, Bt_)                                                                                                \
  do {                                                                                                                       \
    __builtin_amdgcn_s_setprio(1);                                                                                           \
    for (int m = 0; m < 4; ++m)                                                                                              \
      for (int n = 0; n < 2; ++n)                                                                                            \
        for (int k = 0; k < 2; ++k)                                                                                          \
          acc[ai][bj][m][n] = __builtin_amdgcn_mfma_f32_16x16x32_bf16(Bt_[n][k], At_[m][k], acc[ai][bj][m][n], 0, 0, 0);    \
    __builtin_amdgcn_s_setprio(0);                                                                                           \
  } while (0)
#define WAIT_V(n) asm volatile("s_waitcnt vmcnt(" #n ")" ::: "memory")
#define WAIT_L(n) asm volatile("s_waitcnt lgkmcnt(" #n ")" ::: "memory")
#define BAR __builtin_amdgcn_s_barrier()
#define SCHED __builtin_amdgcn_sched_barrier(0)

  int tx = wave_s * 64 + lane_id();
  asm volatile("" : "+v"(tx));
  const int wid = tx >> 6, lane = tx & 63, wr = wid >> 2, wc = wid & 3, fr = lane & 15, fq = lane >> 4;
  const int sb0 = tx * 16, sb1 = sb0 + 8192;
  int r0, c0, r1, c1;
  stage_rc(sb0, r0, c0);
  stage_rc(sb1, r1, c1);
  const unsigned aoff0 = (unsigned)(r0 * lda + c0), aoff1 = (unsigned)(r1 * lda + c1);
  const int rp0 = (r0 & ~31) | (8 * ((r0 & 15) >> 2) + 4 * ((r0 >> 4) & 1) + (r0 & 3));
  const int rp1 = (r1 & ~31) | (8 * ((r1 & 15) >> 2) + 4 * ((r1 >> 4) & 1) + (r1 & 3));
  const unsigned boff0 = (unsigned)(rp0 * ldb + c0), boff1 = (unsigned)(rp1 * ldb + c1);
  f32x4 acc[2][2][4][2];
#pragma unroll
  for (int a = 0; a < 2; ++a)
#pragma unroll
    for (int b = 0; b < 2; ++b)
#pragma unroll
      for (int m = 0; m < 4; ++m)
#pragma unroll
        for (int n = 0; n < 2; ++n) acc[a][b][m][n] = (f32x4){0.f, 0.f, 0.f, 0.f};
  bf16x8 At[4][2], B0[2][2], B1[2][2];
  const int nt = K / BK;
  STAGE_B(SB(0, 0), bcol, 0);
  STAGE_A(SA(0, 0), brow, 0);
  STAGE_B(SB(0, 1), bcol + HALF, 0);
  STAGE_A(SA(0, 1), brow + HALF, 0);
  if (wr == 1) BAR;
  WAIT_V(4);
  BAR;
  STAGE_B(SB(1, 0), bcol, 1);
  STAGE_A(SA(1, 0), brow, 1);
  STAGE_B(SB(1, 1), bcol + HALF, 1);
  WAIT_V(6);
  BAR;
  for (int t = 0; t < nt - 2; t += 2) {
    LDB(B0, 0, 0); SCHED; LDA(At, 0, 0); STAGE_A(SA(1, 1), brow + HALF, t + 1);
    WAIT_L(8); BAR; WAIT_L(0); MMA(0, 0, At, B0); BAR; SCHED;
    LDB(B1, 0, 1); STAGE_B(SB(0, 0), bcol, t + 2);
    BAR; WAIT_L(0); MMA(0, 1, At, B1); BAR;
    LDA(At, 0, 1); STAGE_A(SA(0, 0), brow, t + 2);
    BAR; WAIT_L(0); MMA(1, 0, At, B0); BAR; SCHED;
    STAGE_B(SB(0, 1), bcol + HALF, t + 2);
    WAIT_V(6); BAR; MMA(1, 1, At, B1); BAR;
    LDB(B0, 1, 0); SCHED; LDA(At, 1, 0); STAGE_A(SA(0, 1), brow + HALF, t + 2);
    WAIT_L(8); BAR; WAIT_L(0); MMA(0, 0, At, B0); BAR; SCHED;
    LDB(B1, 1, 1); STAGE_B(SB(1, 0), bcol, t + 3);
    BAR; WAIT_L(0); MMA(0, 1, At, B1); BAR;
    LDA(At, 1, 1); STAGE_A(SA(1, 0), brow, t + 3);
    BAR; WAIT_L(0); MMA(1, 0, At, B0); BAR; SCHED;
    STAGE_B(SB(1, 1), bcol + HALF, t + 3);
    WAIT_V(6); BAR; MMA(1, 1, At, B1); BAR;
  }
  {
    LDB(B0, 0, 0); LDA(At, 0, 0); STAGE_A(SA(1, 1), brow + HALF, nt - 1);
    BAR; WAIT_L(0); MMA(0, 0, At, B0); BAR;
    LDB(B1, 0, 1); BAR; WAIT_L(0); MMA(0, 1, At, B1); BAR;
    LDA(At, 0, 1); WAIT_V(4); BAR; WAIT_L(0); MMA(1, 0, At, B0); MMA(1, 1, At, B1); BAR;
  }
  {
    LDB(B0, 1, 0); LDA(At, 1, 0); WAIT_V(2); BAR; WAIT_L(0); MMA(0, 0, At, B0); BAR;
    LDB(B1, 1, 1); WAIT_V(0); BAR; WAIT_L(0); MMA(0, 1, At, B1); BAR;
    LDA(At, 1, 1); BAR; WAIT_L(0); MMA(1, 0, At, B0); MMA(1, 1, At, B1); BAR;
  }
  if (wr == 0) BAR;
#pragma unroll
  for (int ai = 0; ai < 2; ++ai)
#pragma unroll
    for (int m = 0; m < 4; ++m)
#pragma unroll
      for (int bj = 0; bj < 2; ++bj)
        epi(brow + ai * HALF + wr * 64 + m * 16 + fr, bcol + bj * HALF + wc * 32 + fq * 8, acc[ai][bj][m][0], acc[ai][bj][m][1]);
#undef SA
#undef SB
#undef STAGE_A
#undef STAGE_B
#undef LDA
#undef LDB
#undef MMA
}


template <class Epi>
__device__ __forceinline__ void tail_gemm8(const bf16_t* __restrict__ A, const int lda, const bf16_t* __restrict__ Bt, const int ldb,
                                           const int nct, const int K, const Epi& epi, const int wave_s) {
  extern __shared__ __attribute__((aligned(16))) bf16_t shm[];
  float* red = (float*)shm;
  int tx = wave_s * 64 + lane_id(), bid_ = blockIdx.x;
  asm volatile("" : "+v"(tx), "+s"(bid_));
  const int wave = tx >> 6, lane = tx & 63, fr = lane & 15, fq = lane >> 4;
  const int kw = K >> 3;
  for (int ct = bid_; ct < nct; ct += gridDim.x) {
    const bf16_t* ap = A + (size_t)fr * lda + wave * kw + fq * 8;
    const bf16_t* bp = Bt + (size_t)(ct * 16 + fr) * ldb + wave * kw + fq * 8;
    f32x4 acc = (f32x4){0.f, 0.f, 0.f, 0.f};
#pragma unroll 8
    for (int k = 0; k < kw; k += 32) {
      const bf16x8 a = *(const bf16x8*)(ap + k);
      const bf16x8 b = *(const bf16x8*)(bp + k);
      acc = __builtin_amdgcn_mfma_f32_16x16x32_bf16(b, a, acc, 0, 0, 0);
    }
    *(f32x4*)(red + (wave * 64 + lane) * 4) = acc;
    __syncthreads();
    if (wave == 0) {
      f32x4 sum = acc;
#pragma unroll
      for (int w = 1; w < 8; ++w) sum += *(const f32x4*)(red + (w * 64 + lane) * 4);
      epi(TAIL0 + fr, ct * 16 + fq * 4, sum);
    }
    __syncthreads();
  }
}
template <class Epi>
__device__ __forceinline__ void tail_tile1(const bf16_t* __restrict__ A, const int lda, const bf16_t* __restrict__ Bt, const int ldb,
                                           const int ct, const int K, const int lane, const Epi& epi) {
  const int fr = lane & 15, fq = lane >> 4;
  const bf16_t* ap = A + (size_t)fr * lda + fq * 8;
  const bf16_t* bp = Bt + (size_t)(ct * 16 + fr) * ldb + fq * 8;
  f32x4 acc = (f32x4){0.f, 0.f, 0.f, 0.f};
#pragma unroll 8
  for (int k = 0; k < K; k += 32) {
    const bf16x8 a = *(const bf16x8*)(ap + k);
    const bf16x8 b = *(const bf16x8*)(bp + k);
    acc = __builtin_amdgcn_mfma_f32_16x16x32_bf16(b, a, acc, 0, 0, 0);
  }
  epi(TAIL0 + fr, ct * 16 + fq * 4, acc);
}

__device__ __forceinline__ void tile_map(int wgid, int nM, int nN, int& pm, int& pn) {
  const int nwg = nM * nN, q = nwg / 8, r = nwg % 8, xcd = wgid % 8, off = wgid / 8;
  wgid = (xcd < r ? xcd * (q + 1) : r * (q + 1) + (xcd - r) * q) + off;
  const int nig = 8 * nN, gid = wgid / nig, fm = gid * 8, gsz = (nM - fm) < 8 ? (nM - fm) : 8;
  pm = fm + ((wgid % nig) % gsz);
  pn = (wgid % nig) / gsz;
}


typedef unsigned u32x2 __attribute__((ext_vector_type(2)));
template <int GRP>
__device__ __forceinline__ void pool_group(const bf16_t* __restrict__ PROJ, bf16_t* __restrict__ YPOOL, const int r, const int lane) {
  constexpr int W = 2 << GRP;
  u32x2 raw[W];
#pragma unroll
  for (int i = 0; i < W; ++i) {
    const int t = (r - i) < 0 ? 0 : (r - i);
    raw[i] = *(const u32x2*)(PROJ + (size_t)t * NINP + C_PIN + GRP * 256 + lane * 4);
  }
  float s0 = 0.f, s1 = 0.f, s2 = 0.f, s3 = 0.f;
#pragma unroll
  for (int i = W - 1; i >= 0; --i) {
    if (r - i >= 0) {
      s0 += bf2f(raw[i].x & 0xffff); s1 += bf2f(raw[i].x >> 16); s2 += bf2f(raw[i].y & 0xffff); s3 += bf2f(raw[i].y >> 16);
    }
  }
  const float c0 = bf2f(raw[0].x & 0xffff), c1 = bf2f(raw[0].x >> 16), c2 = bf2f(raw[0].y & 0xffff), c3 = bf2f(raw[0].y >> 16);
  const int cntw = (r + 1) < W ? (r + 1) : W;
  const float inv = 1.0f / (float)cntw;
  uint2 o; o.x = pk2(s0 * inv - c0, s1 * inv - c1); o.y = pk2(s2 * inv - c2, s3 * inv - c3);
  *(uint2*)(YPOOL + (size_t)r * 1024 + GRP * 256 + lane * 4) = o;
}


__device__ __forceinline__ void rmsnorm_rows(const float* __restrict__ HRES, const float* __restrict__ g, bf16_t* __restrict__ HN,
                                             const int gw, const int NGW, const int lane) {
  for (int r = gw; r < NKEYS; r += 2 * NGW) {
    const int r2 = (r + NGW < NKEYS) ? r + NGW : r;
    f32x4 va[8], vb[8];
#pragma unroll
    for (int j = 0; j < 8; ++j) {
      va[j] = *(const f32x4*)(HRES + (size_t)r * D + j * 256 + lane * 4);
      vb[j] = *(const f32x4*)(HRES + (size_t)r2 * D + j * 256 + lane * 4);
    }
    float sa = 0.f, sb = 0.f;
#pragma unroll
    for (int j = 0; j < 8; ++j) {
      sa += va[j][0] * va[j][0] + va[j][1] * va[j][1] + va[j][2] * va[j][2] + va[j][3] * va[j][3];
      sb += vb[j][0] * vb[j][0] + vb[j][1] * vb[j][1] + vb[j][2] * vb[j][2] + vb[j][3] * vb[j][3];
    }
#pragma unroll
    for (int o = 1; o < 64; o <<= 1) { sa += shx(sa, o, lane); sb += shx(sb, o, lane); }
    const float ra = rsqrtf(sa * (1.0f / D) + 1e-6f), rb = rsqrtf(sb * (1.0f / D) + 1e-6f);
#pragma unroll
    for (int j = 0; j < 8; ++j) {
      const f32x4 gg = *(const f32x4*)(g + j * 256 + lane * 4);
      uint2 oa, ob;
      oa.x = pk2(va[j][0] * ra * gg[0], va[j][1] * ra * gg[1]); oa.y = pk2(va[j][2] * ra * gg[2], va[j][3] * ra * gg[3]);
      ob.x = pk2(vb[j][0] * rb * gg[0], vb[j][1] * rb * gg[1]); ob.y = pk2(vb[j][2] * rb * gg[2], vb[j][3] * rb * gg[3]);
      *(uint2*)(HN + (size_t)r * D + j * 256 + lane * 4) = oa;
      *(uint2*)(HN + (size_t)r2 * D + j * 256 + lane * 4) = ob;
    }
  }
}

__device__ __forceinline__ void wconv_T(const float* __restrict__ W, int K, int N, int Npad, bf16_t* __restrict__ WT, int ldt,
                                        int nbatch, size_t strideW, size_t strideWT, float scale, const int wave_s, const bool nt_out = false) {
  extern __shared__ __attribute__((aligned(16))) bf16_t shm[];
  float* tile = (float*)shm;
  const int nkb = K / 64, nnb = Npad / 256, per = nkb * nnb, items = per * nbatch;
  int t = wave_s * 64 + lane_id(), bid_ = blockIdx.x;
  asm volatile("" : "+v"(t), "+s"(bid_));
  for (int item = bid_; item < items; item += gridDim.x) {
    const int b = item / per, it = item % per, kb = it % nkb, nb = it / nkb, k0 = kb * 64, n0 = nb * 256;
    const float* Wb = W + (size_t)b * strideW;
    bf16_t* WTb = WT + (size_t)b * strideWT;
    float4 v[8];
#pragma unroll
    for (int i = 0; i < 8; ++i) {
      const int kk = (t >> 4) + 32 * (i & 1), n4 = (t & 15) * 4 + (i >> 1) * 64;
      v[i] = make_float4(0.f, 0.f, 0.f, 0.f);
      if (n0 + n4 < N) {
        const f32x4 w4 = __builtin_nontemporal_load((const f32x4*)(Wb + (size_t)(k0 + kk) * N + n0 + n4));
        v[i] = make_float4(w4[0], w4[1], w4[2], w4[3]);
      }
    }
#pragma unroll
    for (int i = 0; i < 8; ++i) {
      const int kk = (t >> 4) + 32 * (i & 1), c4 = (t & 15) * 4;
      float* tp = tile + (i >> 1) * (64 * 65) + kk * 65 + c4;
      tp[0] = v[i].x; tp[1] = v[i].y; tp[2] = v[i].z; tp[3] = v[i].w;
    }
    __syncthreads();
    {
      const int n = t >> 3, kc = (t & 7) * 8;
#pragma unroll
      for (int sub = 0; sub < 4; ++sub) {
        const float* tp = tile + sub * (64 * 65) + kc * 65 + n;
        uint4 o;
        o.x = pk2(tp[0 * 65] * scale, tp[1 * 65] * scale);
        o.y = pk2(tp[2 * 65] * scale, tp[3 * 65] * scale);
        o.z = pk2(tp[4 * 65] * scale, tp[5 * 65] * scale);
        o.w = pk2(tp[6 * 65] * scale, tp[7 * 65] * scale);
        u32x4* dst = (u32x4*)(WTb + (size_t)(n0 + sub * 64 + n) * ldt + k0 + kc);
        if (nt_out) __builtin_nontemporal_store((u32x4){o.x, o.y, o.z, o.w}, dst);
        else *dst = (u32x4){o.x, o.y, o.z, o.w};
      }
    }
    __syncthreads();
  }
}


#define XB_TMO      128
#define XB_XCNT(j)  (256  + 64 * (j))
#define XB_XSUB(j)  (1280 + 64 * (j))
#define XB_XGEN(j)  (2304 + 64 * (j))
#define XB_TOP      3328
#define XB_TOPGEN   3392
#define XCD_BAR_WORDS 3456
#define XB_SPIN_CAP (1u << 18)
#define LAS __attribute__((address_space(3)))
__device__ __forceinline__ unsigned xb_ld(unsigned* p)              { return __hip_atomic_load(p, __ATOMIC_RELAXED, __HIP_MEMORY_SCOPE_AGENT); }
__device__ __forceinline__ unsigned xb_add(unsigned* p, unsigned v) { return __hip_atomic_fetch_add(p, v, __ATOMIC_RELAXED, __HIP_MEMORY_SCOPE_AGENT); }
__device__ __forceinline__ unsigned xb_xcc_id() { return (unsigned)__builtin_amdgcn_s_getreg((3 << 11) | 20) & 0xFu; }
#define XB_SPIN(cond, bar) do { unsigned _sp = 0; while (cond) { __builtin_amdgcn_s_sleep(1); \
    if ((++_sp & 255u) == 0u) { if (xb_ld(&(bar)[XB_TMO])) break; if (_sp > XB_SPIN_CAP) { atomicAdd(&(bar)[XB_TMO], 1u); break; } } } } while (0)
struct XcdBarrier { unsigned* bar; unsigned x; volatile LAS unsigned* st; };
__device__ __forceinline__ XcdBarrier xcd_barrier_post(unsigned* bar, volatile LAS unsigned* st) {
    XcdBarrier b; b.bar = bar; b.x = xb_xcc_id(); b.st = st;
    if (threadIdx.x == 0) (void)xb_add(&bar[XB_XCNT(b.x)], 1u);
    return b;
}
__device__ __forceinline__ void xcd_barrier_complete(unsigned* bar, unsigned x, unsigned& nloc, unsigned& nx) {
    const unsigned G = gridDim.x * gridDim.y * gridDim.z;
    unsigned sum, cnt, mine, sp = 0u;
    for (;;) {
        sum = 0u; cnt = 0u; mine = 0u;
#pragma unroll
        for (unsigned j = 0; j < 16; ++j) { const unsigned c = xb_ld(&bar[XB_XCNT(j)]); sum += c; cnt += (c > 0u) ? 1u : 0u; mine = (j == x) ? c : mine; }
        if (sum == G) break;
        __builtin_amdgcn_s_sleep(1);
        if ((++sp & 255u) == 0u) { if (xb_ld(&bar[XB_TMO])) break; if (sp > XB_SPIN_CAP) { atomicAdd(&bar[XB_TMO], 1u); break; } }
    }
    nloc = mine > 0u ? mine : 1u; nx = cnt > 0u ? cnt : 1u;
}
__device__ __forceinline__ void xcd_barrier(const XcdBarrier& b, const int wave_s) {
    asm volatile("s_waitcnt vmcnt(0)" ::: "memory");
    __syncthreads();
    if (wave_s == 0 && lane_id() == 0) {
        unsigned* bar = b.bar;
        __builtin_amdgcn_s_waitcnt(0);
        unsigned nloc = b.st[0], nx = b.st[1];
        if (nloc == 0u) { xcd_barrier_complete(bar, b.x, nloc, nx); b.st[0] = nloc; b.st[1] = nx; }
        const unsigned old = xb_add(&bar[XB_XSUB(b.x)], 1u);
        const unsigned gen = old / nloc;
        if (old + 1u == (gen + 1u) * nloc) {
            __builtin_amdgcn_fence(__ATOMIC_RELEASE, "agent");
            asm volatile("s_waitcnt vmcnt(0)" ::: "memory");
            const unsigned og = xb_add(&bar[XB_TOP], 1u);
            const unsigned tg = og / nx;
            if (og + 1u == (tg + 1u) * nx) xb_add(&bar[XB_TOPGEN], 1u);
            else XB_SPIN(xb_ld(&bar[XB_TOPGEN]) == tg, bar);
            __builtin_amdgcn_fence(__ATOMIC_ACQUIRE, "agent");
            xb_add(&bar[XB_XGEN(b.x)], 1u);
            asm volatile("s_waitcnt vmcnt(0)" ::: "memory");
        } else {
            XB_SPIN(xb_ld(&bar[XB_XGEN(b.x)]) == gen, bar);
            __builtin_amdgcn_fence(__ATOMIC_ACQUIRE, "agent");
            asm volatile("s_waitcnt vmcnt(0)" ::: "memory");
        }
    }
    __syncthreads();
}

__global__ void __launch_bounds__(512) fwd(Params p) {
  extern __shared__ __attribute__((aligned(16))) bf16_t shm[];
  cg::grid_group grid = cg::this_grid();
  const int wave_s = __builtin_amdgcn_readfirstlane((int)(threadIdx.x >> 6));
  volatile LAS unsigned* xst = (volatile LAS unsigned*)((LAS char*)shm + LDS_XB_OFF);
  if (threadIdx.x == 0) { xst[0] = 0u; xst[1] = 0u; xst[2] = 0u; xst[3] = 0u; }
  __syncthreads();
  const XcdBarrier xbar = xcd_barrier_post((unsigned*)(p.ws + OFF_BAR), xst);
#define BLOCK_IDS                                   \
  int bid = blockIdx.x, G = gridDim.x;              \
  asm volatile("" : "+s"(bid), "+s"(G));            \
  const int NGW = G * 8; (void)NGW;
#define PHASE_PTRS \
  unsigned long long zo_ = 0; \
  asm volatile("" : "+s"(zo_)); \
  unsigned char* wsb = p.ws + zo_; \
  float* HRES = (float*)(wsb + OFF_HRES); \
  bf16_t* HN = (bf16_t*)(wsb + OFF_HN); \
  bf16_t* PROJ = (bf16_t*)(wsb + OFF_PROJ); \
  bf16_t* CKV = (bf16_t*)(wsb + OFF_CKV); \
  bf16_t* KIDX = (bf16_t*)(wsb + OFF_KIDX); \
  bf16_t* YPOOL = (bf16_t*)(wsb + OFF_YPOOL); \
  bf16_t* YP2 = (bf16_t*)(wsb + OFF_YP2); \
  bf16_t* QLAT = (bf16_t*)(wsb + OFF_QLAT); \
  bf16_t* OLAT = (bf16_t*)(wsb + OFF_OLAT); \
  bf16_t* OB = (bf16_t*)(wsb + OFF_O); \
  float* MB = (float*)(wsb + OFF_MB); \
  bf16_t* MERGED = (bf16_t*)(wsb + OFF_MERGED); \
  bf16_t* WIN = (bf16_t*)(wsb + OFF_WIN); \
  bf16_t* WUK = (bf16_t*)(wsb + OFF_WUK); \
  bf16_t* WUV = (bf16_t*)(wsb + OFF_WUV); \
  bf16_t* WAO = (bf16_t*)(wsb + OFF_WAO); \
  bf16_t* WPOOL = (bf16_t*)(wsb + OFF_WPOOL); \
  bf16_t* WPO = (bf16_t*)(wsb + OFF_WPO); \
  bf16_t* WOUT = (bf16_t*)(wsb + OFF_WOUT); \
  bf16_t* WMI = (bf16_t*)(wsb + OFF_WMI); \
  bf16_t* WMO = (bf16_t*)(wsb + OFF_WMO); \
  bf16_t* UB = PROJ; \
  (void)HRES; (void)HN; (void)CKV; (void)KIDX; (void)YPOOL; (void)YP2; (void)QLAT; (void)OLAT; (void)OB; (void)MB; (void)MERGED; (void)WIN; (void)WUK; (void)WUV; (void)WAO; (void)WPOOL; (void)WPO; (void)WOUT; (void)WMI; (void)WMO; (void)UB;
#define PHASE_IDS                                  \
  int tid = wave_s * 64 + lane_id();               \
  asm volatile("" : "+v"(tid));                    \
  const int wave = tid >> 6, lane = tid & 63, gw = bid * 8 + wave; \
  (void)lane; (void)gw; \
  PHASE_PTRS


#pragma unroll 1
  for (int l = 0; l < DEPTH; ++l) {
    BLOCK_IDS
    for (int rep = 0; rep < REP_P1; ++rep) {
      PHASE_IDS
      if (l == 0) {
        const float* g0 = p.in[2];
        for (int r = gw; r < NKEYS; r += NGW) {
          const float* src = (r < NMETA) ? p.in[1] + (size_t)r * D : p.in[0] + (size_t)(r - NMETA) * D;
          f32x4 v[8];
          float sq = 0.f;
#pragma unroll
          for (int j = 0; j < 8; ++j) {
            v[j] = __builtin_nontemporal_load((const f32x4*)(src + j * 256 + lane * 4));
            sq += v[j][0] * v[j][0] + v[j][1] * v[j][1] + v[j][2] * v[j][2] + v[j][3] * v[j][3];
          }
#pragma unroll
          for (int o = 1; o < 64; o <<= 1) sq += shx(sq, o, lane);
          const float rs = rsqrtf(sq * (1.0f / D) + 1e-6f);
#pragma unroll
          for (int j = 0; j < 8; ++j) {
            *(f32x4*)(HRES + (size_t)r * D + j * 256 + lane * 4) = v[j];
            const f32x4 gg = *(const f32x4*)(g0 + j * 256 + lane * 4);
            uint2 o2;
            o2.x = pk2(v[j][0] * rs * gg[0], v[j][1] * rs * gg[1]); o2.y = pk2(v[j][2] * rs * gg[2], v[j][3] * rs * gg[3]);
            *(uint2*)(HN + (size_t)r * D + j * 256 + lane * 4) = o2;
          }
        }
      } else {
        rmsnorm_rows(HRES, p.in[2] + (size_t)l * D, HN, gw, NGW, lane);
      }
      wconv_T(p.in[3] + (size_t)l * D * NIN, D, NIN, NINP, WIN, D, 1, 0, 0, 1.0f, wave_s);
      wconv_T(p.in[7] + (size_t)l * 16 * 256 * 128, 256, 128, 256, WUV, 256, 16, (size_t)256 * 128, (size_t)65536, 1.0f, wave_s);
      wconv_T(p.in[8] + (size_t)l * D * D, D, D, D, WAO, D, 1, 0, 0, 1.0f, wave_s, true);
      wconv_T(p.in[9] + (size_t)l * 4 * 65536, 256, 256, 256, WPOOL, 256, 4, (size_t)65536, (size_t)65536, 1.0f, wave_s);
      wconv_T(p.in[11] + (size_t)l * 1024 * D, 1024, D, D, WPO, 1024, 1, 0, 0, 1.0f, wave_s);
      wconv_T(p.in[12] + (size_t)l * D * D, D, D, D, WOUT, D, 1, 0, 0, 1.0f, wave_s, true);
      wconv_T(p.in[14] + (size_t)l * D * DFF, D, DFF, DFF, WMI, D, 1, 0, 0, 1.0f, wave_s, true);
      wconv_T(p.in[15] + (size_t)l * DFF * D, DFF, D, D, WMO, DFF, 1, 0, 0, 1.0f, wave_s, true);
      {
        const float* wuk = p.in[6] + (size_t)l * 16 * 256 * 128;
        const float sc = 0.08838834764831845f * 1.4426950408889634f;
        for (int i = bid * 512 + tid; i < 16 * 256 * 32; i += G * 512) {
          const int row = i >> 5, kc = (i & 31) * 8;
          uint4 o = make_uint4(0u, 0u, 0u, 0u);
          if (kc < 128) {
            const f32x4 a = __builtin_nontemporal_load((const f32x4*)(wuk + (size_t)row * 128 + kc));
            const f32x4 b = __builtin_nontemporal_load((const f32x4*)(wuk + (size_t)row * 128 + kc + 4));
            o.x = pk2(a[0] * sc, a[1] * sc); o.y = pk2(a[2] * sc, a[3] * sc);
            o.z = pk2(b[0] * sc, b[1] * sc); o.w = pk2(b[2] * sc, b[3] * sc);
          }
          *(uint4*)(WUK + (size_t)row * 256 + kc) = o;
        }
      }
    }
    if (l == 0) grid.sync();
    else xcd_barrier(xbar, wave_s);

    {
      PHASE_PTRS
      auto epi = [&](int row, int col, f32x4 v) {
        uint2 o; o.x = pk2(v[0], v[1]); o.y = pk2(v[2], v[3]);
        *(uint2*)(PROJ + (size_t)row * NINP + col) = o;
      };
      auto epi8 = [&](int row, int col, f32x4 a, f32x4 b) {
        uint4 o; o.x = pk2(a[0], a[1]); o.y = pk2(a[2], a[3]); o.z = pk2(b[0], b[1]); o.w = pk2(b[2], b[3]);
        *(uint4*)(PROJ + (size_t)row * NINP + col) = o;
      };
      const int nN = NINP / 256, ntiles = NMT * nN;
      for (int t = bid; t < ntiles; t += G) {
        int pm, pn; tile_map(t, NMT, nN, pm, pn);
        gemm_tile(HN, D, WIN, D, pm * 256, pn * 256, D, epi8, wave_s);
      }
      tail_gemm8(HN + (size_t)TAIL0 * D, D, WIN, D, NINP / 16, D, epi, wave_s);
    }
    xcd_barrier(xbar, wave_s);

    {
      PHASE_IDS
      const float* gkv = p.in[4] + (size_t)l * 256;
      const float* gik = p.in[5] + (size_t)l * 64;
      for (int r = gw; r < NKEYS; r += NGW) {
        const bf16_t* pr = PROJ + (size_t)r * NINP;
        {
          const uint2 raw = *(const uint2*)(pr + C_CKV + lane * 4);
          float a0 = bf2f(raw.x & 0xffff), a1 = bf2f(raw.x >> 16), a2 = bf2f(raw.y & 0xffff), a3 = bf2f(raw.y >> 16);
          float s = wave_sum(a0 * a0 + a1 * a1 + a2 * a2 + a3 * a3, lane);
          const float rs = rsqrtf(s * (1.0f / 256.0f) + 1e-6f);
          const float4 gg = *(const float4*)(gkv + lane * 4);
          uint2 o; o.x = pk2(a0 * rs * gg.x, a1 * rs * gg.y); o.y = pk2(a2 * rs * gg.z, a3 * rs * gg.w);
          *(uint2*)(CKV + (size_t)r * 256 + lane * 4) = o;
        }
        {
          const float a = bf2f(pr[C_KIDX + lane]);
          const float s = wave_sum(a * a, lane);
          const float rs = rsqrtf(s * (1.0f / 64.0f) + 1e-6f);
          KIDX[((size_t)((r >> 5) * 4 + (lane >> 4)) * 64 + ((lane >> 3) & 1) * 32 + (r & 31)) * 8 + (lane & 7)] = f2bf(a * rs * gik[lane]);
        }
        pool_group<0>(PROJ, YPOOL, r, lane);
        pool_group<1>(PROJ, YPOOL, r, lane);
        pool_group<2>(PROJ, YPOOL, r, lane);
        pool_group<3>(PROJ, YPOOL, r, lane);
      }
      const int ntiles = 16 * NMT;
      for (int t = bid; t < ntiles; t += G) {
        const int h = t / NMT, pm = t % NMT;
        auto epi8 = [&](int row, int col, f32x4 a, f32x4 b) {
          uint4 o; o.x = pk2(a[0], a[1]); o.y = pk2(a[2], a[3]); o.z = pk2(b[0], b[1]); o.w = pk2(b[2], b[3]);
          *(uint4*)(QLAT + (size_t)row * 4096 + h * 256 + col) = o;
        };
        gemm_tile(PROJ + h * 128, NINP, WUK + (size_t)h * 65536, 256, pm * 256, 0, 256, epi8, wave_s);
      }
      int tid2 = wave_s * 64 + lane_id();
      asm volatile("" : "+v"(tid2));
      const int lane2 = tid2 & 63, gw2 = bid * 8 + (tid2 >> 6);
      for (int task = gw2; task < 16 * 16; task += NGW) {
        const int h = task >> 4, ct = task & 15;
        auto epi = [&](int row, int col, f32x4 v) {
          uint2 o; o.x = pk2(v[0], v[1]); o.y = pk2(v[2], v[3]);
          *(uint2*)(QLAT + (size_t)row * 4096 + h * 256 + col) = o;
        };
        tail_tile1(PROJ + (size_t)TAIL0 * NINP + h * 128, NINP, WUK + (size_t)h * 65536, 256, ct, 128, lane2, epi);
      }
    }
    xcd_barrier(xbar, wave_s);

    {
      PHASE_IDS
      unsigned* SC = (unsigned*)shm;
      int* IDX = (int*)((char*)shm + LDS_IDX_OFF);
      int* CAND = (int*)((char*)shm + LDS_CAND_OFF);
      const int nunits = NKEYS / 4;
      unsigned* qctr = (unsigned*)(wsb + OFF_BAR) + 3520 + 64 * l;
      volatile int* QW = (volatile int*)((char*)shm + LDS_XCH_OFF) + 32;
      unsigned* HIST = (unsigned*)CAND;
      {
        u32x4* hz = (u32x4*)HIST + tid * 2;
        unsigned z = 0u;
        asm volatile("" : "+v"(z));
        hz[0] = (u32x4){z, z, z, z}; hz[1] = (u32x4){z, z, z, z};
      }
      int tkt;
      {
        if (wave == 0 && lane == 0) *QW = (int)__hip_atomic_fetch_add(qctr, 1u, __ATOMIC_RELAXED, __HIP_MEMORY_SCOPE_AGENT);
        __syncthreads();
        tkt = __builtin_amdgcn_readfirstlane(*QW);
      }
#pragma unroll 1
      while (tkt < nunits) {
        int nxt = 0;
        if (wave == 0 && lane == 0) nxt = (int)__hip_atomic_fetch_add(qctr, 1u, __ATOMIC_RELAXED, __HIP_MEMORY_SCOPE_AGENT);
        const int u = nunits - 1 - tkt;
        int lane_u_ = lane;
        asm volatile("" : "+v"(lane_u_));
        const int lane = lane_u_;
        const int q0 = u * 4;
        const int nk = q0 + 4;
        const int nit = (nk + 255) >> 8;
        const int ntile = nit * 8;
        for (int rsc = 0; rsc < REP_SC; ++rsc) {
          const int r = lane & 31, kg = lane >> 5, qi = r & 3, head = r >> 2;
          bf16x8 qa[4];
          const bf16_t* qp = PROJ + (size_t)(q0 + qi) * NINP + C_QIDX + head * 64 + kg * 8;
#pragma unroll
          for (int ks = 0; ks < 4; ++ks) qa[ks] = *(const bf16x8*)(qp + ks * 16);
          float wv[4][4];
#pragma unroll
          for (int i = 0; i < 4; ++i)
#pragma unroll
            for (int j = 0; j < 4; ++j) wv[i][j] = bf2f(PROJ[(size_t)(q0 + j) * NINP + C_WIDX + 2 * i + kg]);
          const unsigned klane = (unsigned)lane * 8u;
          bf16x8 kbuf[4][4];
#pragma unroll
          for (int pi = 0; pi < 3; ++pi) {
            const int tp = wave_s + 8 * ((pi < nit) ? pi : nit - 1);
#pragma unroll
            for (int ks = 0; ks < 4; ++ks) kbuf[pi][ks] = *(const bf16x8*)(KIDX + (size_t)(tp * 4 + ks) * 512 + klane);
          }
          for (int base = 0; base < nit; base += 4) {
#pragma unroll
            for (int uu = 0; uu < 4; ++uu) {
              const int i = (base + uu < nit) ? base + uu : nit - 1;
              {
                {
                  const int ip = (base + uu + 3 < nit) ? base + uu + 3 : nit - 1;
                  const int tp = wave_s + 8 * ip;
#pragma unroll
                  for (int ks = 0; ks < 4; ++ks) kbuf[(uu + 3) % 4][ks] = *(const bf16x8*)(KIDX + (size_t)(tp * 4 + ks) * 512 + klane);
                }
                if (base + uu < nit) {
                const int tt = wave_s + 8 * i;
                const int key = tt * 32 + r;
                f32x16 acc;
#pragma unroll
                for (int q = 0; q < 16; ++q) acc[q] = 0.f;
#pragma unroll
                for (int ks = 0; ks < 4; ++ks) acc = __builtin_amdgcn_mfma_f32_32x32x16_bf16(qa[ks], kbuf[uu][ks], acc, 0, 0, 0);
#define RELU_(x) __int_as_float(max(__float_as_int(x), 0))
                const float p0 = wv[0][0] * RELU_(acc[0]) + wv[1][0] * RELU_(acc[4]) + wv[2][0] * RELU_(acc[8]) + wv[3][0] * RELU_(acc[12]);
                const float p1 = wv[0][1] * RELU_(acc[1]) + wv[1][1] * RELU_(acc[5]) + wv[2][1] * RELU_(acc[9]) + wv[3][1] * RELU_(acc[13]);
                const float p2 = wv[0][2] * RELU_(acc[2]) + wv[1][2] * RELU_(acc[6]) + wv[2][2] * RELU_(acc[10]) + wv[3][2] * RELU_(acc[14]);
                const float p3 = wv[0][3] * RELU_(acc[3]) + wv[1][3] * RELU_(acc[7]) + wv[2][3] * RELU_(acc[11]) + wv[3][3] * RELU_(acc[15]);
#undef RELU_
                const auto r02 = __builtin_amdgcn_permlane32_swap(__float_as_uint(p0), __float_as_uint(p2), false, false);
                const auto r13 = __builtin_amdgcn_permlane32_swap(__float_as_uint(p1), __float_as_uint(p3), false, false);
                const float sa = __uint_as_float(r02[0]) + __uint_as_float(r02[1]);
                const float sb = __uint_as_float(r13[0]) + __uint_as_float(r13[1]);
#pragma unroll
                for (int jj = 0; jj < 2; ++jj) {
                  const int j = kg * 2 + jj;
                  const float s = (jj ? sb : sa) + 0.0f;
                  unsigned ub = __float_as_uint(s);
                  ub ^= (unsigned)((int)ub >> 31) | 0x80000000u;
                  if (key > q0 + j) ub = 0u;
                  SC[j * SCLD + key] = ub;
                  if (ub != 0u) {
                    const unsigned bin = ub >> 21;
                    __hip_atomic_fetch_add(HIST + j * 1024 + (bin >> 1), 1u << ((bin & 1u) * 16u), __ATOMIC_RELAXED, __HIP_MEMORY_SCOPE_WORKGROUP);
                  }
                }
                }
              }
            }
          }
        }
        __syncthreads();
        for (int rsel = 0; rsel < REP_SEL; ++rsel) {
          const int j = wave & 3, half = wave >> 2, qpos = q0 + j, nvalid = qpos + 1;
          const bool big = nvalid > 256;
          int* idx = IDX + j * 256;
          int* cand = CAND + (j * 2 + half) * CAND_CAP2;
          int* XCH = (int*)((char*)shm + LDS_XCH_OFF);
          const unsigned* sc1 = SC + j * SCLD;
          const uint4* sc4 = (const uint4*)sc1;
          const int nh = (nit + 1) >> 1;
          const int g0 = half ? nh : 0, g1 = half ? nit : nh;
          unsigned prefix = 0u;
          if (big) {
            const u32x4* hq = (const u32x4*)(HIST + j * 1024) + lane * 4;
            const u32x4 w0 = hq[0], w1 = hq[1], w2 = hq[2], w3 = hq[3];
            unsigned cw[16];
#pragma unroll
            for (int q = 0; q < 4; ++q) { cw[q] = w0[q]; cw[4 + q] = w1[q]; cw[8 + q] = w2[q]; cw[12 + q] = w3[q]; }
            int sl = 0;
#pragma unroll
            for (int q = 0; q < 16; ++q) sl += (int)(cw[q] & 0xffffu) + (int)(cw[q] >> 16);
            int S = sl;
#pragma unroll
            for (int o = 1; o < 64; o <<= 1) {
              const int tv = __builtin_amdgcn_ds_bpermute(((lane + o) & 63) << 2, S);
              if (lane + o < 64) S += tv;
            }
            const int L = __popcll(__ballot(S >= 256)) - 1;
            int run = S - sl, found = -1;
#pragma unroll
            for (int bb = 31; bb >= 0; --bb) {
              run += (bb & 1) ? (int)(cw[bb >> 1] >> 16) : (int)(cw[bb >> 1] & 0xffffu);
              if (run >= 256 && found < 0) found = bb;
            }
            const int fb = __builtin_amdgcn_readlane(found, L);
            prefix = (unsigned)(L * 32 + fb) << 21;
          }
          __syncthreads();
          const unsigned P = prefix >> 21;
          int c = 0, m = 0;
          if (big) {
            for (int it = g0 * 4; it < g1 * 4; it += 4) {
              unsigned x[4];
#pragma unroll
              for (int e = 0; e < 4; ++e) x[e] = sc1[(it + e) * 64 + lane];
#pragma unroll
              for (int e = 0; e < 4; ++e) {
                const unsigned t = x[e] >> 21;
                const bool isA = t > P, isB = t == P;
                const unsigned long long mA = __ballot(isA), mB = __ballot(isB);
                const int oA = __builtin_amdgcn_mbcnt_hi((unsigned)(mA >> 32), __builtin_amdgcn_mbcnt_lo((unsigned)mA, 0u));
                const int oB = __builtin_amdgcn_mbcnt_hi((unsigned)(mB >> 32), __builtin_amdgcn_mbcnt_lo((unsigned)mB, 0u));
                if (isA) idx[half ? (255 - (c + oA)) : (c + oA)] = (it + e) * 64 + lane;
                if (isB && (m + oB) < CAND_CAP2) cand[m + oB] = (it + e) * 64 + lane;
                c += __popcll(mA);
                m += __popcll(mB);
              }
            }
          }
          if (lane == 0) { XCH[16 + wave * 2] = c; XCH[16 + wave * 2 + 1] = m; }
          __syncthreads();
          if (half == 0) {
            if (!big) {
              for (int i = lane; i < 256; i += 64) idx[i] = (i < nvalid) ? i : 0;
            } else {
              const int cB = XCH[16 + (wave + 4) * 2], mB = XCH[16 + (wave + 4) * 2 + 1];
              const int mA = m, mt = mA + mB;
              const int* candB = CAND + (j * 2 + 1) * CAND_CAP2;
              if (mA <= CAND_CAP2 && mB <= CAND_CAP2) {
                const int need = 256 - c - cB;
                unsigned T = prefix;
                auto fine = [&](auto KMtag) {
                  constexpr int KM = decltype(KMtag)::value;
                  unsigned cv[KM];
                  int ci[KM];
#pragma unroll
                  for (int k = 0; k < KM; ++k) {
                    const int i = k * 64 + lane;
                    ci[k] = (i < mA) ? cand[i] : ((i < mt) ? candB[i - mA] : 0);
                    cv[k] = (i < mt) ? sc1[ci[k]] : 0u;
                  }
                  for (int bit = 20; bit >= 0; --bit) {
                    const unsigned cd = T | (1u << bit);
                    int cnt = 0;
#pragma unroll
                    for (int k = 0; k < KM; ++k) cnt += __popcll(__ballot(cv[k] >= cd));
                    if (cnt >= need) T = cd;
                  }
                  int pos = c;
#pragma unroll
                  for (int k = 0; k < KM; ++k) {
                    const bool sel = cv[k] > T;
                    const unsigned long long mk = __ballot(sel);
                    const int off = __builtin_amdgcn_mbcnt_hi((unsigned)(mk >> 32), __builtin_amdgcn_mbcnt_lo((unsigned)mk, 0u));
                    if (sel) idx[pos + off] = ci[k];
                    pos += __popcll(mk);
                  }
                  const int lim = 256 - cB;
#pragma unroll
                  for (int k = 0; k < KM; ++k) {
                    const bool sel = cv[k] == T;
                    const unsigned long long mk = __ballot(sel);
                    const int off = __builtin_amdgcn_mbcnt_hi((unsigned)(mk >> 32), __builtin_amdgcn_mbcnt_lo((unsigned)mk, 0u));
                    if (sel && (pos + off) < lim) idx[pos + off] = ci[k];
                    pos += __popcll(mk);
                  }
                };
                if (mt <= 256) fine(std::integral_constant<int, 4>{});
                else fine(std::integral_constant<int, (2 * CAND_CAP2) / 64>{});
              } else {
                unsigned pf = 0u;
                for (int bit = 31; bit >= 0; --bit) {
                  const unsigned cd = pf | (1u << bit);
                  int cnt = 0;
                  for (int it = 0; it < nit; ++it) {
                    const uint4 v = sc4[it * 64 + lane];
                    cnt += __popcll(__ballot(v.x >= cd)) + __popcll(__ballot(v.y >= cd)) + __popcll(__ballot(v.z >= cd)) + __popcll(__ballot(v.w >= cd));
                  }
                  if (cnt >= 256) pf = cd;
                }
                const unsigned T = pf;
                int c2 = 0;
                const int nit64 = nit * 4;
                for (int it = 0; it < nit64; ++it) {
                  const unsigned x = sc1[it * 64 + lane];
                  const bool sel = x > T;
                  const unsigned long long mask = __ballot(sel);
                  const int off = __builtin_amdgcn_mbcnt_hi((unsigned)(mask >> 32), __builtin_amdgcn_mbcnt_lo((unsigned)mask, 0u));
                  if (sel) idx[c2 + off] = it * 64 + lane;
                  c2 += __popcll(mask);
                }
                for (int it = 0; it < nit64 && c2 < 256; ++it) {
                  const unsigned x = sc1[it * 64 + lane];
                  const bool sel = x == T;
                  const unsigned long long mask = __ballot(sel);
                  const int off = __builtin_amdgcn_mbcnt_hi((unsigned)(mask >> 32), __builtin_amdgcn_mbcnt_lo((unsigned)mask, 0u));
                  if (sel && (c2 + off) < 256) idx[c2 + off] = it * 64 + lane;
                  c2 += __popcll(mask);
                }
              }
            }
          }
          if (rsel + 1 < REP_SEL) __syncthreads();
        }
        __syncthreads();
        {
          u32x4* hz = (u32x4*)HIST + (wave * 64 + lane) * 2;
          unsigned z = 0u;
          asm volatile("" : "+v"(z));
          hz[0] = (u32x4){z, z, z, z}; hz[1] = (u32x4){z, z, z, z};
        }
        for (int ratt = 0; ratt < REP_ATT; ++ratt) {
          if (ratt) __syncthreads();
          const int j = wave & 3, half = wave >> 2, qpos = q0 + j;
          const int nsel = (qpos + 1) < 256 ? (qpos + 1) : 256;
          const int* idx = IDX + j * 256;
          bf16_t* ST = (bf16_t*)((char*)shm + wave * (32 * ST_LD * 2));
          float* XF = (float*)ST;
          const int fr = lane & 15, fq = lane >> 4;
          bf16x8 qb[8];
          const bf16_t* qlp = QLAT + (size_t)qpos * 4096 + fr * 256 + fq * 8;
#pragma unroll
          for (int ks = 0; ks < 8; ++ks) qb[ks] = *(const bf16x8*)(qlp + ks * 32);
          f32x4 o[16];
#pragma unroll
          for (int i = 0; i < 16; ++i) o[i] = (f32x4){0.f, 0.f, 0.f, 0.f};
          float mrun = -INFINITY, lrun = 0.f;
          const int nchunk = (nsel + 31) >> 5, nfirst = (nchunk + 1) >> 1;
          const int cb = half ? nfirst : 0, ce = half ? nchunk : nfirst;
          const unsigned st_base = (unsigned)(size_t)(__attribute__((address_space(3))) char*)ST;
          const unsigned tr_addr = st_base + (unsigned)(((fq * 4 + (fr >> 2)) * ST_LD + (fr & 3) * 4) * 2);
          bf16x8 ar[2][8];
          {
            const int c0 = (cb < ce) ? cb : 0;
#pragma unroll
            for (int tt = 0; tt < 2; ++tt) {
              const bf16_t* kr = CKV + (size_t)idx[c0 * 32 + tt * 16 + fr] * 256 + fq * 8;
#pragma unroll
              for (int ks = 0; ks < 8; ++ks) ar[tt][ks] = *(const bf16x8*)(kr + ks * 32);
            }
          }
          for (int ch = cb; ch < ce; ++ch) {
            f32x4 s[2];
#pragma unroll
            for (int tt = 0; tt < 2; ++tt) {
              s[tt] = (f32x4){0.f, 0.f, 0.f, 0.f};
#pragma unroll
              for (int ks = 0; ks < 8; ++ks) s[tt] = __builtin_amdgcn_mfma_f32_16x16x32_bf16(ar[tt][ks], qb[ks], s[tt], 0, 0, 0);
            }
#pragma unroll
            for (int tt = 0; tt < 2; ++tt)
#pragma unroll
              for (int ks = 0; ks < 8; ++ks) *(bf16x8*)(ST + (tt * 16 + fr) * ST_LD + ks * 32 + fq * 8) = ar[tt][ks];
            asm volatile("s_waitcnt lgkmcnt(0)" ::: "memory");
            __builtin_amdgcn_wave_barrier();
            {
              const int cn = (ch + 1 < ce) ? ch + 1 : ch;
#pragma unroll
              for (int tt = 0; tt < 2; ++tt) {
                const bf16_t* kr = CKV + (size_t)idx[cn * 32 + tt * 16 + fr] * 256 + fq * 8;
#pragma unroll
                for (int ks = 0; ks < 8; ++ks) ar[tt][ks] = *(const bf16x8*)(kr + ks * 32);
              }
            }
            if (nsel < 256) {
#pragma unroll
              for (int tt = 0; tt < 2; ++tt)
#pragma unroll
                for (int e = 0; e < 4; ++e)
                  if (ch * 32 + tt * 16 + fq * 4 + e >= nsel) s[tt][e] = -INFINITY;
            }
            float mx = fmaxf(fmaxf(fmaxf(s[0][0], s[0][1]), fmaxf(s[0][2], s[0][3])), fmaxf(fmaxf(s[1][0], s[1][1]), fmaxf(s[1][2], s[1][3])));
            mx = fmaxf(mx, shx(mx, 16, lane));
            mx = fmaxf(mx, shx(mx, 32, lane));
            const float mnew = fmaxf(mrun, mx);
            const float alpha = __builtin_amdgcn_exp2f(mrun - mnew);
            float ps = 0.f;
            float pv[8];
#pragma unroll
            for (int tt = 0; tt < 2; ++tt)
#pragma unroll
              for (int e = 0; e < 4; ++e) {
                const float pe = __builtin_amdgcn_exp2f(s[tt][e] - mnew);
                pv[tt * 4 + e] = pe;
                ps += pe;
              }
            ps += shx(ps, 16, lane);
            ps += shx(ps, 32, lane);
            lrun = lrun * alpha + ps;
            mrun = mnew;
            union { bf16x8 v; unsigned u[4]; } pb;
            pb.u[0] = pk2(pv[0], pv[1]); pb.u[1] = pk2(pv[2], pv[3]); pb.u[2] = pk2(pv[4], pv[5]); pb.u[3] = pk2(pv[6], pv[7]);
#pragma unroll
            for (int rt = 0; rt < 16; ++rt) o[rt] *= alpha;
#pragma unroll
            for (int rb = 0; rb < 4; ++rb) {
              union { bf16x8 v; u16x4 h[2]; } va[4];
              asm volatile(
                  "ds_read_b64_tr_b16 %0, %8 offset:%9\n\t"
                  "ds_read_b64_tr_b16 %1, %8 offset:%10\n\t"
                  "ds_read_b64_tr_b16 %2, %8 offset:%11\n\t"
                  "ds_read_b64_tr_b16 %3, %8 offset:%12\n\t"
                  "ds_read_b64_tr_b16 %4, %8 offset:%13\n\t"
                  "ds_read_b64_tr_b16 %5, %8 offset:%14\n\t"
                  "ds_read_b64_tr_b16 %6, %8 offset:%15\n\t"
                  "ds_read_b64_tr_b16 %7, %8 offset:%16\n\t"
                  "s_waitcnt lgkmcnt(0)"
                  : "=&v"(va[0].h[0]), "=&v"(va[0].h[1]), "=&v"(va[1].h[0]), "=&v"(va[1].h[1]),
                    "=&v"(va[2].h[0]), "=&v"(va[2].h[1]), "=&v"(va[3].h[0]), "=&v"(va[3].h[1])
                  : "v"(tr_addr),
                    "i"((rb * 4 + 0) * 32), "i"((rb * 4 + 0) * 32 + 16 * ST_LD * 2),
                    "i"((rb * 4 + 1) * 32), "i"((rb * 4 + 1) * 32 + 16 * ST_LD * 2),
                    "i"((rb * 4 + 2) * 32), "i"((rb * 4 + 2) * 32 + 16 * ST_LD * 2),
                    "i"((rb * 4 + 3) * 32), "i"((rb * 4 + 3) * 32 + 16 * ST_LD * 2)
                  : "memory");
#pragma unroll
              for (int q = 0; q < 4; ++q)
                o[rb * 4 + q] = __builtin_amdgcn_mfma_f32_16x16x32_bf16(va[q].v, pb.v, o[rb * 4 + q], 0, 0, 0);
            }
            asm volatile("s_waitcnt lgkmcnt(0)" ::: "memory");
            __builtin_amdgcn_wave_barrier();
          }
          if (half == 1) {
            XF[lane] = mrun;
            XF[64 + lane] = lrun;
#pragma unroll
            for (int rt = 0; rt < 16; ++rt)
#pragma unroll
              for (int e = 0; e < 4; ++e) XF[(2 + rt * 4 + e) * 64 + lane] = o[rt][e];
          }
          __syncthreads();
          if (half == 0) {
            const float* XP = (const float*)((char*)shm + (wave + 4) * (32 * ST_LD * 2));
            const float m1 = XP[lane], l1 = XP[64 + lane];
            const float mm = fmaxf(mrun, m1);
            const float a0 = __builtin_amdgcn_exp2f(mrun - mm), a1 = __builtin_amdgcn_exp2f(m1 - mm);
            const float invl = 1.0f / (lrun * a0 + l1 * a1);
            const float w0 = a0 * invl, w1 = a1 * invl;
            bf16_t* op = OLAT + (size_t)qpos * 4096 + fr * 256 + fq * 4;
#pragma unroll
            for (int rt = 0; rt < 16; ++rt) {
              float r[4];
#pragma unroll
              for (int e = 0; e < 4; ++e) r[e] = o[rt][e] * w0 + XP[(2 + rt * 4 + e) * 64 + lane] * w1;
              uint2 w; w.x = pk2(r[0], r[1]); w.y = pk2(r[2], r[3]);
              *(uint2*)(op + rt * 16) = w;
            }
          }
        }
        if (wave == 0 && lane == 0) *QW = nxt;
        __syncthreads();
        tkt = __builtin_amdgcn_readfirstlane(*QW);
      }
      {
        const float* psc = p.in[10] + (size_t)l * 1024;
        const int ntiles = 4 * NMT;
        for (int t = bid; t < ntiles; t += G) {
          const int g = t / NMT, pm = t % NMT;
          auto epi8 = [&](int row, int col, f32x4 a, f32x4 b) {
            const float4 sa = *(const float4*)(psc + g * 256 + col), sb = *(const float4*)(psc + g * 256 + col + 4);
            uint4 o; o.x = pk2(a[0] * sa.x, a[1] * sa.y); o.y = pk2(a[2] * sa.z, a[3] * sa.w); o.z = pk2(b[0] * sb.x, b[1] * sb.y); o.w = pk2(b[2] * sb.z, b[3] * sb.w);
            *(uint4*)(YP2 + (size_t)row * 1024 + g * 256 + col) = o;
          };
          gemm_tile(YPOOL + g * 256, 1024, WPOOL + (size_t)g * 65536, 256, pm * 256, 0, 256, epi8, wave_s);
        }
        int tid2 = wave_s * 64 + lane_id();
        asm volatile("" : "+v"(tid2));
        const int lane2 = tid2 & 63, gw2 = bid * 8 + (tid2 >> 6);
        for (int task = gw2; task < 4 * 16; task += NGW) {
          const int g = task >> 4, ct = task & 15;
          auto epi = [&](int row, int col, f32x4 v) {
            const float4 sc = *(const float4*)(psc + g * 256 + col);
            uint2 o; o.x = pk2(v[0] * sc.x, v[1] * sc.y); o.y = pk2(v[2] * sc.z, v[3] * sc.w);
            *(uint2*)(YP2 + (size_t)row * 1024 + g * 256 + col) = o;
          };
          tail_tile1(YPOOL + (size_t)TAIL0 * 1024 + g * 256, 1024, WPOOL + (size_t)g * 65536, 256, ct, 256, lane2, epi);
        }
      }
    }
    xcd_barrier(xbar, wave_s);

    {
      PHASE_PTRS
      auto epib = [&](int row, int col, f32x4 v) {
        const uint2 raw = *(const uint2*)(PROJ + (size_t)row * NINP + C_GB + col);
        f32x4 o;
        o[0] = sigmoidf(bf2f(raw.x & 0xffff)) * v[0]; o[1] = sigmoidf(bf2f(raw.x >> 16)) * v[1];
        o[2] = sigmoidf(bf2f(raw.y & 0xffff)) * v[2]; o[3] = sigmoidf(bf2f(raw.y >> 16)) * v[3];
        *(f32x4*)(MB + (size_t)row * D + col) = o;
      };
      auto epib8 = [&](int row, int col, f32x4 a, f32x4 b) {
        const uint4 raw = *(const uint4*)(PROJ + (size_t)row * NINP + C_GB + col);
        f32x4 oa, ob;
        oa[0] = sigmoidf(bf2f(raw.x & 0xffff)) * a[0]; oa[1] = sigmoidf(bf2f(raw.x >> 16)) * a[1];
        oa[2] = sigmoidf(bf2f(raw.y & 0xffff)) * a[2]; oa[3] = sigmoidf(bf2f(raw.y >> 16)) * a[3];
        ob[0] = sigmoidf(bf2f(raw.z & 0xffff)) * b[0]; ob[1] = sigmoidf(bf2f(raw.z >> 16)) * b[1];
        ob[2] = sigmoidf(bf2f(raw.w & 0xffff)) * b[2]; ob[3] = sigmoidf(bf2f(raw.w >> 16)) * b[3];
        f32x4* mp = (f32x4*)(MB + (size_t)row * D + col);
        mp[0] = oa; mp[1] = ob;
      };
      const int n1 = 16 * NMT, n2 = NMT * 8;
      for (int t = bid; t < n1 + n2; t += G) {
        if (t < n1) {
          const int h = t / NMT, pm = t % NMT;
          auto epi8 = [&](int row, int col, f32x4 a, f32x4 b) {
            if (col < 128) {
              uint4 o; o.x = pk2(a[0], a[1]); o.y = pk2(a[2], a[3]); o.z = pk2(b[0], b[1]); o.w = pk2(b[2], b[3]);
              *(uint4*)(OB + (size_t)row * D + h * 128 + col) = o;
            }
          };
          gemm_tile(OLAT + h * 256, 4096, WUV + (size_t)h * 65536, 256, pm * 256, 0, 256, epi8, wave_s);
        } else {
          int pm, pn; tile_map(t - n1, NMT, 8, pm, pn);
          gemm_tile(YP2, 1024, WPO, 1024, pm * 256, pn * 256, 1024, epib8, wave_s);
        }
      }
      int tid2 = wave_s * 64 + lane_id();
      asm volatile("" : "+v"(tid2));
      const int lane2 = tid2 & 63, gw2 = bid * 8 + (tid2 >> 6);
      for (int task = gw2; task < 16 * 8; task += NGW) {
        const int h = task >> 3, ct = task & 7;
        auto epi = [&](int row, int col, f32x4 v) {
          uint2 o; o.x = pk2(v[0], v[1]); o.y = pk2(v[2], v[3]);
          *(uint2*)(OB + (size_t)row * D + h * 128 + col) = o;
        };
        tail_tile1(OLAT + (size_t)TAIL0 * 4096 + h * 256, 4096, WUV + (size_t)h * 65536, 256, ct, 256, lane2, epi);
      }
      tail_gemm8(YP2 + (size_t)TAIL0 * 1024, 1024, WPO, 1024, D / 16, 1024, epib, wave_s);
    }
    xcd_barrier(xbar, wave_s);

    {
      PHASE_PTRS
      auto epi = [&](int row, int col, f32x4 v) {
        const uint2 raw = *(const uint2*)(PROJ + (size_t)row * NINP + C_GA + col);
        const f32x4 mb = *(const f32x4*)(MB + (size_t)row * D + col);
        uint2 o;
        o.x = pk2(sigmoidf(bf2f(raw.x & 0xffff)) * v[0] + mb[0], sigmoidf(bf2f(raw.x >> 16)) * v[1] + mb[1]);
        o.y = pk2(sigmoidf(bf2f(raw.y & 0xffff)) * v[2] + mb[2], sigmoidf(bf2f(raw.y >> 16)) * v[3] + mb[3]);
        *(uint2*)(MERGED + (size_t)row * D + col) = o;
      };
      auto epi8 = [&](int row, int col, f32x4 a, f32x4 b) {
        const uint4 raw = *(const uint4*)(PROJ + (size_t)row * NINP + C_GA + col);
        const f32x4* mp = (const f32x4*)(MB + (size_t)row * D + col);
        const f32x4 ma = mp[0], mb = mp[1];
        uint4 o;
        o.x = pk2(sigmoidf(bf2f(raw.x & 0xffff)) * a[0] + ma[0], sigmoidf(bf2f(raw.x >> 16)) * a[1] + ma[1]);
        o.y = pk2(sigmoidf(bf2f(raw.y & 0xffff)) * a[2] + ma[2], sigmoidf(bf2f(raw.y >> 16)) * a[3] + ma[3]);
        o.z = pk2(sigmoidf(bf2f(raw.z & 0xffff)) * b[0] + mb[0], sigmoidf(bf2f(raw.z >> 16)) * b[1] + mb[1]);
        o.w = pk2(sigmoidf(bf2f(raw.w & 0xffff)) * b[2] + mb[2], sigmoidf(bf2f(raw.w >> 16)) * b[3] + mb[3]);
        *(uint4*)(MERGED + (size_t)row * D + col) = o;
      };
      for (int t = bid; t < NMT * 8; t += G) {
        int pm, pn; tile_map(t, NMT, 8, pm, pn);
        gemm_tile(OB, D, WAO, D, pm * 256, pn * 256, D, epi8, wave_s);
      }
      tail_gemm8(OB + (size_t)TAIL0 * D, D, WAO, D, D / 16, D, epi, wave_s);
    }
    xcd_barrier(xbar, wave_s);

    {
      PHASE_PTRS
      auto epi = [&](int row, int col, f32x4 v) {
        f32x4* hp = (f32x4*)(HRES + (size_t)row * D + col);
        *hp = *hp + v;
      };
      auto epi8 = [&](int row, int col, f32x4 a, f32x4 b) {
        f32x4* hp = (f32x4*)(HRES + (size_t)row * D + col);
        const f32x4 ha = hp[0], hb = hp[1];
        hp[0] = ha + a; hp[1] = hb + b;
      };
      for (int t = bid; t < NMT * 8; t += G) {
        int pm, pn; tile_map(t, NMT, 8, pm, pn);
        gemm_tile(MERGED, D, WOUT, D, pm * 256, pn * 256, D, epi8, wave_s);
      }
      tail_gemm8(MERGED + (size_t)TAIL0 * D, D, WOUT, D, D / 16, D, epi, wave_s);
    }
    xcd_barrier(xbar, wave_s);

    {
      PHASE_IDS
      rmsnorm_rows(HRES, p.in[13] + (size_t)l * D, HN, gw, NGW, lane);
    }
    xcd_barrier(xbar, wave_s);

    for (int rep = 0; rep < REP_P9; ++rep) {
      PHASE_PTRS
      auto epi = [&](int row, int col, f32x4 v) {
        float a0 = fmaxf(v[0], 0.f), a1 = fmaxf(v[1], 0.f), a2 = fmaxf(v[2], 0.f), a3 = fmaxf(v[3], 0.f);
        uint2 o; o.x = pk2(a0 * a0, a1 * a1); o.y = pk2(a2 * a2, a3 * a3);
        *(uint2*)(UB + (size_t)row * DFF + col) = o;
      };
      auto epi8 = [&](int row, int col, f32x4 a, f32x4 b) {
        const float a0 = fmaxf(a[0], 0.f), a1 = fmaxf(a[1], 0.f), a2 = fmaxf(a[2], 0.f), a3 = fmaxf(a[3], 0.f);
        const float b0 = fmaxf(b[0], 0.f), b1 = fmaxf(b[1], 0.f), b2 = fmaxf(b[2], 0.f), b3 = fmaxf(b[3], 0.f);
        uint4 o; o.x = pk2(a0 * a0, a1 * a1); o.y = pk2(a2 * a2, a3 * a3); o.z = pk2(b0 * b0, b1 * b1); o.w = pk2(b2 * b2, b3 * b3);
        *(uint4*)(UB + (size_t)row * DFF + col) = o;
      };
      const int nN = DFF / 256, ntiles = NMT * nN;
      for (int t = bid; t < ntiles; t += G) {
        int pm, pn; tile_map(t, NMT, nN, pm, pn);
        gemm_tile(HN, D, WMI, D, pm * 256, pn * 256, D, epi8, wave_s);
      }
      tail_gemm8(HN + (size_t)TAIL0 * D, D, WMI, D, DFF / 16, D, epi, wave_s);
    }
    xcd_barrier(xbar, wave_s);

    {
      PHASE_PTRS
      auto epi = [&](int row, int col, f32x4 v) {
        f32x4* hp = (f32x4*)(HRES + (size_t)row * D + col);
        *hp = *hp + v;
      };
      auto epi8 = [&](int row, int col, f32x4 a, f32x4 b) {
        f32x4* hp = (f32x4*)(HRES + (size_t)row * D + col);
        const f32x4 ha = hp[0], hb = hp[1];
        hp[0] = ha + a; hp[1] = hb + b;
      };
      for (int t = bid; t < NMT * 8; t += G) {
        int pm, pn; tile_map(t, NMT, 8, pm, pn);
        gemm_tile(UB, DFF, WMO, DFF, pm * 256, pn * 256, DFF, epi8, wave_s);
      }
      tail_gemm8(UB + (size_t)TAIL0 * DFF, DFF, WMO, DFF, D / 16, DFF, epi, wave_s);
    }
    xcd_barrier(xbar, wave_s);
  }

  {
    BLOCK_IDS
    PHASE_IDS
    const float* g = p.in[16];
    for (int r0 = gw; r0 < SEQ; r0 += NGW) {
      const int r = r0 + NMETA;
      float4 v[8];
      float s = 0.f;
#pragma unroll
      for (int j = 0; j < 8; ++j) {
        v[j] = *(const float4*)(HRES + (size_t)r * D + j * 256 + lane * 4);
        s += v[j].x * v[j].x + v[j].y * v[j].y + v[j].z * v[j].z + v[j].w * v[j].w;
      }
      s = wave_sum(s, lane);
      const float rs = rsqrtf(s * (1.0f / D) + 1e-6f);
#pragma unroll
      for (int j = 0; j < 8; ++j) {
        const float4 gg = *(const float4*)(g + j * 256 + lane * 4);
        __builtin_nontemporal_store((f32x4){v[j].x * rs * gg.x, v[j].y * rs * gg.y, v[j].z * rs * gg.z, v[j].w * rs * gg.w}, (f32x4*)(p.out + (size_t)r0 * D + j * 256 + lane * 4));
      }
    }
  }
}

extern "C" void kernel_launch(void* const* d_in, const int* in_sizes, int n_in, void* d_out, int out_size,
                              void* d_ws, size_t ws_size, hipStream_t stream) {
  static int grid_blocks = 0;
  if (!grid_blocks) {
    int dev = 0, cus = 0, per_cu = 0;
    (void)hipGetDevice(&dev);
    (void)hipDeviceGetAttribute(&cus, hipDeviceAttributeMultiprocessorCount, dev);
    (void)hipFuncSetAttribute((const void*)fwd, hipFuncAttributeMaxDynamicSharedMemorySize, LDS_BYTES);
    (void)hipOccupancyMaxActiveBlocksPerMultiprocessor(&per_cu, (const void*)fwd, 512, LDS_BYTES);
    (void)hipGetLastError();
    grid_blocks = cus > 0 ? cus : 256;
    if (ws_size < WS_END) { fprintf(stderr, "workspace too small: %zu < %zu\n", ws_size, (size_t)WS_END); grid_blocks = -1; }
  }
  if (grid_blocks < 0) return;
  Params p{};
  for (int i = 0; i < 17; ++i) p.in[i] = (const float*)d_in[i];
  p.out = (float*)d_out;
  p.ws = (unsigned char*)d_ws;
  (void)hipMemsetAsync((unsigned char*)d_ws + OFF_BAR, 0, BAR_BYTES, stream);
  void* args[] = {&p};
  hipError_t e = hipLaunchCooperativeKernel((void*)fwd, dim3(grid_blocks), dim3(512), args, LDS_BYTES, stream);
  if (e != hipSuccess) fprintf(stderr, "cooperative launch failed: %s (grid %d)\n", hipGetErrorString(e), grid_blocks);
}
```

```cpp
#include <hip/hip_runtime.h>
#include <hip/hip_bf16.h>
#include <hip/hip_cooperative_groups.h>
#include <cstdio>
#include <type_traits>
namespace cg = cooperative_groups;

typedef unsigned short bf16_t;
typedef short bf16x8 __attribute__((ext_vector_type(8)));
typedef float f32x4 __attribute__((ext_vector_type(4)));
typedef float f32x16 __attribute__((ext_vector_type(16)));
typedef unsigned short u16x4 __attribute__((ext_vector_type(4)));
typedef unsigned u32x4 __attribute__((ext_vector_type(4)));

constexpr int D = 2048, SEQ = 8192, NMETA = 16, NKEYS = SEQ + NMETA, MP = 8448, DEPTH = 4;
constexpr int NIN = 8008, NINP = 8192, DFF = 8192;
constexpr int C_CKV = 2048, C_QIDX = 2304, C_KIDX = 2816, C_WIDX = 2880, C_PIN = 2888, C_GA = 3912, C_GB = 5960;
constexpr int NMT = 32;
constexpr int TAIL0 = 8192;

constexpr size_t SZ_HRES = (size_t)MP * D * 4, SZ_HN = (size_t)MP * D * 2, SZ_PROJ = (size_t)MP * NINP * 2;
constexpr size_t OFF_HRES = 0;
constexpr size_t OFF_HN = OFF_HRES + SZ_HRES;
constexpr size_t OFF_PROJ = OFF_HN + SZ_HN;
constexpr size_t OFF_CKV = OFF_PROJ + SZ_PROJ;
constexpr size_t OFF_KIDX = OFF_CKV + (size_t)MP * 256 * 2;
constexpr size_t OFF_YPOOL = OFF_KIDX + (size_t)MP * 64 * 2;
constexpr size_t OFF_YP2 = OFF_YPOOL + (size_t)MP * 1024 * 2;
constexpr size_t OFF_QLAT = OFF_YP2 + (size_t)MP * 1024 * 2;
constexpr size_t OFF_OLAT = OFF_QLAT + (size_t)MP * 4096 * 2;
constexpr size_t OFF_O = OFF_OLAT + (size_t)MP * 4096 * 2;
constexpr size_t OFF_MB = OFF_O + (size_t)MP * D * 2;
constexpr size_t OFF_MERGED = OFF_MB + (size_t)MP * D * 4;
constexpr size_t OFF_WIN = OFF_MERGED + (size_t)MP * D * 2;
constexpr size_t OFF_WUK = OFF_WIN + (size_t)NINP * D * 2;
constexpr size_t OFF_WUV = OFF_WUK + (size_t)16 * 256 * 256 * 2;
constexpr size_t OFF_WAO = OFF_WUV + (size_t)16 * 256 * 256 * 2;
constexpr size_t OFF_WPOOL = OFF_WAO + (size_t)D * D * 2;
constexpr size_t OFF_WPO = OFF_WPOOL + (size_t)4 * 256 * 256 * 2;
constexpr size_t OFF_WOUT = OFF_WPO + (size_t)D * 1024 * 2;
constexpr size_t OFF_WMI = OFF_WOUT + (size_t)D * D * 2;
constexpr size_t OFF_WMO = OFF_WMI + (size_t)DFF * D * 2;
constexpr size_t OFF_BAR = OFF_WMO + (size_t)D * DFF * 2;
constexpr size_t BAR_BYTES = 16384;
constexpr size_t WS_END = OFF_BAR + BAR_BYTES;

constexpr int SCLD = 8448;
constexpr int ST_LD = 272;
constexpr int LDS_SC_BYTES = 4 * SCLD * 4;
constexpr int LDS_IDX_OFF = (8 * 32 * ST_LD * 2 > LDS_SC_BYTES) ? 8 * 32 * ST_LD * 2 : LDS_SC_BYTES;
constexpr int CAND_CAP = 1024;
constexpr int LDS_CAND_OFF = LDS_IDX_OFF + 4 * 256 * 4;
constexpr int LDS_XB_OFF = LDS_CAND_OFF + 4 * CAND_CAP * 4;
constexpr int LDS_XCH_OFF = LDS_XB_OFF + 16;
constexpr int CAND_CAP2 = CAND_CAP / 2;
constexpr int LDS_BYTES = LDS_XCH_OFF + 144;

#ifndef REP_P1
#define REP_P1 1
#endif
#ifndef REP_P4
#define REP_P4 1
#endif
#ifndef REP_SC
#define REP_SC 1
#endif
#ifndef REP_SEL
#define REP_SEL 1
#endif
#ifndef REP_ATT
#define REP_ATT 1
#endif
#ifndef REP_P9
#define REP_P9 1
#endif
struct Params {
  const float* in[17];
  float* out;
  unsigned char* ws;
};

__device__ __forceinline__ unsigned short f2bf(float f) {
  unsigned u = __float_as_uint(f);
  u += 0x7FFFu + ((u >> 16) & 1u);
  return (unsigned short)(u >> 16);
}
__device__ __forceinline__ float bf2f(unsigned short h) { return __uint_as_float(((unsigned)h) << 16); }
typedef float f32x2_t __attribute__((ext_vector_type(2)));
typedef __bf16 bf16x2_t __attribute__((ext_vector_type(2)));
__device__ __forceinline__ unsigned pk2(float a, float b) { const f32x2_t f = {a, b}; return __builtin_bit_cast(unsigned, __builtin_convertvector(f, bf16x2_t)); }
__device__ __forceinline__ float shx(float v, int o, int lane) { return __int_as_float(__builtin_amdgcn_ds_bpermute((lane ^ o) << 2, __float_as_int(v))); }
__device__ __forceinline__ int shxi(int v, int o, int lane) { return __builtin_amdgcn_ds_bpermute((lane ^ o) << 2, v); }
__device__ __forceinline__ float wave_sum(float v, int lane) {
#pragma unroll
  for (int o = 1; o < 64; o <<= 1) v += shx(v, o, lane);
  return v;
}
__device__ __forceinline__ int lane_id() { return (int)__builtin_amdgcn_mbcnt_hi(~0u, __builtin_amdgcn_mbcnt_lo(~0u, 0u)); }
__device__ __forceinline__ float sigmoidf(float x) { return __builtin_amdgcn_rcpf(1.0f + __builtin_amdgcn_exp2f(-1.4426950408889634f * x)); }

constexpr int BM = 256, BK = 64, HALF = 128, HT = HALF * BK;
__device__ __forceinline__ int lds_byte(int r, int c) {
  int st = (r >> 4) * 2 + (c >> 5), rr = r & 15, cc = c & 31, ob = rr * 64 + cc * 2;
  return st * 1024 + (ob ^ (((ob >> 9) & 1) << 5));
}
__device__ __forceinline__ void stage_rc(int b, int& R, int& C) {
  int st = b / 1024, sb = b % 1024, swz = sb ^ (((sb >> 9) & 1) << 5);
  R = (st >> 1) * 16 + swz / 64;
  C = (st & 1) * 32 + (swz % 64) / 2;
}

template <class Epi>
__device__ __forceinline__ void gemm_tile(const bf16_t* __restrict__ A, const int lda, const bf16_t* __restrict__ Bt, const int ldb,
                                          const int brow, const int bcol, const int K, const Epi& epi, const int wave_s) {
  extern __shared__ __attribute__((aligned(16))) bf16_t shm[];
#define SA(b, h) (shm + ((b) * 2 + (h)) * HT)
#define SB(b, h) (shm + (4 + (b) * 2 + (h)) * HT)
#define STAGE_A(P, br, kt)                                                                                                   \
  do {                                                                                                                       \
    const bf16_t* _g = A + (long)(br) * lda + (long)(kt) * BK;                                                               \
    __builtin_amdgcn_global_load_lds((const unsigned*)(_g + aoff0), (unsigned*)((char*)(P) + sb0), 16, 0, 0);               \
    __builtin_amdgcn_global_load_lds((const unsigned*)(_g + aoff1), (unsigned*)((char*)(P) + sb1), 16, 0, 0);               \
  } while (0)
#define STAGE_B(P, br, kt)                                                                                                   \
  do {                                                                                                                       \
    const bf16_t* _g = Bt + (long)(br) * ldb + (long)(kt) * BK;                                                              \
    __builtin_amdgcn_global_load_lds((const unsigned*)(_g + boff0), (unsigned*)((char*)(P) + sb0), 16, 0, 0);               \
    __builtin_amdgcn_global_load_lds((const unsigned*)(_g + boff1), (unsigned*)((char*)(P) + sb1), 16, 0, 0);               \
  } while (0)
#define LDA(dst, b, h)                                                                                                       \
  for (int m = 0; m < 4; ++m)                                                                                                \
    for (int k = 0; k < 2; ++k) dst[m][k] = *reinterpret_cast<const bf16x8*>((char*)SA(b, h) + lds_byte(wr * 64 + m * 16 + fr, k * 32 + fq * 8))
#define LDB(dst, b, h)                                                                                                       \
  for (int n = 0; n < 2; ++n)                                                                                                \
    for (int k = 0; k < 2; ++k) dst[n][k] = *reinterpret_cast<const bf16x8*>((char*)SB(b, h) + lds_byte(wc * 32 + n * 16 + fr, k * 32 + fq * 8))
#define MMA(ai, bj, At_, Bt_)                                                                                                \
  do {                                                                                                                       \
    __builtin_amdgcn_s_setprio(1);                                                                                           \
    for (int m = 0; m < 4; ++m)                                                                                              \
      for (int n = 0; n < 2; ++n)                                                                                            \
        for (int k = 0; k < 2; ++k)                                                                                          \
          acc[ai][bj][m][n] = __builtin_amdgcn_mfma_f32_16x16x32_bf16(Bt_[n][k], At_[m][k], acc[ai][bj][m][n], 0, 0, 0);    \
    __builtin_amdgcn_s_setprio(0);                                                                                           \
  } while (0)
#define WAIT_V(n) asm volatile("s_waitcnt vmcnt(" #n ")" ::: "memory")
#define WAIT_L(n) asm volatile("s_waitcnt lgkmcnt(" #n ")" ::: "memory")
#define BAR __builtin_amdgcn_s_barrier()
#define SCHED __builtin_amdgcn_sched_barrier(0)

  int tx = wave_s * 64 + lane_id();
  asm volatile("" : "+v"(tx));
  const int wid = tx >> 6, lane = tx & 63, wr = wid >> 2, wc = wid & 3, fr = lane & 15, fq = lane >> 4;
  const int sb0 = tx * 16, sb1 = sb0 + 8192;
  int r0, c0, r1, c1;
  stage_rc(sb0, r0, c0);
  stage_rc(sb1, r1, c1);
  const unsigned aoff0 = (unsigned)(r0 * lda + c0), aoff1 = (unsigned)(r1 * lda + c1);
  const int rp0 = (r0 & ~31) | (8 * ((r0 & 15) >> 2) + 4 * ((r0 >> 4) & 1) + (r0 & 3));
  const int rp1 = (r1 & ~31) | (8 * ((r1 & 15) >> 2) + 4 * ((r1 >> 4) & 1) + (r1 & 3));
  const unsigned boff0 = (unsigned)(rp0 * ldb + c0), boff1 = (unsigned)(rp1 * ldb + c1);
  f32x4 acc[2][2][4][2];
#pragma unroll
  for (int a = 0; a < 2; ++a)
#pragma unroll
    for (int b = 0; b < 2; ++b)
#pragma unroll
      for (int m = 0; m < 4; ++m)
#pragma unroll
        for (int n = 0; n < 2; ++n) acc[a][b][m][n] = (f32x4){0.f, 0.f, 0.f, 0.f};
  bf16x8 At[4][2], B0[2][2], B1[2][2];
  const int nt = K / BK;
  STAGE_B(SB(0, 0), bcol, 0);
  STAGE_A(SA(0, 0), brow, 0);
  STAGE_B(SB(0, 1), bcol + HALF, 0);
  STAGE_A(SA(0, 1), brow + HALF, 0);
  if (wr == 1) BAR;
  WAIT_V(4);
  BAR;
  STAGE_B(SB(1, 0), bcol, 1);
  STAGE_A(SA(1, 0), brow, 1);
  STAGE_B(SB(1, 1), bcol + HALF, 1);
  WAIT_V(6);
  BAR;
  for (int t = 0; t < nt - 2; t += 2) {
    LDB(B0, 0, 0); SCHED; LDA(At, 0, 0); STAGE_A(SA(1, 1), brow + HALF, t + 1);
    WAIT_L(8); BAR; WAIT_L(0); MMA(0, 0, At, B0); BAR; SCHED;
    LDB(B1, 0, 1); STAGE_B(SB(0, 0), bcol, t + 2);
    BAR; WAIT_L(0); MMA(0, 1, At, B1); BAR;
    LDA(At, 0, 1); STAGE_A(SA(0, 0), brow, t + 2);
    BAR; WAIT_L(0); MMA(1, 0, At, B0); BAR; SCHED;
    STAGE_B(SB(0, 1), bcol + HALF, t + 2);
    WAIT_V(6); BAR; MMA(1, 1, At, B1); BAR;
    LDB(B0, 1, 0); SCHED; LDA(At, 1, 0); STAGE_A(SA(0, 1), brow + HALF, t + 2);
    WAIT_L(8); BAR; WAIT_L(0); MMA(0, 0, At, B0); BAR; SCHED;
    LDB(B1, 1, 1); STAGE_B(SB(1, 0), bcol, t + 3);
    BAR; WAIT_L(0); MMA(0, 1, At, B1); BAR;
    LDA(At, 1, 1); STAGE_A(SA(1, 0), brow, t + 3);
    BAR; WAIT_L(0); MMA(1, 0, At, B0); BAR; SCHED;
    STAGE_B(SB(1, 1), bcol + HALF, t + 3);
    WAIT_V(6); BAR; MMA(1, 1, At, B1); BAR;
  }
  {
    LDB(B0, 0, 0); LDA(At, 0, 0); STAGE_A(SA(1, 1), brow + HALF, nt - 1);
    BAR; WAIT_L(0); MMA(0, 0, At, B0); BAR;
    LDB(B1, 0, 1); BAR; WAIT_L(0); MMA(0, 1, At, B1); BAR;
    LDA(At, 0, 1); WAIT_V(4); BAR; WAIT_L(0); MMA(1, 0, At, B0); MMA(1, 1, At, B1); BAR;
  }
  {
    LDB(B0, 1, 0); LDA(At, 1, 0); WAIT_V(2); BAR; WAIT_L(0); MMA(0, 0, At, B0); BAR;
    LDB(B1, 1, 1); WAIT_V(0); BAR; WAIT_L(0); MMA(0, 1, At, B1); BAR;
    LDA(At, 1, 1); BAR; WAIT_L(0); MMA(1, 0, At, B0); MMA(1, 1, At, B1); BAR;
  }
  if (wr == 0) BAR;
#pragma unroll
  for (int ai = 0; ai < 2; ++ai)
#pragma unroll
    for (int m = 0; m < 4; ++m)
#pragma unroll
      for (int bj = 0; bj < 2; ++bj)
        epi(brow + ai * HALF + wr * 64 + m * 16 + fr, bcol + bj * HALF + wc * 32 + fq * 8, acc[ai][bj][m][0], acc[ai][bj][m][1]);
#undef SA
#undef SB
#undef STAGE_A
#undef STAGE_B
#undef LDA
#undef LDB
#undef MMA
}


template <class Epi>
__device__ __forceinline__ void tail_gemm8(const bf16_t* __restrict__ A, const int lda, const bf16_t* __restrict__ Bt, const int ldb,
                                           const int nct, const int K, const Epi& epi, const int wave_s) {
  extern __shared__ __attribute__((aligned(16))) bf16_t shm[];
  float* red = (float*)shm;
  int tx = wave_s * 64 + lane_id(), bid_ = blockIdx.x;
  asm volatile("" : "+v"(tx), "+s"(bid_));
  const int wave = tx >> 6, lane = tx & 63, fr = lane & 15, fq = lane >> 4;
  const int kw = K >> 3;
  for (int ct = bid_; ct < nct; ct += gridDim.x) {
    const bf16_t* ap = A + (size_t)fr * lda + wave * kw + fq * 8;
    const bf16_t* bp = Bt + (size_t)(ct * 16 + fr) * ldb + wave * kw + fq * 8;
    f32x4 acc = (f32x4){0.f, 0.f, 0.f, 0.f};
#pragma unroll 8
    for (int k = 0; k < kw; k += 32) {
      const bf16x8 a = *(const bf16x8*)(ap + k);
      const bf16x8 b = *(const bf16x8*)(bp + k);
      acc = __builtin_amdgcn_mfma_f32_16x16x32_bf16(b, a, acc, 0, 0, 0);
    }
    *(f32x4*)(red + (wave * 64 + lane) * 4) = acc;
    __syncthreads();
    if (wave == 0) {
      f32x4 sum = acc;
#pragma unroll
      for (int w = 1; w < 8; ++w) sum += *(const f32x4*)(red + (w * 64 + lane) * 4);
      epi(TAIL0 + fr, ct * 16 + fq * 4, sum);
    }
    __syncthreads();
  }
}
template <class Epi>
__device__ __forceinline__ void tail_tile1(const bf16_t* __restrict__ A, const int lda, const bf16_t* __restrict__ Bt, const int ldb,
                                           const int ct, const int K, const int lane, const Epi& epi) {
  const int fr = lane & 15, fq = lane >> 4;
  const bf16_t* ap = A + (size_t)fr * lda + fq * 8;
  const bf16_t* bp = Bt + (size_t)(ct * 16 + fr) * ldb + fq * 8;
  f32x4 acc = (f32x4){0.f, 0.f, 0.f, 0.f};
#pragma unroll 8
  for (int k = 0; k < K; k += 32) {
    const bf16x8 a = *(const bf16x8*)(ap + k);
    const bf16x8 b = *(const bf16x8*)(bp + k);
    acc = __builtin_amdgcn_mfma_f32_16x16x32_bf16(b, a, acc, 0, 0, 0);
  }
  epi(TAIL0 + fr, ct * 16 + fq * 4, acc);
}

__device__ __forceinline__ void tile_map(int wgid, int nM, int nN, int& pm, int& pn) {
  const int nwg = nM * nN, q = nwg / 8, r = nwg % 8, xcd = wgid % 8, off = wgid / 8;
  wgid = (xcd < r ? xcd * (q + 1) : r * (q + 1) + (xcd - r) * q) + off;
  const int nig = 8 * nN, gid = wgid / nig, fm = gid * 8, gsz = (nM - fm) < 8 ? (nM - fm) : 8;
  pm = fm + ((wgid % nig) % gsz);
  pn = (wgid % nig) / gsz;
}


typedef unsigned u32x2 __attribute__((ext_vector_type(2)));
template <int GRP>
__device__ __forceinline__ void pool_group(const bf16_t* __restrict__ PROJ, bf16_t* __restrict__ YPOOL, const int r, const int lane) {
  constexpr int W = 2 << GRP;
  u32x2 raw[W];
#pragma unroll
  for (int i = 0; i < W; ++i) {
    const int t = (r - i) < 0 ? 0 : (r - i);
    raw[i] = *(const u32x2*)(PROJ + (size_t)t * NINP + C_PIN + GRP * 256 + lane * 4);
  }
  float s0 = 0.f, s1 = 0.f, s2 = 0.f, s3 = 0.f;
#pragma unroll
  for (int i = W - 1; i >= 0; --i) {
    if (r - i >= 0) {
      s0 += bf2f(raw[i].x & 0xffff); s1 += bf2f(raw[i].x >> 16); s2 += bf2f(raw[i].y & 0xffff); s3 += bf2f(raw[i].y >> 16);
    }
  }
  const float c0 = bf2f(raw[0].x & 0xffff), c1 = bf2f(raw[0].x >> 16), c2 = bf2f(raw[0].y & 0xffff), c3 = bf2f(raw[0].y >> 16);
  const int cntw = (r + 1) < W ? (r + 1) : W;
  const float inv = 1.0f / (float)cntw;
  uint2 o; o.x = pk2(s0 * inv - c0, s1 * inv - c1); o.y = pk2(s2 * inv - c2, s3 * inv - c3);
  *(uint2*)(YPOOL + (size_t)r * 1024 + GRP * 256 + lane * 4) = o;
}


__device__ __forceinline__ void rmsnorm_rows(const float* __restrict__ HRES, const float* __restrict__ g, bf16_t* __restrict__ HN,
                                             const int gw, const int NGW, const int lane) {
  for (int r = gw; r < NKEYS; r += 2 * NGW) {
    const int r2 = (r + NGW < NKEYS) ? r + NGW : r;
    f32x4 va[8], vb[8];
#pragma unroll
    for (int j = 0; j < 8; ++j) {
      va[j] = *(const f32x4*)(HRES + (size_t)r * D + j * 256 + lane * 4);
      vb[j] = *(const f32x4*)(HRES + (size_t)r2 * D + j * 256 + lane * 4);
    }
    float sa = 0.f, sb = 0.f;
#pragma unroll
    for (int j = 0; j < 8; ++j) {
      sa += va[j][0] * va[j][0] + va[j][1] * va[j][1] + va[j][2] * va[j][2] + va[j][3] * va[j][3];
      sb += vb[j][0] * vb[j][0] + vb[j][1] * vb[j][1] + vb[j][2] * vb[j][2] + vb[j][3] * vb[j][3];
    }
#pragma unroll
    for (int o = 1; o < 64; o <<= 1) { sa += shx(sa, o, lane); sb += shx(sb, o, lane); }
    const float ra = rsqrtf(sa * (1.0f / D) + 1e-6f), rb = rsqrtf(sb * (1.0f / D) + 1e-6f);
#pragma unroll
    for (int j = 0; j < 8; ++j) {
      const f32x4 gg = *(const f32x4*)(g + j * 256 + lane * 4);
      uint2 oa, ob;
      oa.x = pk2(va[j][0] * ra * gg[0], va[j][1] * ra * gg[1]); oa.y = pk2(va[j][2] * ra * gg[2], va[j][3] * ra * gg[3]);
      ob.x = pk2(vb[j][0] * rb * gg[0], vb[j][1] * rb * gg[1]); ob.y = pk2(vb[j][2] * rb * gg[2], vb[j][3] * rb * gg[3]);
      *(uint2*)(HN + (size_t)r * D + j * 256 + lane * 4) = oa;
      *(uint2*)(HN + (size_t)r2 * D + j * 256 + lane * 4) = ob;
    }
  }
}

__device__ __forceinline__ void wconv_T(const float* __restrict__ W, int K, int N, int Npad, bf16_t* __restrict__ WT, int ldt,
                                        int nbatch, size_t strideW, size_t strideWT, float scale, const int wave_s, const bool nt_out = false) {
  extern __shared__ __attribute__((aligned(16))) bf16_t shm[];
  float* tile = (float*)shm;
  const int nkb = K / 64, nnb = Npad / 256, per = nkb * nnb, items = per * nbatch;
  int t = wave_s * 64 + lane_id(), bid_ = blockIdx.x;
  asm volatile("" : "+v"(t), "+s"(bid_));
  for (int item = bid_; item < items; item += gridDim.x) {
    const int b = item / per, it = item % per, kb = it % nkb, nb = it / nkb, k0 = kb * 64, n0 = nb * 256;
    const float* Wb = W + (size_t)b * strideW;
    bf16_t* WTb = WT + (size_t)b * strideWT;
    float4 v[8];
#pragma unroll
    for (int i = 0; i < 8; ++i) {
      const int kk = (t >> 4) + 32 * (i & 1), n4 = (t & 15) * 4 + (i >> 1) * 64;
      v[i] = make_float4(0.f, 0.f, 0.f, 0.f);
      if (n0 + n4 < N) {
        const f32x4 w4 = __builtin_nontemporal_load((const f32x4*)(Wb + (size_t)(k0 + kk) * N + n0 + n4));
        v[i] = make_float4(w4[0], w4[1], w4[2], w4[3]);
      }
    }
#pragma unroll
    for (int i = 0; i < 8; ++i) {
      const int kk = (t >> 4) + 32 * (i & 1), c4 = (t & 15) * 4;
      float* tp = tile + (i >> 1) * (64 * 65) + kk * 65 + c4;
      tp[0] = v[i].x; tp[1] = v[i].y; tp[2] = v[i].z; tp[3] = v[i].w;
    }
    __syncthreads();
    {
      const int n = t >> 3, kc = (t & 7) * 8;
#pragma unroll
      for (int sub = 0; sub < 4; ++sub) {
        const float* tp = tile + sub * (64 * 65) + kc * 65 + n;
        uint4 o;
        o.x = pk2(tp[0 * 65] * scale, tp[1 * 65] * scale);
        o.y = pk2(tp[2 * 65] * scale, tp[3 * 65] * scale);
        o.z = pk2(tp[4 * 65] * scale, tp[5 * 65] * scale);
        o.w = pk2(tp[6 * 65] * scale, tp[7 * 65] * scale);
        u32x4* dst = (u32x4*)(WTb + (size_t)(n0 + sub * 64 + n) * ldt + k0 + kc);
        if (nt_out) __builtin_nontemporal_store((u32x4){o.x, o.y, o.z, o.w}, dst);
        else *dst = (u32x4){o.x, o.y, o.z, o.w};
      }
    }
    __syncthreads();
  }
}


#define XB_TMO      128
#define XB_XCNT(j)  (256  + 64 * (j))
#define XB_XSUB(j)  (1280 + 64 * (j))
#define XB_XGEN(j)  (2304 + 64 * (j))
#define XB_TOP      3328
#define XB_TOPGEN   3392
#define XCD_BAR_WORDS 3456
#define XB_SPIN_CAP (1u << 18)
#define LAS __attribute__((address_space(3)))
__device__ __forceinline__ unsigned xb_ld(unsigned* p)              { return __hip_atomic_load(p, __ATOMIC_RELAXED, __HIP_MEMORY_SCOPE_AGENT); }
__device__ __forceinline__ unsigned xb_add(unsigned* p, unsigned v) { return __hip_atomic_fetch_add(p, v, __ATOMIC_RELAXED, __HIP_MEMORY_SCOPE_AGENT); }
__device__ __forceinline__ unsigned xb_xcc_id() { return (unsigned)__builtin_amdgcn_s_getreg((3 << 11) | 20) & 0xFu; }
#define XB_SPIN(cond, bar) do { unsigned _sp = 0; while (cond) { __builtin_amdgcn_s_sleep(1); \
    if ((++_sp & 255u) == 0u) { if (xb_ld(&(bar)[XB_TMO])) break; if (_sp > XB_SPIN_CAP) { atomicAdd(&(bar)[XB_TMO], 1u); break; } } } } while (0)
struct XcdBarrier { unsigned* bar; unsigned x; volatile LAS unsigned* st; };
__device__ __forceinline__ XcdBarrier xcd_barrier_post(unsigned* bar, volatile LAS unsigned* st) {
    XcdBarrier b; b.bar = bar; b.x = xb_xcc_id(); b.st = st;
    if (threadIdx.x == 0) (void)xb_add(&bar[XB_XCNT(b.x)], 1u);
    return b;
}
__device__ __forceinline__ void xcd_barrier_complete(unsigned* bar, unsigned x, unsigned& nloc, unsigned& nx) {
    const unsigned G = gridDim.x * gridDim.y * gridDim.z;
    unsigned sum, cnt, mine, sp = 0u;
    for (;;) {
        sum = 0u; cnt = 0u; mine = 0u;
#pragma unroll
        for (unsigned j = 0; j < 16; ++j) { const unsigned c = xb_ld(&bar[XB_XCNT(j)]); sum += c; cnt += (c > 0u) ? 1u : 0u; mine = (j == x) ? c : mine; }
        if (sum == G) break;
        __builtin_amdgcn_s_sleep(1);
        if ((++sp & 255u) == 0u) { if (xb_ld(&bar[XB_TMO])) break; if (sp > XB_SPIN_CAP) { atomicAdd(&bar[XB_TMO], 1u); break; } }
    }
    nloc = mine > 0u ? mine : 1u; nx = cnt > 0u ? cnt : 1u;
}
__device__ __forceinline__ void xcd_barrier(const XcdBarrier& b, const int wave_s) {
    asm volatile("s_waitcnt vmcnt(0)" ::: "memory");
    __syncthreads();
    if (wave_s == 0 && lane_id() == 0) {
        unsigned* bar = b.bar;
        __builtin_amdgcn_s_waitcnt(0);
        unsigned nloc = b.st[0], nx = b.st[1];
        if (nloc == 0u) { xcd_barrier_complete(bar, b.x, nloc, nx); b.st[0] = nloc; b.st[1] = nx; }
        const unsigned old = xb_add(&bar[XB_XSUB(b.x)], 1u);
        const unsigned gen = old / nloc;
        if (old + 1u == (gen + 1u) * nloc) {
            __builtin_amdgcn_fence(__ATOMIC_RELEASE, "agent");
            asm volatile("s_waitcnt vmcnt(0)" ::: "memory");
            const unsigned og = xb_add(&bar[XB_TOP], 1u);
            const unsigned tg = og / nx;
            if (og + 1u == (tg + 1u) * nx) xb_add(&bar[XB_TOPGEN], 1u);
            else XB_SPIN(xb_ld(&bar[XB_TOPGEN]) == tg, bar);
            __builtin_amdgcn_fence(__ATOMIC_ACQUIRE, "agent");
            xb_add(&bar[XB_XGEN(b.x)], 1u);
            asm volatile("s_waitcnt vmcnt(0)" ::: "memory");
        } else {
            XB_SPIN(xb_ld(&bar[XB_XGEN(b.x)]) == gen, bar);
            __builtin_amdgcn_fence(__ATOMIC_ACQUIRE, "agent");
            asm volatile("s_waitcnt vmcnt(0)" ::: "memory");
        }
    }
    __syncthreads();
}

__global__ void __launch_bounds__(512) fwd(Params p) {
  extern __shared__ __attribute__((aligned(16))) bf16_t shm[];
  cg::grid_group grid = cg::this_grid();
  const int wave_s = __builtin_amdgcn_readfirstlane((int)(threadIdx.x >> 6));
  volatile LAS unsigned* xst = (volatile LAS unsigned*)((LAS char*)shm + LDS_XB_OFF);
  if (threadIdx.x == 0) { xst[0] = 0u; xst[1] = 0u; xst[2] = 0u; xst[3] = 0u; }
  __syncthreads();
  const XcdBarrier xbar = xcd_barrier_post((unsigned*)(p.ws + OFF_BAR), xst);
#define BLOCK_IDS                                   \
  int bid = blockIdx.x, G = gridDim.x;              \
  asm volatile("" : "+s"(bid), "+s"(G));            \
  const int NGW = G * 8; (void)NGW;
#define PHASE_PTRS \
  unsigned long long zo_ = 0; \
  asm volatile("" : "+s"(zo_)); \
  unsigned char* wsb = p.ws + zo_; \
  float* HRES = (float*)(wsb + OFF_HRES); \
  bf16_t* HN = (bf16_t*)(wsb + OFF_HN); \
  bf16_t* PROJ = (bf16_t*)(wsb + OFF_PROJ); \
  bf16_t* CKV = (bf16_t*)(wsb + OFF_CKV); \
  bf16_t* KIDX = (bf16_t*)(wsb + OFF_KIDX); \
  bf16_t* YPOOL = (bf16_t*)(wsb + OFF_YPOOL); \
  bf16_t* YP2 = (bf16_t*)(wsb + OFF_YP2); \
  bf16_t* QLAT = (bf16_t*)(wsb + OFF_QLAT); \
  bf16_t* OLAT = (bf16_t*)(wsb + OFF_OLAT); \
  bf16_t* OB = (bf16_t*)(wsb + OFF_O); \
  float* MB = (float*)(wsb + OFF_MB); \
  bf16_t* MERGED = (bf16_t*)(wsb + OFF_MERGED); \
  bf16_t* WIN = (bf16_t*)(wsb + OFF_WIN); \
  bf16_t* WUK = (bf16_t*)(wsb + OFF_WUK); \
  bf16_t* WUV = (bf16_t*)(wsb + OFF_WUV); \
  bf16_t* WAO = (bf16_t*)(wsb + OFF_WAO); \
  bf16_t* WPOOL = (bf16_t*)(wsb + OFF_WPOOL); \
  bf16_t* WPO = (bf16_t*)(wsb + OFF_WPO); \
  bf16_t* WOUT = (bf16_t*)(wsb + OFF_WOUT); \
  bf16_t* WMI = (bf16_t*)(wsb + OFF_WMI); \
  bf16_t* WMO = (bf16_t*)(wsb + OFF_WMO); \
  bf16_t* UB = PROJ; \
  (void)HRES; (void)HN; (void)CKV; (void)KIDX; (void)YPOOL; (void)YP2; (void)QLAT; (void)OLAT; (void)OB; (void)MB; (void)MERGED; (void)WIN; (void)WUK; (void)WUV; (void)WAO; (void)WPOOL; (void)WPO; (void)WOUT; (void)WMI; (void)WMO; (void)UB;
#define PHASE_IDS                                  \
  int tid = wave_s * 64 + lane_id();               \
  asm volatile("" : "+v"(tid));                    \
  const int wave = tid >> 6, lane = tid & 63, gw = bid * 8 + wave; \
  (void)lane; (void)gw; \
  PHASE_PTRS


#pragma unroll 1
  for (int l = 0; l < DEPTH; ++l) {
    BLOCK_IDS
    for (int rep = 0; rep < REP_P1; ++rep) {
      PHASE_IDS
      if (l == 0) {
        const float* g0 = p.in[2];
        for (int r = gw; r < NKEYS; r += NGW) {
          const float* src = (r < NMETA) ? p.in[1] + (size_t)r * D : p.in[0] + (size_t)(r - NMETA) * D;
          f32x4 v[8];
          float sq = 0.f;
#pragma unroll
          for (int j = 0; j < 8; ++j) {
            v[j] = __builtin_nontemporal_load((const f32x4*)(src + j * 256 + lane * 4));
            sq += v[j][0] * v[j][0] + v[j][1] * v[j][1] + v[j][2] * v[j][2] + v[j][3] * v[j][3];
          }
#pragma unroll
          for (int o = 1; o < 64; o <<= 1) sq += shx(sq, o, lane);
          const float rs = rsqrtf(sq * (1.0f / D) + 1e-6f);
#pragma unroll
          for (int j = 0; j < 8; ++j) {
            *(f32x4*)(HRES + (size_t)r * D + j * 256 + lane * 4) = v[j];
            const f32x4 gg = *(const f32x4*)(g0 + j * 256 + lane * 4);
            uint2 o2;
            o2.x = pk2(v[j][0] * rs * gg[0], v[j][1] * rs * gg[1]); o2.y = pk2(v[j][2] * rs * gg[2], v[j][3] * rs * gg[3]);
            *(uint2*)(HN + (size_t)r * D + j * 256 + lane * 4) = o2;
          }
        }
      } else {
        rmsnorm_rows(HRES, p.in[2] + (size_t)l * D, HN, gw, NGW, lane);
      }
      wconv_T(p.in[3] + (size_t)l * D * NIN, D, NIN, NINP, WIN, D, 1, 0, 0, 1.0f, wave_s);
      wconv_T(p.in[7] + (size_t)l * 16 * 256 * 128, 256, 128, 256, WUV, 256, 16, (size_t)256 * 128, (size_t)65536, 1.0f, wave_s);
      wconv_T(p.in[8] + (size_t)l * D * D, D, D, D, WAO, D, 1, 0, 0, 1.0f, wave_s, true);
      wconv_T(p.in[9] + (size_t)l * 4 * 65536, 256, 256, 256, WPOOL, 256, 4, (size_t)65536, (size_t)65536, 1.0f, wave_s);
      wconv_T(p.in[11] + (size_t)l * 1024 * D, 1024, D, D, WPO, 1024, 1, 0, 0, 1.0f, wave_s);
      wconv_T(p.in[12] + (size_t)l * D * D, D, D, D, WOUT, D, 1, 0, 0, 1.0f, wave_s, true);
      wconv_T(p.in[14] + (size_t)l * D * DFF, D, DFF, DFF, WMI, D, 1, 0, 0, 1.0f, wave_s, true);
      wconv_T(p.in[15] + (size_t)l * DFF * D, DFF, D, D, WMO, DFF, 1, 0, 0, 1.0f, wave_s, true);
      {
        const float* wuk = p.in[6] + (size_t)l * 16 * 256 * 128;
        const float sc = 0.08838834764831845f * 1.4426950408889634f;
        for (int i = bid * 512 + tid; i < 16 * 256 * 32; i += G * 512) {
          const int row = i >> 5, kc = (i & 31) * 8;
          uint4 o = make_uint4(0u, 0u, 0u, 0u);
          if (kc < 128) {
            const f32x4 a = __builtin_nontemporal_load((const f32x4*)(wuk + (size_t)row * 128 + kc));
            const f32x4 b = __builtin_nontemporal_load((const f32x4*)(wuk + (size_t)row * 128 + kc + 4));
            o.x = pk2(a[0] * sc, a[1] * sc); o.y = pk2(a[2] * sc, a[3] * sc);
            o.z = pk2(b[0] * sc, b[1] * sc); o.w = pk2(b[2] * sc, b[3] * sc);
          }
          *(uint4*)(WUK + (size_t)row * 256 + kc) = o;
        }
      }
    }
    if (l == 0) grid.sync();
    else xcd_barrier(xbar, wave_s);

    {
      PHASE_PTRS
      auto epi = [&](int row, int col, f32x4 v) {
        uint2 o; o.x = pk2(v[0], v[1]); o.y = pk2(v[2], v[3]);
        *(uint2*)(PROJ + (size_t)row * NINP + col) = o;
      };
      auto epi8 = [&](int row, int col, f32x4 a, f32x4 b) {
        uint4 o; o.x = pk2(a[0], a[1]); o.y = pk2(a[2], a[3]); o.z = pk2(b[0], b[1]); o.w = pk2(b[2], b[3]);
        *(uint4*)(PROJ + (size_t)row * NINP + col) = o;
      };
      const int nN = NINP / 256, ntiles = NMT * nN;
      for (int t = bid; t < ntiles; t += G) {
        int pm, pn; tile_map(t, NMT, nN, pm, pn);
        gemm_tile(HN, D, WIN, D, pm * 256, pn * 256, D, epi8, wave_s);
      }
      tail_gemm8(HN + (size_t)TAIL0 * D, D, WIN, D, NINP / 16, D, epi, wave_s);
    }
    xcd_barrier(xbar, wave_s);

    {
      PHASE_IDS
      const float* gkv = p.in[4] + (size_t)l * 256;
      const float* gik = p.in[5] + (size_t)l * 64;
      for (int r = gw; r < NKEYS; r += NGW) {
        const bf16_t* pr = PROJ + (size_t)r * NINP;
        {
          const uint2 raw = *(const uint2*)(pr + C_CKV + lane * 4);
          float a0 = bf2f(raw.x & 0xffff), a1 = bf2f(raw.x >> 16), a2 = bf2f(raw.y & 0xffff), a3 = bf2f(raw.y >> 16);
          float s = wave_sum(a0 * a0 + a1 * a1 + a2 * a2 + a3 * a3, lane);
          const float rs = rsqrtf(s * (1.0f / 256.0f) + 1e-6f);
          const float4 gg = *(const float4*)(gkv + lane * 4);
          uint2 o; o.x = pk2(a0 * rs * gg.x, a1 * rs * gg.y); o.y = pk2(a2 * rs * gg.z, a3 * rs * gg.w);
          *(uint2*)(CKV + (size_t)r * 256 + lane * 4) = o;
        }
        {
          const float a = bf2f(pr[C_KIDX + lane]);
          const float s = wave_sum(a * a, lane);
          const float rs = rsqrtf(s * (1.0f / 64.0f) + 1e-6f);
          KIDX[((size_t)((r >> 5) * 4 + (lane >> 4)) * 64 + ((lane >> 3) & 1) * 32 + (r & 31)) * 8 + (lane & 7)] = f2bf(a * rs * gik[lane]);
        }
        pool_group<0>(PROJ, YPOOL, r, lane);
        pool_group<1>(PROJ, YPOOL, r, lane);
        pool_group<2>(PROJ, YPOOL, r, lane);
        pool_group<3>(PROJ, YPOOL, r, lane);
      }
      const int ntiles = 16 * NMT;
      for (int t = bid; t < ntiles; t += G) {
        const int h = t / NMT, pm = t % NMT;
        auto epi8 = [&](int row, int col, f32x4 a, f32x4 b) {
          uint4 o; o.x = pk2(a[0], a[1]); o.y = pk2(a[2], a[3]); o.z = pk2(b[0], b[1]); o.w = pk2(b[2], b[3]);
          *(uint4*)(QLAT + (size_t)row * 4096 + h * 256 + col) = o;
        };
        gemm_tile(PROJ + h * 128, NINP, WUK + (size_t)h * 65536, 256, pm * 256, 0, 128, epi8, wave_s);
      }
      int tid2 = wave_s * 64 + lane_id();
      asm volatile("" : "+v"(tid2));
      const int lane2 = tid2 & 63, gw2 = bid * 8 + (tid2 >> 6);
      for (int task = gw2; task < 16 * 16; task += NGW) {
        const int h = task >> 4, ct = task & 15;
        auto epi = [&](int row, int col, f32x4 v) {
          uint2 o; o.x = pk2(v[0], v[1]); o.y = pk2(v[2], v[3]);
          *(uint2*)(QLAT + (size_t)row * 4096 + h * 256 + col) = o;
        };
        tail_tile1(PROJ + (size_t)TAIL0 * NINP + h * 128, NINP, WUK + (size_t)h * 65536, 256, ct, 128, lane2, epi);
      }
    }
    xcd_barrier(xbar, wave_s);

    {
      PHASE_IDS
      unsigned* SC = (unsigned*)shm;
      int* IDX = (int*)((char*)shm + LDS_IDX_OFF);
      int* CAND = (int*)((char*)shm + LDS_CAND_OFF);
      const int nunits = NKEYS / 4;
      unsigned* qctr = (unsigned*)(wsb + OFF_BAR) + 3520 + 64 * l;
      volatile int* QW = (volatile int*)((char*)shm + LDS_XCH_OFF) + 32;
      unsigned* HIST = (unsigned*)CAND;
      {
        u32x4* hz = (u32x4*)HIST + tid * 2;
        unsigned z = 0u;
        asm volatile("" : "+v"(z));
        hz[0] = (u32x4){z, z, z, z}; hz[1] = (u32x4){z, z, z, z};
      }
      int tkt;
      {
        if (wave == 0 && lane == 0) *QW = (int)__hip_atomic_fetch_add(qctr, 1u, __ATOMIC_RELAXED, __HIP_MEMORY_SCOPE_AGENT);
        __syncthreads();
        tkt = __builtin_amdgcn_readfirstlane(*QW);
      }
#pragma unroll 1
      while (tkt < nunits) {
        int nxt = 0;
        if (wave == 0 && lane == 0) nxt = (int)__hip_atomic_fetch_add(qctr, 1u, __ATOMIC_RELAXED, __HIP_MEMORY_SCOPE_AGENT);
        const int u = nunits - 1 - tkt;
        int lane_u_ = lane;
        asm volatile("" : "+v"(lane_u_));
        const int lane = lane_u_;
        const int q0 = u * 4;
        const int nk = q0 + 4;
        const int nit = (nk + 255) >> 8;
        const int ntile = nit * 8;
        for (int rsc = 0; rsc < REP_SC; ++rsc) {
          const int r = lane & 31, kg = lane >> 5, qi = r & 3, head = r >> 2;
          bf16x8 qa[4];
          const bf16_t* qp = PROJ + (size_t)(q0 + qi) * NINP + C_QIDX + head * 64 + kg * 8;
#pragma unroll
          for (int ks = 0; ks < 4; ++ks) qa[ks] = *(const bf16x8*)(qp + ks * 16);
          float wv[4][4];
#pragma unroll
          for (int i = 0; i < 4; ++i)
#pragma unroll
            for (int j = 0; j < 4; ++j) wv[i][j] = bf2f(PROJ[(size_t)(q0 + j) * NINP + C_WIDX + 2 * i + kg]);
          const unsigned klane = (unsigned)lane * 8u;
          bf16x8 kbuf[4][4];
#pragma unroll
          for (int pi = 0; pi < 3; ++pi) {
            const int tp = wave_s + 8 * ((pi < nit) ? pi : nit - 1);
#pragma unroll
            for (int ks = 0; ks < 4; ++ks) kbuf[pi][ks] = *(const bf16x8*)(KIDX + (size_t)(tp * 4 + ks) * 512 + klane);
          }
          for (int base = 0; base < nit; base += 4) {
#pragma unroll
            for (int uu = 0; uu < 4; ++uu) {
              const int i = (base + uu < nit) ? base + uu : nit - 1;
              {
                {
                  const int ip = (base + uu + 3 < nit) ? base + uu + 3 : nit - 1;
                  const int tp = wave_s + 8 * ip;
#pragma unroll
                  for (int ks = 0; ks < 4; ++ks) kbuf[(uu + 3) % 4][ks] = *(const bf16x8*)(KIDX + (size_t)(tp * 4 + ks) * 512 + klane);
                }
                if (base + uu < nit) {
                const int tt = wave_s + 8 * i;
                const int key = tt * 32 + r;
                f32x16 acc;
#pragma unroll
                for (int q = 0; q < 16; ++q) acc[q] = 0.f;
#pragma unroll
                for (int ks = 0; ks < 4; ++ks) acc = __builtin_amdgcn_mfma_f32_32x32x16_bf16(qa[ks], kbuf[uu][ks], acc, 0, 0, 0);
#define RELU_(x) __int_as_float(max(__float_as_int(x), 0))
                const float p0 = wv[0][0] * RELU_(acc[0]) + wv[1][0] * RELU_(acc[4]) + wv[2][0] * RELU_(acc[8]) + wv[3][0] * RELU_(acc[12]);
                const float p1 = wv[0][1] * RELU_(acc[1]) + wv[1][1] * RELU_(acc[5]) + wv[2][1] * RELU_(acc[9]) + wv[3][1] * RELU_(acc[13]);
                const float p2 = wv[0][2] * RELU_(acc[2]) + wv[1][2] * RELU_(acc[6]) + wv[2][2] * RELU_(acc[10]) + wv[3][2] * RELU_(acc[14]);
                const float p3 = wv[0][3] * RELU_(acc[3]) + wv[1][3] * RELU_(acc[7]) + wv[2][3] * RELU_(acc[11]) + wv[3][3] * RELU_(acc[15]);
#undef RELU_
                const auto r02 = __builtin_amdgcn_permlane32_swap(__float_as_uint(p0), __float_as_uint(p2), false, false);
                const auto r13 = __builtin_amdgcn_permlane32_swap(__float_as_uint(p1), __float_as_uint(p3), false, false);
                const float sa = __uint_as_float(r02[0]) + __uint_as_float(r02[1]);
                const float sb = __uint_as_float(r13[0]) + __uint_as_float(r13[1]);
#pragma unroll
                for (int jj = 0; jj < 2; ++jj) {
                  const int j = kg * 2 + jj;
                  const float s = (jj ? sb : sa) + 0.0f;
                  unsigned ub = __float_as_uint(s);
                  ub ^= (unsigned)((int)ub >> 31) | 0x80000000u;
                  if (key > q0 + j) ub = 0u;
                  SC[j * SCLD + key] = ub;
                  if (ub != 0u) {
                    const unsigned bin = ub >> 21;
                    __hip_atomic_fetch_add(HIST + j * 1024 + (bin >> 1), 1u << ((bin & 1u) * 16u), __ATOMIC_RELAXED, __HIP_MEMORY_SCOPE_WORKGROUP);
                  }
                }
                }
              }
            }
          }
        }
        __syncthreads();
        for (int rsel = 0; rsel < REP_SEL; ++rsel) {
          const int j = wave & 3, half = wave >> 2, qpos = q0 + j, nvalid = qpos + 1;
          const bool big = nvalid > 256;
          int* idx = IDX + j * 256;
          int* cand = CAND + (j * 2 + half) * CAND_CAP2;
          int* XCH = (int*)((char*)shm + LDS_XCH_OFF);
          const unsigned* sc1 = SC + j * SCLD;
          const uint4* sc4 = (const uint4*)sc1;
          const int nh = (nit + 1) >> 1;
          const int g0 = half ? nh : 0, g1 = half ? nit : nh;
          unsigned prefix = 0u;
          if (big) {
            const u32x4* hq = (const u32x4*)(HIST + j * 1024) + lane * 4;
            const u32x4 w0 = hq[0], w1 = hq[1], w2 = hq[2], w3 = hq[3];
            unsigned cw[16];
#pragma unroll
            for (int q = 0; q < 4; ++q) { cw[q] = w0[q]; cw[4 + q] = w1[q]; cw[8 + q] = w2[q]; cw[12 + q] = w3[q]; }
            int sl = 0;
#pragma unroll
            for (int q = 0; q < 16; ++q) sl += (int)(cw[q] & 0xffffu) + (int)(cw[q] >> 16);
            int S = sl;
#pragma unroll
            for (int o = 1; o < 64; o <<= 1) {
              const int tv = __builtin_amdgcn_ds_bpermute(((lane + o) & 63) << 2, S);
              if (lane + o < 64) S += tv;
            }
            const int L = __popcll(__ballot(S >= 256)) - 1;
            int run = S - sl, found = -1;
#pragma unroll
            for (int bb = 31; bb >= 0; --bb) {
              run += (bb & 1) ? (int)(cw[bb >> 1] >> 16) : (int)(cw[bb >> 1] & 0xffffu);
              if (run >= 256 && found < 0) found = bb;
            }
            const int fb = __builtin_amdgcn_readlane(found, L);
            prefix = (unsigned)(L * 32 + fb) << 21;
          }
          __syncthreads();
          const unsigned P = prefix >> 21;
          int c = 0, m = 0;
          if (big) {
            for (int it = g0 * 4; it < g1 * 4; it += 4) {
              unsigned x[4];
#pragma unroll
              for (int e = 0; e < 4; ++e) x[e] = sc1[(it + e) * 64 + lane];
#pragma unroll
              for (int e = 0; e < 4; ++e) {
                const unsigned t = x[e] >> 21;
                const bool isA = t > P, isB = t == P;
                const unsigned long long mA = __ballot(isA), mB = __ballot(isB);
                const int oA = __builtin_amdgcn_mbcnt_hi((unsigned)(mA >> 32), __builtin_amdgcn_mbcnt_lo((unsigned)mA, 0u));
                const int oB = __builtin_amdgcn_mbcnt_hi((unsigned)(mB >> 32), __builtin_amdgcn_mbcnt_lo((unsigned)mB, 0u));
                if (isA) idx[half ? (255 - (c + oA)) : (c + oA)] = (it + e) * 64 + lane;
                if (isB && (m + oB) < CAND_CAP2) cand[m + oB] = (it + e) * 64 + lane;
                c += __popcll(mA);
                m += __popcll(mB);
              }
            }
          }
          if (lane == 0) { XCH[16 + wave * 2] = c; XCH[16 + wave * 2 + 1] = m; }
          __syncthreads();
          if (half == 0) {
            if (!big) {
              for (int i = lane; i < 256; i += 64) idx[i] = (i < nvalid) ? i : 0;
            } else {
              const int cB = XCH[16 + (wave + 4) * 2], mB = XCH[16 + (wave + 4) * 2 + 1];
              const int mA = m, mt = mA + mB;
              const int* candB = CAND + (j * 2 + 1) * CAND_CAP2;
              if (mA <= CAND_CAP2 && mB <= CAND_CAP2) {
                const int need = 256 - c - cB;
                unsigned T = prefix;
                auto fine = [&](auto KMtag) {
                  constexpr int KM = decltype(KMtag)::value;
                  unsigned cv[KM];
                  int ci[KM];
#pragma unroll
                  for (int k = 0; k < KM; ++k) {
                    const int i = k * 64 + lane;
                    ci[k] = (i < mA) ? cand[i] : ((i < mt) ? candB[i - mA] : 0);
                    cv[k] = (i < mt) ? sc1[ci[k]] : 0u;
                  }
                  for (int bit = 20; bit >= 0; --bit) {
                    const unsigned cd = T | (1u << bit);
                    int cnt = 0;
#pragma unroll
                    for (int k = 0; k < KM; ++k) cnt += __popcll(__ballot(cv[k] >= cd));
                    if (cnt >= need) T = cd;
                  }
                  int pos = c;
#pragma unroll
                  for (int k = 0; k < KM; ++k) {
                    const bool sel = cv[k] > T;
                    const unsigned long long mk = __ballot(sel);
                    const int off = __builtin_amdgcn_mbcnt_hi((unsigned)(mk >> 32), __builtin_amdgcn_mbcnt_lo((unsigned)mk, 0u));
                    if (sel) idx[pos + off] = ci[k];
                    pos += __popcll(mk);
                  }
                  const int lim = 256 - cB;
#pragma unroll
                  for (int k = 0; k < KM; ++k) {
                    const bool sel = cv[k] == T;
                    const unsigned long long mk = __ballot(sel);
                    const int off = __builtin_amdgcn_mbcnt_hi((unsigned)(mk >> 32), __builtin_amdgcn_mbcnt_lo((unsigned)mk, 0u));
                    if (sel && (pos + off) < lim) idx[pos + off] = ci[k];
                    pos += __popcll(mk);
                  }
                };
                if (mt <= 256) fine(std::integral_constant<int, 4>{});
                else fine(std::integral_constant<int, (2 * CAND_CAP2) / 64>{});
              } else {
                unsigned pf = 0u;
                for (int bit = 31; bit >= 0; --bit) {
                  const unsigned cd = pf | (1u << bit);
                  int cnt = 0;
                  for (int it = 0; it < nit; ++it) {
                    const uint4 v = sc4[it * 64 + lane];
                    cnt += __popcll(__ballot(v.x >= cd)) + __popcll(__ballot(v.y >= cd)) + __popcll(__ballot(v.z >= cd)) + __popcll(__ballot(v.w >= cd));
                  }
                  if (cnt >= 256) pf = cd;
                }
                const unsigned T = pf;
                int c2 = 0;
                const int nit64 = nit * 4;
                for (int it = 0; it < nit64; ++it) {
                  const unsigned x = sc1[it * 64 + lane];
                  const bool sel = x > T;
                  const unsigned long long mask = __ballot(sel);
                  const int off = __builtin_amdgcn_mbcnt_hi((unsigned)(mask >> 32), __builtin_amdgcn_mbcnt_lo((unsigned)mask, 0u));
                  if (sel) idx[c2 + off] = it * 64 + lane;
                  c2 += __popcll(mask);
                }
                for (int it = 0; it < nit64 && c2 < 256; ++it) {
                  const unsigned x = sc1[it * 64 + lane];
                  const bool sel = x == T;
                  const unsigned long long mask = __ballot(sel);
                  const int off = __builtin_amdgcn_mbcnt_hi((unsigned)(mask >> 32), __builtin_amdgcn_mbcnt_lo((unsigned)mask, 0u));
                  if (sel && (c2 + off) < 256) idx[c2 + off] = it * 64 + lane;
                  c2 += __popcll(mask);
                }
              }
            }
          }
          if (rsel + 1 < REP_SEL) __syncthreads();
        }
        __syncthreads();
        {
          u32x4* hz = (u32x4*)HIST + (wave * 64 + lane) * 2;
          unsigned z = 0u;
          asm volatile("" : "+v"(z));
          hz[0] = (u32x4){z, z, z, z}; hz[1] = (u32x4){z, z, z, z};
        }
        for (int ratt = 0; ratt < REP_ATT; ++ratt) {
          if (ratt) __syncthreads();
          const int j = wave & 3, half = wave >> 2, qpos = q0 + j;
          const int nsel = (qpos + 1) < 256 ? (qpos + 1) : 256;
          const int* idx = IDX + j * 256;
          bf16_t* ST = (bf16_t*)((char*)shm + wave * (32 * ST_LD * 2));
          float* XF = (float*)ST;
          const int fr = lane & 15, fq = lane >> 4;
          bf16x8 qb[8];
          const bf16_t* qlp = QLAT + (size_t)qpos * 4096 + fr * 256 + fq * 8;
#pragma unroll
          for (int ks = 0; ks < 8; ++ks) qb[ks] = *(const bf16x8*)(qlp + ks * 32);
          f32x4 o[16];
#pragma unroll
          for (int i = 0; i < 16; ++i) o[i] = (f32x4){0.f, 0.f, 0.f, 0.f};
          float mrun = -INFINITY, lrun = 0.f;
          const int nchunk = (nsel + 31) >> 5, nfirst = (nchunk + 1) >> 1;
          const int cb = half ? nfirst : 0, ce = half ? nchunk : nfirst;
          const unsigned st_base = (unsigned)(size_t)(__attribute__((address_space(3))) char*)ST;
          const unsigned tr_addr = st_base + (unsigned)(((fq * 4 + (fr >> 2)) * ST_LD + (fr & 3) * 4) * 2);
          bf16x8 ar[2][8];
          {
            const int c0 = (cb < ce) ? cb : 0;
#pragma unroll
            for (int tt = 0; tt < 2; ++tt) {
              const bf16_t* kr = CKV + (size_t)idx[c0 * 32 + tt * 16 + fr] * 256 + fq * 8;
#pragma unroll
              for (int ks = 0; ks < 8; ++ks) ar[tt][ks] = *(const bf16x8*)(kr + ks * 32);
            }
          }
          for (int ch = cb; ch < ce; ++ch) {
            f32x4 s[2];
#pragma unroll
            for (int tt = 0; tt < 2; ++tt) {
              s[tt] = (f32x4){0.f, 0.f, 0.f, 0.f};
#pragma unroll
              for (int ks = 0; ks < 8; ++ks) s[tt] = __builtin_amdgcn_mfma_f32_16x16x32_bf16(ar[tt][ks], qb[ks], s[tt], 0, 0, 0);
            }
#pragma unroll
            for (int tt = 0; tt < 2; ++tt)
#pragma unroll
              for (int ks = 0; ks < 8; ++ks) *(bf16x8*)(ST + (tt * 16 + fr) * ST_LD + ks * 32 + fq * 8) = ar[tt][ks];
            asm volatile("s_waitcnt lgkmcnt(0)" ::: "memory");
            __builtin_amdgcn_wave_barrier();
            {
              const int cn = (ch + 1 < ce) ? ch + 1 : ch;
#pragma unroll
              for (int tt = 0; tt < 2; ++tt) {
                const bf16_t* kr = CKV + (size_t)idx[cn * 32 + tt * 16 + fr] * 256 + fq * 8;
#pragma unroll
                for (int ks = 0; ks < 8; ++ks) ar[tt][ks] = *(const bf16x8*)(kr + ks * 32);
              }
            }
            if (nsel < 256) {
#pragma unroll
              for (int tt = 0; tt < 2; ++tt)
#pragma unroll
                for (int e = 0; e < 4; ++e)
                  if (ch * 32 + tt * 16 + fq * 4 + e >= nsel) s[tt][e] = -INFINITY;
            }
            float mx = fmaxf(fmaxf(fmaxf(s[0][0], s[0][1]), fmaxf(s[0][2], s[0][3])), fmaxf(fmaxf(s[1][0], s[1][1]), fmaxf(s[1][2], s[1][3])));
            mx = fmaxf(mx, shx(mx, 16, lane));
            mx = fmaxf(mx, shx(mx, 32, lane));
            const float mnew = fmaxf(mrun, mx);
            const float alpha = __builtin_amdgcn_exp2f(mrun - mnew);
            float ps = 0.f;
            float pv[8];
#pragma unroll
            for (int tt = 0; tt < 2; ++tt)
#pragma unroll
              for (int e = 0; e < 4; ++e) {
                const float pe = __builtin_amdgcn_exp2f(s[tt][e] - mnew);
                pv[tt * 4 + e] = pe;
                ps += pe;
              }
            ps += shx(ps, 16, lane);
            ps += shx(ps, 32, lane);
            lrun = lrun * alpha + ps;
            mrun = mnew;
            union { bf16x8 v; unsigned u[4]; } pb;
            pb.u[0] = pk2(pv[0], pv[1]); pb.u[1] = pk2(pv[2], pv[3]); pb.u[2] = pk2(pv[4], pv[5]); pb.u[3] = pk2(pv[6], pv[7]);
#pragma unroll
            for (int rt = 0; rt < 16; ++rt) o[rt] *= alpha;
#pragma unroll
            for (int rb = 0; rb < 4; ++rb) {
              union { bf16x8 v; u16x4 h[2]; } va[4];
              asm volatile(
                  "ds_read_b64_tr_b16 %0, %8 offset:%9\n\t"
                  "ds_read_b64_tr_b16 %1, %8 offset:%10\n\t"
                  "ds_read_b64_tr_b16 %2, %8 offset:%11\n\t"
                  "ds_read_b64_tr_b16 %3, %8 offset:%12\n\t"
                  "ds_read_b64_tr_b16 %4, %8 offset:%13\n\t"
                  "ds_read_b64_tr_b16 %5, %8 offset:%14\n\t"
                  "ds_read_b64_tr_b16 %6, %8 offset:%15\n\t"
                  "ds_read_b64_tr_b16 %7, %8 offset:%16\n\t"
                  "s_waitcnt lgkmcnt(0)"
                  : "=&v"(va[0].h[0]), "=&v"(va[0].h[1]), "=&v"(va[1].h[0]), "=&v"(va[1].h[1]),
                    "=&v"(va[2].h[0]), "=&v"(va[2].h[1]), "=&v"(va[3].h[0]), "=&v"(va[3].h[1])
                  : "v"(tr_addr),
                    "i"((rb * 4 + 0) * 32), "i"((rb * 4 + 0) * 32 + 16 * ST_LD * 2),
                    "i"((rb * 4 + 1) * 32), "i"((rb * 4 + 1) * 32 + 16 * ST_LD * 2),
                    "i"((rb * 4 + 2) * 32), "i"((rb * 4 + 2) * 32 + 16 * ST_LD * 2),
                    "i"((rb * 4 + 3) * 32), "i"((rb * 4 + 3) * 32 + 16 * ST_LD * 2)
                  : "memory");
#pragma unroll
              for (int q = 0; q < 4; ++q)
                o[rb * 4 + q] = __builtin_amdgcn_mfma_f32_16x16x32_bf16(va[q].v, pb.v, o[rb * 4 + q], 0, 0, 0);
            }
            asm volatile("s_waitcnt lgkmcnt(0)" ::: "memory");
            __builtin_amdgcn_wave_barrier();
          }
          if (half == 1) {
            XF[lane] = mrun;
            XF[64 + lane] = lrun;
#pragma unroll
            for (int rt = 0; rt < 16; ++rt)
#pragma unroll
              for (int e = 0; e < 4; ++e) XF[(2 + rt * 4 + e) * 64 + lane] = o[rt][e];
          }
          __syncthreads();
          if (half == 0) {
            const float* XP = (const float*)((char*)shm + (wave + 4) * (32 * ST_LD * 2));
            const float m1 = XP[lane], l1 = XP[64 + lane];
            const float mm = fmaxf(mrun, m1);
            const float a0 = __builtin_amdgcn_exp2f(mrun - mm), a1 = __builtin_amdgcn_exp2f(m1 - mm);
            const float invl = 1.0f / (lrun * a0 + l1 * a1);
            const float w0 = a0 * invl, w1 = a1 * invl;
            bf16_t* op = OLAT + (size_t)qpos * 4096 + fr * 256 + fq * 4;
#pragma unroll
            for (int rt = 0; rt < 16; ++rt) {
              float r[4];
#pragma unroll
              for (int e = 0; e < 4; ++e) r[e] = o[rt][e] * w0 + XP[(2 + rt * 4 + e) * 64 + lane] * w1;
              uint2 w; w.x = pk2(r[0], r[1]); w.y = pk2(r[2], r[3]);
              *(uint2*)(op + rt * 16) = w;
            }
          }
        }
        if (wave == 0 && lane == 0) *QW = nxt;
        __syncthreads();
        tkt = __builtin_amdgcn_readfirstlane(*QW);
      }
      {
        const float* psc = p.in[10] + (size_t)l * 1024;
        const int ntiles = 4 * NMT;
        for (int t = bid; t < ntiles; t += G) {
          const int g = t / NMT, pm = t % NMT;
          auto epi8 = [&](int row, int col, f32x4 a, f32x4 b) {
            const float4 sa = *(const float4*)(psc + g * 256 + col), sb = *(const float4*)(psc + g * 256 + col + 4);
            uint4 o; o.x = pk2(a[0] * sa.x, a[1] * sa.y); o.y = pk2(a[2] * sa.z, a[3] * sa.w); o.z = pk2(b[0] * sb.x, b[1] * sb.y); o.w = pk2(b[2] * sb.z, b[3] * sb.w);
            *(uint4*)(YP2 + (size_t)row * 1024 + g * 256 + col) = o;
          };
          gemm_tile(YPOOL + g * 256, 1024, WPOOL + (size_t)g * 65536, 256, pm * 256, 0, 256, epi8, wave_s);
        }
        int tid2 = wave_s * 64 + lane_id();
        asm volatile("" : "+v"(tid2));
        const int lane2 = tid2 & 63, gw2 = bid * 8 + (tid2 >> 6);
        for (int task = gw2; task < 4 * 16; task += NGW) {
          const int g = task >> 4, ct = task & 15;
          auto epi = [&](int row, int col, f32x4 v) {
            const float4 sc = *(const float4*)(psc + g * 256 + col);
            uint2 o; o.x = pk2(v[0] * sc.x, v[1] * sc.y); o.y = pk2(v[2] * sc.z, v[3] * sc.w);
            *(uint2*)(YP2 + (size_t)row * 1024 + g * 256 + col) = o;
          };
          tail_tile1(YPOOL + (size_t)TAIL0 * 1024 + g * 256, 1024, WPOOL + (size_t)g * 65536, 256, ct, 256, lane2, epi);
        }
      }
    }
    xcd_barrier(xbar, wave_s);

    {
      PHASE_PTRS
      auto epib = [&](int row, int col, f32x4 v) {
        const uint2 raw = *(const uint2*)(PROJ + (size_t)row * NINP + C_GB + col);
        f32x4 o;
        o[0] = sigmoidf(bf2f(raw.x & 0xffff)) * v[0]; o[1] = sigmoidf(bf2f(raw.x >> 16)) * v[1];
        o[2] = sigmoidf(bf2f(raw.y & 0xffff)) * v[2]; o[3] = sigmoidf(bf2f(raw.y >> 16)) * v[3];
        *(f32x4*)(MB + (size_t)row * D + col) = o;
      };
      auto epib8 = [&](int row, int col, f32x4 a, f32x4 b) {
        const uint4 raw = *(const uint4*)(PROJ + (size_t)row * NINP + C_GB + col);
        f32x4 oa, ob;
        oa[0] = sigmoidf(bf2f(raw.x & 0xffff)) * a[0]; oa[1] = sigmoidf(bf2f(raw.x >> 16)) * a[1];
        oa[2] = sigmoidf(bf2f(raw.y & 0xffff)) * a[2]; oa[3] = sigmoidf(bf2f(raw.y >> 16)) * a[3];
        ob[0] = sigmoidf(bf2f(raw.z & 0xffff)) * b[0]; ob[1] = sigmoidf(bf2f(raw.z >> 16)) * b[1];
        ob[2] = sigmoidf(bf2f(raw.w & 0xffff)) * b[2]; ob[3] = sigmoidf(bf2f(raw.w >> 16)) * b[3];
        f32x4* mp = (f32x4*)(MB + (size_t)row * D + col);
        mp[0] = oa; mp[1] = ob;
      };
      const int n1 = 16 * NMT, n2 = NMT * 8;
      for (int t = bid; t < n1 + n2; t += G) {
        if (t < n1) {
          const int h = t / NMT, pm = t % NMT;
          auto epi8 = [&](int row, int col, f32x4 a, f32x4 b) {
            if (col < 128) {
              uint4 o; o.x = pk2(a[0], a[1]); o.y = pk2(a[2], a[3]); o.z = pk2(b[0], b[1]); o.w = pk2(b[2], b[3]);
              *(uint4*)(OB + (size_t)row * D + h * 128 + col) = o;
            }
          };
          gemm_tile(OLAT + h * 256, 4096, WUV + (size_t)h * 65536, 256, pm * 256, 0, 256, epi8, wave_s);
        } else {
          int pm, pn; tile_map(t - n1, NMT, 8, pm, pn);
          gemm_tile(YP2, 1024, WPO, 1024, pm * 256, pn * 256, 1024, epib8, wave_s);
        }
      }
      int tid2 = wave_s * 64 + lane_id();
      asm volatile("" : "+v"(tid2));
      const int lane2 = tid2 & 63, gw2 = bid * 8 + (tid2 >> 6);
      for (int task = gw2; task < 16 * 8; task += NGW) {
        const int h = task >> 3, ct = task & 7;
        auto epi = [&](int row, int col, f32x4 v) {
          uint2 o; o.x = pk2(v[0], v[1]); o.y = pk2(v[2], v[3]);
          *(uint2*)(OB + (size_t)row * D + h * 128 + col) = o;
        };
        tail_tile1(OLAT + (size_t)TAIL0 * 4096 + h * 256, 4096, WUV + (size_t)h * 65536, 256, ct, 256, lane2, epi);
      }
      tail_gemm8(YP2 + (size_t)TAIL0 * 1024, 1024, WPO, 1024, D / 16, 1024, epib, wave_s);
    }
    xcd_barrier(xbar, wave_s);

    {
      PHASE_PTRS
      auto epi = [&](int row, int col, f32x4 v) {
        const uint2 raw = *(const uint2*)(PROJ + (size_t)row * NINP + C_GA + col);
        const f32x4 mb = *(const f32x4*)(MB + (size_t)row * D + col);
        uint2 o;
        o.x = pk2(sigmoidf(bf2f(raw.x & 0xffff)) * v[0] + mb[0], sigmoidf(bf2f(raw.x >> 16)) * v[1] + mb[1]);
        o.y = pk2(sigmoidf(bf2f(raw.y & 0xffff)) * v[2] + mb[2], sigmoidf(bf2f(raw.y >> 16)) * v[3] + mb[3]);
        *(uint2*)(MERGED + (size_t)row * D + col) = o;
      };
      auto epi8 = [&](int row, int col, f32x4 a, f32x4 b) {
        const uint4 raw = *(const uint4*)(PROJ + (size_t)row * NINP + C_GA + col);
        const f32x4* mp = (const f32x4*)(MB + (size_t)row * D + col);
        const f32x4 ma = mp[0], mb = mp[1];
        uint4 o;
        o.x = pk2(sigmoidf(bf2f(raw.x & 0xffff)) * a[0] + ma[0], sigmoidf(bf2f(raw.x >> 16)) * a[1] + ma[1]);
        o.y = pk2(sigmoidf(bf2f(raw.y & 0xffff)) * a[2] + ma[2], sigmoidf(bf2f(raw.y >> 16)) * a[3] + ma[3]);
        o.z = pk2(sigmoidf(bf2f(raw.z & 0xffff)) * b[0] + mb[0], sigmoidf(bf2f(raw.z >> 16)) * b[1] + mb[1]);
        o.w = pk2(sigmoidf(bf2f(raw.w & 0xffff)) * b[2] + mb[2], sigmoidf(bf2f(raw.w >> 16)) * b[3] + mb[3]);
        *(uint4*)(MERGED + (size_t)row * D + col) = o;
      };
      for (int t = bid; t < NMT * 8; t += G) {
        int pm, pn; tile_map(t, NMT, 8, pm, pn);
        gemm_tile(OB, D, WAO, D, pm * 256, pn * 256, D, epi8, wave_s);
      }
      tail_gemm8(OB + (size_t)TAIL0 * D, D, WAO, D, D / 16, D, epi, wave_s);
    }
    xcd_barrier(xbar, wave_s);

    {
      PHASE_PTRS
      auto epi = [&](int row, int col, f32x4 v) {
        f32x4* hp = (f32x4*)(HRES + (size_t)row * D + col);
        *hp = *hp + v;
      };
      auto epi8 = [&](int row, int col, f32x4 a, f32x4 b) {
        f32x4* hp = (f32x4*)(HRES + (size_t)row * D + col);
        const f32x4 ha = hp[0], hb = hp[1];
        hp[0] = ha + a; hp[1] = hb + b;
      };
      for (int t = bid; t < NMT * 8; t += G) {
        int pm, pn; tile_map(t, NMT, 8, pm, pn);
        gemm_tile(MERGED, D, WOUT, D, pm * 256, pn * 256, D, epi8, wave_s);
      }
      tail_gemm8(MERGED + (size_t)TAIL0 * D, D, WOUT, D, D / 16, D, epi, wave_s);
    }
    xcd_barrier(xbar, wave_s);

    {
      PHASE_IDS
      rmsnorm_rows(HRES, p.in[13] + (size_t)l * D, HN, gw, NGW, lane);
    }
    xcd_barrier(xbar, wave_s);

    for (int rep = 0; rep < REP_P9; ++rep) {
      PHASE_PTRS
      auto epi = [&](int row, int col, f32x4 v) {
        float a0 = fmaxf(v[0], 0.f), a1 = fmaxf(v[1], 0.f), a2 = fmaxf(v[2], 0.f), a3 = fmaxf(v[3], 0.f);
        uint2 o; o.x = pk2(a0 * a0, a1 * a1); o.y = pk2(a2 * a2, a3 * a3);
        *(uint2*)(UB + (size_t)row * DFF + col) = o;
      };
      auto epi8 = [&](int row, int col, f32x4 a, f32x4 b) {
        const float a0 = fmaxf(a[0], 0.f), a1 = fmaxf(a[1], 0.f), a2 = fmaxf(a[2], 0.f), a3 = fmaxf(a[3], 0.f);
        const float b0 = fmaxf(b[0], 0.f), b1 = fmaxf(b[1], 0.f), b2 = fmaxf(b[2], 0.f), b3 = fmaxf(b[3], 0.f);
        uint4 o; o.x = pk2(a0 * a0, a1 * a1); o.y = pk2(a2 * a2, a3 * a3); o.z = pk2(b0 * b0, b1 * b1); o.w = pk2(b2 * b2, b3 * b3);
        *(uint4*)(UB + (size_t)row * DFF + col) = o;
      };
      const int nN = DFF / 256, ntiles = NMT * nN;
      for (int t = bid; t < ntiles; t += G) {
        int pm, pn; tile_map(t, NMT, nN, pm, pn);
        gemm_tile(HN, D, WMI, D, pm * 256, pn * 256, D, epi8, wave_s);
      }
      tail_gemm8(HN + (size_t)TAIL0 * D, D, WMI, D, DFF / 16, D, epi, wave_s);
    }
    xcd_barrier(xbar, wave_s);

    {
      PHASE_PTRS
      auto epi = [&](int row, int col, f32x4 v) {
        f32x4* hp = (f32x4*)(HRES + (size_t)row * D + col);
        *hp = *hp + v;
      };
      auto epi8 = [&](int row, int col, f32x4 a, f32x4 b) {
        f32x4* hp = (f32x4*)(HRES + (size_t)row * D + col);
        const f32x4 ha = hp[0], hb = hp[1];
        hp[0] = ha + a; hp[1] = hb + b;
      };
      for (int t = bid; t < NMT * 8; t += G) {
        int pm, pn; tile_map(t, NMT, 8, pm, pn);
        gemm_tile(UB, DFF, WMO, DFF, pm * 256, pn * 256, DFF, epi8, wave_s);
      }
      tail_gemm8(UB + (size_t)TAIL0 * DFF, DFF, WMO, DFF, D / 16, DFF, epi, wave_s);
    }
    xcd_barrier(xbar, wave_s);
  }

  {
    BLOCK_IDS
    PHASE_IDS
    const float* g = p.in[16];
    for (int r0 = gw; r0 < SEQ; r0 += NGW) {
      const int r = r0 + NMETA;
      float4 v[8];
      float s = 0.f;
#pragma unroll
      for (int j = 0; j < 8; ++j) {
        v[j] = *(const float4*)(HRES + (size_t)r * D + j * 256 + lane * 4);
        s += v[j].x * v[j].x + v[j].y * v[j].y + v[j].z * v[j].z + v[j].w * v[j].w;
      }
      s = wave_sum(s, lane);
      const float rs = rsqrtf(s * (1.0f / D) + 1e-6f);
#pragma unroll
      for (int j = 0; j < 8; ++j) {
        const float4 gg = *(const float4*)(g + j * 256 + lane * 4);
        __builtin_nontemporal_store((f32x4){v[j].x * rs * gg.x, v[j].y * rs * gg.y, v[j].z * rs * gg.z, v[j].w * rs * gg.w}, (f32x4*)(p.out + (size_t)r0 * D + j * 256 + lane * 4));
      }
    }
  }
}

extern "C" void kernel_launch(void* const* d_in, const int* in_sizes, int n_in, void* d_out, int out_size,
                              void* d_ws, size_t ws_size, hipStream_t stream) {
  static int grid_blocks = 0;
  if (!grid_blocks) {
    int dev = 0, cus = 0, per_cu = 0;
    (void)hipGetDevice(&dev);
    (void)hipDeviceGetAttribute(&cus, hipDeviceAttributeMultiprocessorCount, dev);
    (void)hipFuncSetAttribute((const void*)fwd, hipFuncAttributeMaxDynamicSharedMemorySize, LDS_BYTES);
    (void)hipOccupancyMaxActiveBlocksPerMultiprocessor(&per_cu, (const void*)fwd, 512, LDS_BYTES);
    (void)hipGetLastError();
    grid_blocks = cus > 0 ? cus : 256;
    if (ws_size < WS_END) { fprintf(stderr, "workspace too small: %zu < %zu\n", ws_size, (size_t)WS_END); grid_blocks = -1; }
  }
  if (grid_blocks < 0) return;
  Params p{};
  for (int i = 0; i < 17; ++i) p.in[i] = (const float*)d_in[i];
  p.out = (float*)d_out;
  p.ws = (unsigned char*)d_ws;
  (void)hipMemsetAsync((unsigned char*)d_ws + OFF_BAR, 0, BAR_BYTES, stream);
  void* args[] = {&p};
  hipError_t e = hipLaunchCooperativeKernel((void*)fwd, dim3(grid_blocks), dim3(512), args, LDS_BYTES, stream);
  if (e != hipSuccess) fprintf(stderr, "cooperative launch failed: %s (grid %d)\n", hipGetErrorString(e), grid_blocks);
}
```

```cpp
#include <hip/hip_runtime.h>
#include <hip/hip_bf16.h>
#include <hip/hip_cooperative_groups.h>
#include <cstdio>
#include <type_traits>
namespace cg = cooperative_groups;

typedef unsigned short bf16_t;
typedef short bf16x8 __attribute__((ext_vector_type(8)));
typedef float f32x4 __attribute__((ext_vector_type(4)));
typedef float f32x16 __attribute__((ext_vector_type(16)));
typedef unsigned short u16x4 __attribute__((ext_vector_type(4)));
typedef unsigned u32x4 __attribute__((ext_vector_type(4)));

constexpr int D = 2048, SEQ = 8192, NMETA = 16, NKEYS = SEQ + NMETA, MP = 8448, DEPTH = 4;
constexpr int NIN = 8008, NINP = 8192, DFF = 8192;
constexpr int C_CKV = 2048, C_QIDX = 2304, C_KIDX = 2816, C_WIDX = 2880, C_PIN = 2888, C_GA = 3912, C_GB = 5960;
constexpr int NMT = 32;
constexpr int TAIL0 = 8192;

constexpr size_t SZ_HRES = (size_t)MP * D * 4, SZ_HN = (size_t)MP * D * 2, SZ_PROJ = (size_t)MP * NINP * 2;
constexpr size_t OFF_HRES = 0;
constexpr size_t OFF_HN = OFF_HRES + SZ_HRES;
constexpr size_t OFF_PROJ = OFF_HN + SZ_HN;
constexpr size_t OFF_CKV = OFF_PROJ + SZ_PROJ;
constexpr size_t OFF_KIDX = OFF_CKV + (size_t)MP * 256 * 2;
constexpr size_t OFF_YPOOL = OFF_KIDX + (size_t)MP * 64 * 2;
constexpr size_t OFF_YP2 = OFF_YPOOL + (size_t)MP * 1024 * 2;
constexpr size_t OFF_QLAT = OFF_YP2 + (size_t)MP * 1024 * 2;
constexpr size_t OFF_OLAT = OFF_QLAT + (size_t)MP * 4096 * 2;
constexpr size_t OFF_O = OFF_OLAT + (size_t)MP * 4096 * 2;
constexpr size_t OFF_MB = OFF_O + (size_t)MP * D * 2;
constexpr size_t OFF_MERGED = OFF_MB + (size_t)MP * D * 4;
constexpr size_t OFF_WIN = OFF_MERGED + (size_t)MP * D * 2;
constexpr size_t OFF_WUK = OFF_WIN + (size_t)NINP * D * 2;
constexpr size_t OFF_WUV = OFF_WUK + (size_t)16 * 256 * 256 * 2;
constexpr size_t OFF_WAO = OFF_WUV + (size_t)16 * 256 * 256 * 2;
constexpr size_t OFF_WPOOL = OFF_WAO + (size_t)D * D * 2;
constexpr size_t OFF_WPO = OFF_WPOOL + (size_t)4 * 256 * 256 * 2;
constexpr size_t OFF_WOUT = OFF_WPO + (size_t)D * 1024 * 2;
constexpr size_t OFF_WMI = OFF_WOUT + (size_t)D * D * 2;
constexpr size_t OFF_WMO = OFF_WMI + (size_t)DFF * D * 2;
constexpr size_t OFF_BAR = OFF_WMO + (size_t)D * DFF * 2;
constexpr size_t BAR_BYTES = 16384;
constexpr size_t WS_END = OFF_BAR + BAR_BYTES;

constexpr int SCLD = 8448;
constexpr int ST_LD = 272;
constexpr int LDS_SC_BYTES = 4 * SCLD * 4;
constexpr int LDS_IDX_OFF = (8 * 32 * ST_LD * 2 > LDS_SC_BYTES) ? 8 * 32 * ST_LD * 2 : LDS_SC_BYTES;
constexpr int CAND_CAP = 1024;
constexpr int LDS_CAND_OFF = LDS_IDX_OFF + 4 * 256 * 4;
constexpr int LDS_XB_OFF = LDS_CAND_OFF + 4 * CAND_CAP * 4;
constexpr int LDS_XCH_OFF = LDS_XB_OFF + 16;
constexpr int CAND_CAP2 = CAND_CAP / 2;
constexpr int LDS_BYTES = LDS_XCH_OFF + 144;

#ifndef REP_P1
#define REP_P1 1
#endif
#ifndef REP_P4
#define REP_P4 1
#endif
#ifndef REP_SC
#define REP_SC 1
#endif
#ifndef REP_SEL
#define REP_SEL 1
#endif
#ifndef REP_ATT
#define REP_ATT 1
#endif
#ifndef REP_P9
#define REP_P9 1
#endif
struct Params {
  const float* in[17];
  float* out;
  unsigned char* ws;
};

__device__ __forceinline__ unsigned short f2bf(float f) {
  unsigned u = __float_as_uint(f);
  u += 0x7FFFu + ((u >> 16) & 1u);
  return (unsigned short)(u >> 16);
}
__device__ __forceinline__ float bf2f(unsigned short h) { return __uint_as_float(((unsigned)h) << 16); }
typedef float f32x2_t __attribute__((ext_vector_type(2)));
typedef __bf16 bf16x2_t __attribute__((ext_vector_type(2)));
__device__ __forceinline__ unsigned pk2(float a, float b) { const f32x2_t f = {a, b}; return __builtin_bit_cast(unsigned, __builtin_convertvector(f, bf16x2_t)); }
__device__ __forceinline__ float shx(float v, int o, int lane) { return __int_as_float(__builtin_amdgcn_ds_bpermute((lane ^ o) << 2, __float_as_int(v))); }
__device__ __forceinline__ int shxi(int v, int o, int lane) { return __builtin_amdgcn_ds_bpermute((lane ^ o) << 2, v); }
__device__ __forceinline__ float wave_sum(float v, int lane) {
#pragma unroll
  for (int o = 1; o < 64; o <<= 1) v += shx(v, o, lane);
  return v;
}
__device__ __forceinline__ int lane_id() { return (int)__builtin_amdgcn_mbcnt_hi(~0u, __builtin_amdgcn_mbcnt_lo(~0u, 0u)); }
__device__ __forceinline__ float sigmoidf(float x) { return __builtin_amdgcn_rcpf(1.0f + __builtin_amdgcn_exp2f(-1.4426950408889634f * x)); }

constexpr int BM = 256, BK = 64, HALF = 128, HT = HALF * BK;
__device__ __forceinline__ int lds_byte(int r, int c) {
  int st = (r >> 4) * 2 + (c >> 5), rr = r & 15, cc = c & 31, ob = rr * 64 + cc * 2;
  return st * 1024 + (ob ^ (((ob >> 9) & 1) << 5));
}
__device__ __forceinline__ void stage_rc(int b, int& R, int& C) {
  int st = b / 1024, sb = b % 1024, swz = sb ^ (((sb >> 9) & 1) << 5);
  R = (st >> 1) * 16 + swz / 64;
  C = (st & 1) * 32 + (swz % 64) / 2;
}

template <class Epi>
__device__ __forceinline__ void gemm_tile(const bf16_t* __restrict__ A, const int lda, const bf16_t* __restrict__ Bt, const int ldb,
                                          const int brow, const int bcol, const int K, const Epi& epi, const int wave_s) {
  extern __shared__ __attribute__((aligned(16))) bf16_t shm[];
#define SA(b, h) (shm + ((b) * 2 + (h)) * HT)
#define SB(b, h) (shm + (4 + (b) * 2 + (h)) * HT)
#define STAGE_A(P, br, kt)                                                                                                   \
  do {                                                                                                                       \
    const bf16_t* _g = A + (long)(br) * lda + (long)(kt) * BK;                                                               \
    __builtin_amdgcn_global_load_lds((const unsigned*)(_g + aoff0), (unsigned*)((char*)(P) + sb0), 16, 0, 0);               \
    __builtin_amdgcn_global_load_lds((const unsigned*)(_g + aoff1), (unsigned*)((char*)(P) + sb1), 16, 0, 0);               \
  } while (0)
#define STAGE_B(P, br, kt)                                                                                                   \
  do {                                                                                                                       \
    const bf16_t* _g = Bt + (long)(br) * ldb + (long)(kt) * BK;                                                              \
    __builtin_amdgcn_global_load_lds((const unsigned*)(_g + boff0), (unsigned*)((char*)(P) + sb0), 16, 0, 0);               \
    __builtin_amdgcn_global_load_lds((const unsigned*)(_g + boff1), (unsigned*)((char*)(P) + sb1), 16, 0, 0);               \
  } while (0)
#define LDA(dst, b, h)                                                                                                       \
  for (int m = 0; m < 4; ++m)                                                                                                \
    for (int k = 0; k < 2; ++k) dst[m][k] = *reinterpret_cast<const bf16x8*>((char*)SA(b, h) + lds_byte(wr * 64 + m * 16 + fr, k * 32 + fq * 8))
#define LDB(dst, b, h)                                                                                                       \
  for (int n = 0; n < 2; ++n)                                                                                                \
    for (int k = 0; k < 2; ++k) dst[n][k] = *reinterpret_cast<const bf16x8*>((char*)SB(b, h) + lds_byte(wc * 32 + n * 16 + fr, k * 32 + fq * 8))
#define MMA(ai, bj, At_, Bt_)                                                                                                \
  do {                                                                                                                       \
    __builtin_amdgcn_s_setprio(1);                                                                                           \
    for (int m = 0; m < 4; ++m)                                                                                              \
      for (int n = 0; n < 2; ++n)                                                                                            \
        for (int k = 0; k < 2; ++k)                                                                                          \
          acc[ai][bj][m][n] = __builtin_amdgcn_mfma_f32_16x16x32_bf16(Bt_[n][k], At_[m][k], acc[ai][bj][m][n], 0, 0, 0);    \
    __builtin_amdgcn_s_setprio(0);                                                                                           \
  } while (0)
#define WAIT_V(n) asm volatile("s_waitcnt vmcnt(" #n ")" ::: "memory")
#define WAIT_L(n) asm volatile("s_waitcnt lgkmcnt(" #n ")" ::: "memory")
#define BAR __builtin_amdgcn_s_barrier()
#define SCHED __builtin_amdgcn_sched_barrier(0)

  int tx = wave_s * 64 + lane_id();
  asm volatile("" : "+v"(tx));
  const int wid = tx >> 6, lane = tx & 63, wr = wid >> 2, wc = wid & 3, fr = lane & 15, fq = lane >> 4;
  const int sb0 = tx * 16, sb1 = sb0 + 8192;
  int r0, c0, r1, c1;
  stage_rc(sb0, r0, c0);
  stage_rc(sb1, r1, c1);
  const unsigned aoff0 = (unsigned)(r0 * lda + c0), aoff1 = (unsigned)(r1 * lda + c1);
  const int rp0 = (r0 & ~31) | (8 * ((r0 & 15) >> 2) + 4 * ((r0 >> 4) & 1) + (r0 & 3));
  const int rp1 = (r1 & ~31) | (8 * ((r1 & 15) >> 2) + 4 * ((r1 >> 4) & 1) + (r1 & 3));
  const unsigned boff0 = (unsigned)(rp0 * ldb + c0), boff1 = (unsigned)(rp1 * ldb + c1);
  f32x4 acc[2][2][4][2];
#pragma unroll
  for (int a = 0; a < 2; ++a)
#pragma unroll
    for (int b = 0; b < 2; ++b)
#pragma unroll
      for (int m = 0; m < 4; ++m)
#pragma unroll
        for (int n = 0; n < 2; ++n) acc[a][b][m][n] = (f32x4){0.f, 0.f, 0.f, 0.f};
  bf16x8 At[4][2], B0[2][2], B1[2][2];
  const int nt = K / BK;
  STAGE_B(SB(0, 0), bcol, 0);
  STAGE_A(SA(0, 0), brow, 0);
  STAGE_B(SB(0, 1), bcol + HALF, 0);
  STAGE_A(SA(0, 1), brow + HALF, 0);
  if (wr == 1) BAR;
  WAIT_V(4);
  BAR;
  STAGE_B(SB(1, 0), bcol, 1);
  STAGE_A(SA(1, 0), brow, 1);
  STAGE_B(SB(1, 1), bcol + HALF, 1);
  WAIT_V(6);
  BAR;
  for (int t = 0; t < nt - 2; t += 2) {
    LDB(B0, 0, 0); SCHED; LDA(At, 0, 0); STAGE_A(SA(1, 1), brow + HALF, t + 1);
    WAIT_L(8); BAR; WAIT_L(0); MMA(0, 0, At, B0); BAR; SCHED;
    LDB(B1, 0, 1); STAGE_B(SB(0, 0), bcol, t + 2);
    BAR; WAIT_L(0); MMA(0, 1, At, B1); BAR;
    LDA(At, 0, 1); STAGE_A(SA(0, 0), brow, t + 2);
    BAR; WAIT_L(0); MMA(1, 0, At, B0); BAR; SCHED;
    STAGE_B(SB(0, 1), bcol + HALF, t + 2);
    WAIT_V(6); BAR; MMA(1, 1, At, B1); BAR;
    LDB(B0, 1, 0); SCHED; LDA(At, 1, 0); STAGE_A(SA(0, 1), brow + HALF, t + 2);
    WAIT_L(8); BAR; WAIT_L(0); MMA(0, 0, At, B0); BAR; SCHED;
    LDB(B1, 1, 1); STAGE_B(SB(1, 0), bcol, t + 3);
    BAR; WAIT_L(0); MMA(0, 1, At, B1); BAR;
    LDA(At, 1, 1); STAGE_A(SA(1, 0), brow, t + 3);
    BAR; WAIT_L(0); MMA(1, 0, At, B0); BAR; SCHED;
    STAGE_B(SB(1, 1), bcol + HALF, t + 3);
    WAIT_V(6); BAR; MMA(1, 1, At, B1); BAR;
  }
  {
    LDB(B0, 0, 0); LDA(At, 0, 0); STAGE_A(SA(1, 1), brow + HALF, nt - 1);
    BAR; WAIT_L(0); MMA(0, 0, At, B0); BAR;
    LDB(B1, 0, 1); BAR; WAIT_L(0); MMA(0, 1, At, B1); BAR;
    LDA(At, 0, 1); WAIT_V(4); BAR; WAIT_L(0); MMA(1, 0, At, B0); MMA(1, 1, At, B1); BAR;
  }
  {
    LDB(B0, 1, 0); LDA(At, 1, 0); WAIT_V(2); BAR; WAIT_L(0); MMA(0, 0, At, B0); BAR;
    LDB(B1, 1, 1); WAIT_V(0); BAR; WAIT_L(0); MMA(0, 1, At, B1); BAR;
    LDA(At, 1, 1); BAR; WAIT_L(0); MMA(1, 0, At, B0); MMA(1, 1, At, B1); BAR;
  }
  if (wr == 0) BAR;
#pragma unroll
  for (int ai = 0; ai < 2; ++ai)
#pragma unroll
    for (int m = 0; m < 4; ++m)
#pragma unroll
      for (int bj = 0; bj < 2; ++bj)
        epi(brow + ai * HALF + wr * 64 + m * 16 + fr, bcol + bj * HALF + wc * 32 + fq * 8, acc[ai][bj][m][0], acc[ai][bj][m][1]);
#undef SA
#undef SB
#undef STAGE_A
#undef STAGE_B
#undef LDA
#undef LDB
#undef MMA
}


template <class Epi>
__device__ __forceinline__ void tail_gemm8(const bf16_t* __restrict__ A, const int lda, const bf16_t* __restrict__ Bt, const int ldb,
                                           const int nct, const int K, const Epi& epi, const int wave_s) {
  extern __shared__ __attribute__((aligned(16))) bf16_t shm[];
  float* red = (float*)shm;
  int tx = wave_s * 64 + lane_id(), bid_ = blockIdx.x;
  asm volatile("" : "+v"(tx), "+s"(bid_));
  const int wave = tx >> 6, lane = tx & 63, fr = lane & 15, fq = lane >> 4;
  const int kw = K >> 3;
  for (int ct = bid_; ct < nct; ct += gridDim.x) {
    const bf16_t* ap = A + (size_t)fr * lda + wave * kw + fq * 8;
    const bf16_t* bp = Bt + (size_t)(ct * 16 + fr) * ldb + wave * kw + fq * 8;
    f32x4 acc = (f32x4){0.f, 0.f, 0.f, 0.f};
#pragma unroll 8
    for (int k = 0; k < kw; k += 32) {
      const bf16x8 a = *(const bf16x8*)(ap + k);
      const bf16x8 b = *(const bf16x8*)(bp + k);
      acc = __builtin_amdgcn_mfma_f32_16x16x32_bf16(b, a, acc, 0, 0, 0);
    }
    *(f32x4*)(red + (wave * 64 + lane) * 4) = acc;
    __syncthreads();
    if (wave == 0) {
      f32x4 sum = acc;
#pragma unroll
      for (int w = 1; w < 8; ++w) sum += *(const f32x4*)(red + (w * 64 + lane) * 4);
      epi(TAIL0 + fr, ct * 16 + fq * 4, sum);
    }
    __syncthreads();
  }
}
template <class Epi>
__device__ __forceinline__ void tail_tile1(const bf16_t* __restrict__ A, const int lda, const bf16_t* __restrict__ Bt, const int ldb,
                                           const int ct, const int K, const int lane, const Epi& epi) {
  const int fr = lane & 15, fq = lane >> 4;
  const bf16_t* ap = A + (size_t)fr * lda + fq * 8;
  const bf16_t* bp = Bt + (size_t)(ct * 16 + fr) * ldb + fq * 8;
  f32x4 acc = (f32x4){0.f, 0.f, 0.f, 0.f};
#pragma unroll 8
  for (int k = 0; k < K; k += 32) {
    const bf16x8 a = *(const bf16x8*)(ap + k);
    const bf16x8 b = *(const bf16x8*)(bp + k);
    acc = __builtin_amdgcn_mfma_f32_16x16x32_bf16(b, a, acc, 0, 0, 0);
  }
  epi(TAIL0 + fr, ct * 16 + fq * 4, acc);
}

__device__ __forceinline__ void tile_map(int wgid, int nM, int nN, int& pm, int& pn) {
  const int nwg = nM * nN, q = nwg / 8, r = nwg % 8, xcd = wgid % 8, off = wgid / 8;
  wgid = (xcd < r ? xcd * (q + 1) : r * (q + 1) + (xcd - r) * q) + off;
  const int nig = 8 * nN, gid = wgid / nig, fm = gid * 8, gsz = (nM - fm) < 8 ? (nM - fm) : 8;
  pm = fm + ((wgid % nig) % gsz);
  pn = (wgid % nig) / gsz;
}


typedef unsigned u32x2 __attribute__((ext_vector_type(2)));
template <int GRP>
__device__ __forceinline__ void pool_group(const bf16_t* __restrict__ PROJ, bf16_t* __restrict__ YPOOL, const int r, const int lane) {
  constexpr int W = 2 << GRP;
  u32x2 raw[W];
#pragma unroll
  for (int i = 0; i < W; ++i) {
    const int t = (r - i) < 0 ? 0 : (r - i);
    raw[i] = *(const u32x2*)(PROJ + (size_t)t * NINP + C_PIN + GRP * 256 + lane * 4);
  }
  float s0 = 0.f, s1 = 0.f, s2 = 0.f, s3 = 0.f;
#pragma unroll
  for (int i = W - 1; i >= 0; --i) {
    if (r - i >= 0) {
      s0 += bf2f(raw[i].x & 0xffff); s1 += bf2f(raw[i].x >> 16); s2 += bf2f(raw[i].y & 0xffff); s3 += bf2f(raw[i].y >> 16);
    }
  }
  const float c0 = bf2f(raw[0].x & 0xffff), c1 = bf2f(raw[0].x >> 16), c2 = bf2f(raw[0].y & 0xffff), c3 = bf2f(raw[0].y >> 16);
  const int cntw = (r + 1) < W ? (r + 1) : W;
  const float inv = 1.0f / (float)cntw;
  uint2 o; o.x = pk2(s0 * inv - c0, s1 * inv - c1); o.y = pk2(s2 * inv - c2, s3 * inv - c3);
  *(uint2*)(YPOOL + (size_t)r * 1024 + GRP * 256 + lane * 4) = o;
}


__device__ __forceinline__ void rmsnorm_rows(const float* __restrict__ HRES, const float* __restrict__ g, bf16_t* __restrict__ HN,
                                             const int gw, const int NGW, const int lane) {
  for (int r = gw; r < NKEYS; r += 2 * NGW) {
    const int r2 = (r + NGW < NKEYS) ? r + NGW : r;
    f32x4 va[8], vb[8];
#pragma unroll
    for (int j = 0; j < 8; ++j) {
      va[j] = *(const f32x4*)(HRES + (size_t)r * D + j * 256 + lane * 4);
      vb[j] = *(const f32x4*)(HRES + (size_t)r2 * D + j * 256 + lane * 4);
    }
    float sa = 0.f, sb = 0.f;
#pragma unroll
    for (int j = 0; j < 8; ++j) {
      sa += va[j][0] * va[j][0] + va[j][1] * va[j][1] + va[j][2] * va[j][2] + va[j][3] * va[j][3];
      sb += vb[j][0] * vb[j][0] + vb[j][1] * vb[j][1] + vb[j][2] * vb[j][2] + vb[j][3] * vb[j][3];
    }
#pragma unroll
    for (int o = 1; o < 64; o <<= 1) { sa += shx(sa, o, lane); sb += shx(sb, o, lane); }
    const float ra = rsqrtf(sa * (1.0f / D) + 1e-6f), rb = rsqrtf(sb * (1.0f / D) + 1e-6f);
#pragma unroll
    for (int j = 0; j < 8; ++j) {
      const f32x4 gg = *(const f32x4*)(g + j * 256 + lane * 4);
      uint2 oa, ob;
      oa.x = pk2(va[j][0] * ra * gg[0], va[j][1] * ra * gg[1]); oa.y = pk2(va[j][2] * ra * gg[2], va[j][3] * ra * gg[3]);
      ob.x = pk2(vb[j][0] * rb * gg[0], vb[j][1] * rb * gg[1]); ob.y = pk2(vb[j][2] * rb * gg[2], vb[j][3] * rb * gg[3]);
      *(uint2*)(HN + (size_t)r * D + j * 256 + lane * 4) = oa;
      *(uint2*)(HN + (size_t)r2 * D + j * 256 + lane * 4) = ob;
    }
  }
}

__device__ __forceinline__ void wconv_T(const float* __restrict__ W, int K, int N, int Npad, bf16_t* __restrict__ WT, int ldt,
                                        int nbatch, size_t strideW, size_t strideWT, float scale, const int wave_s, const bool nt_out = false) {
  extern __shared__ __attribute__((aligned(16))) bf16_t shm[];
  float* tile = (float*)shm;
  const int nkb = K / 64, nnb = Npad / 256, per = nkb * nnb, items = per * nbatch;
  int t = wave_s * 64 + lane_id(), bid_ = blockIdx.x;
  asm volatile("" : "+v"(t), "+s"(bid_));
  for (int item = bid_; item < items; item += gridDim.x) {
    const int b = item / per, it = item % per, kb = it % nkb, nb = it / nkb, k0 = kb * 64, n0 = nb * 256;
    const float* Wb = W + (size_t)b * strideW;
    bf16_t* WTb = WT + (size_t)b * strideWT;
    float4 v[8];
#pragma unroll
    for (int i = 0; i < 8; ++i) {
      const int kk = (t >> 4) + 32 * (i & 1), n4 = (t & 15) * 4 + (i >> 1) * 64;
      v[i] = make_float4(0.f, 0.f, 0.f, 0.f);
      if (n0 + n4 < N) {
        const f32x4 w4 = __builtin_nontemporal_load((const f32x4*)(Wb + (size_t)(k0 + kk) * N + n0 + n4));
        v[i] = make_float4(w4[0], w4[1], w4[2], w4[3]);
      }
    }
#pragma unroll
    for (int i = 0; i < 8; ++i) {
      const int kk = (t >> 4) + 32 * (i & 1), c4 = (t & 15) * 4;
      float* tp = tile + (i >> 1) * (64 * 65) + kk * 65 + c4;
      tp[0] = v[i].x; tp[1] = v[i].y; tp[2] = v[i].z; tp[3] = v[i].w;
    }
    __syncthreads();
    {
      const int n = t >> 3, kc = (t & 7) * 8;
#pragma unroll
      for (int sub = 0; sub < 4; ++sub) {
        const float* tp = tile + sub * (64 * 65) + kc * 65 + n;
        uint4 o;
        o.x = pk2(tp[0 * 65] * scale, tp[1 * 65] * scale);
        o.y = pk2(tp[2 * 65] * scale, tp[3 * 65] * scale);
        o.z = pk2(tp[4 * 65] * scale, tp[5 * 65] * scale);
        o.w = pk2(tp[6 * 65] * scale, tp[7 * 65] * scale);
        u32x4* dst = (u32x4*)(WTb + (size_t)(n0 + sub * 64 + n) * ldt + k0 + kc);
        if (nt_out) __builtin_nontemporal_store((u32x4){o.x, o.y, o.z, o.w}, dst);
        else *dst = (u32x4){o.x, o.y, o.z, o.w};
      }
    }
    __syncthreads();
  }
}


#define XB_TMO      128
#define XB_XCNT(j)  (256  + 64 * (j))
#define XB_XSUB(j)  (1280 + 64 * (j))
#define XB_XGEN(j)  (2304 + 64 * (j))
#define XB_TOP      3328
#define XB_TOPGEN   3392
#define XCD_BAR_WORDS 3456
#define XB_SPIN_CAP (1u << 18)
#define LAS __attribute__((address_space(3)))
__device__ __forceinline__ unsigned xb_ld(unsigned* p)              { return __hip_atomic_load(p, __ATOMIC_RELAXED, __HIP_MEMORY_SCOPE_AGENT); }
__device__ __forceinline__ unsigned xb_add(unsigned* p, unsigned v) { return __hip_atomic_fetch_add(p, v, __ATOMIC_RELAXED, __HIP_MEMORY_SCOPE_AGENT); }
__device__ __forceinline__ unsigned xb_xcc_id() { return (unsigned)__builtin_amdgcn_s_getreg((3 << 11) | 20) & 0xFu; }
#define XB_SPIN(cond, bar) do { unsigned _sp = 0; while (cond) { __builtin_amdgcn_s_sleep(1); \
    if ((++_sp & 255u) == 0u) { if (xb_ld(&(bar)[XB_TMO])) break; if (_sp > XB_SPIN_CAP) { atomicAdd(&(bar)[XB_TMO], 1u); break; } } } } while (0)
struct XcdBarrier { unsigned* bar; unsigned x; volatile LAS unsigned* st; };
__device__ __forceinline__ XcdBarrier xcd_barrier_post(unsigned* bar, volatile LAS unsigned* st) {
    XcdBarrier b; b.bar = bar; b.x = xb_xcc_id(); b.st = st;
    if (threadIdx.x == 0) (void)xb_add(&bar[XB_XCNT(b.x)], 1u);
    return b;
}
__device__ __forceinline__ void xcd_barrier_complete(unsigned* bar, unsigned x, unsigned& nloc, unsigned& nx) {
    const unsigned G = gridDim.x * gridDim.y * gridDim.z;
    unsigned sum, cnt, mine, sp = 0u;
    for (;;) {
        sum = 0u; cnt = 0u; mine = 0u;
#pragma unroll
        for (unsigned j = 0; j < 16; ++j) { const unsigned c = xb_ld(&bar[XB_XCNT(j)]); sum += c; cnt += (c > 0u) ? 1u : 0u; mine = (j == x) ? c : mine; }
        if (sum == G) break;
        __builtin_amdgcn_s_sleep(1);
        if ((++sp & 255u) == 0u) { if (xb_ld(&bar[XB_TMO])) break; if (sp > XB_SPIN_CAP) { atomicAdd(&bar[XB_TMO], 1u); break; } }
    }
    nloc = mine > 0u ? mine : 1u; nx = cnt > 0u ? cnt : 1u;
}
__device__ __forceinline__ void xcd_barrier(const XcdBarrier& b, const int wave_s) {
    asm volatile("s_waitcnt vmcnt(0)" ::: "memory");
    __syncthreads();
    if (wave_s == 0 && lane_id() == 0) {
        unsigned* bar = b.bar;
        __builtin_amdgcn_s_waitcnt(0);
        unsigned nloc = b.st[0], nx = b.st[1];
        if (nloc == 0u) { xcd_barrier_complete(bar, b.x, nloc, nx); b.st[0] = nloc; b.st[1] = nx; }
        const unsigned old = xb_add(&bar[XB_XSUB(b.x)], 1u);
        const unsigned gen = old / nloc;
        if (old + 1u == (gen + 1u) * nloc) {
            __builtin_amdgcn_fence(__ATOMIC_RELEASE, "agent");
            asm volatile("s_waitcnt vmcnt(0)" ::: "memory");
            const unsigned og = xb_add(&bar[XB_TOP], 1u);
            const unsigned tg = og / nx;
            if (og + 1u == (tg + 1u) * nx) xb_add(&bar[XB_TOPGEN], 1u);
            else XB_SPIN(xb_ld(&bar[XB_TOPGEN]) == tg, bar);
            __builtin_amdgcn_fence(__ATOMIC_ACQUIRE, "agent");
            xb_add(&bar[XB_XGEN(b.x)], 1u);
            asm volatile("s_waitcnt vmcnt(0)" ::: "memory");
        } else {
            XB_SPIN(xb_ld(&bar[XB_XGEN(b.x)]) == gen, bar);
            __builtin_amdgcn_fence(__ATOMIC_ACQUIRE, "agent");
            asm volatile("s_waitcnt vmcnt(0)" ::: "memory");
        }
    }
    __syncthreads();
}

__global__ void __launch_bounds__(512) fwd(Params p) {
  extern __shared__ __attribute__((aligned(16))) bf16_t shm[];
  cg::grid_group grid = cg::this_grid();
  const int wave_s = __builtin_amdgcn_readfirstlane((int)(threadIdx.x >> 6));
  volatile LAS unsigned* xst = (volatile LAS unsigned*)((LAS char*)shm + LDS_XB_OFF);
  if (threadIdx.x == 0) { xst[0] = 0u; xst[1] = 0u; xst[2] = 0u; xst[3] = 0u; }
  __syncthreads();
  const XcdBarrier xbar = xcd_barrier_post((unsigned*)(p.ws + OFF_BAR), xst);
#define BLOCK_IDS                                   \
  int bid = blockIdx.x, G = gridDim.x;              \
  asm volatile("" : "+s"(bid), "+s"(G));            \
  const int NGW = G * 8; (void)NGW;
#define PHASE_PTRS \
  unsigned long long zo_ = 0; \
  asm volatile("" : "+s"(zo_)); \
  unsigned char* wsb = p.ws + zo_; \
  float* HRES = (float*)(wsb + OFF_HRES); \
  bf16_t* HN = (bf16_t*)(wsb + OFF_HN); \
  bf16_t* PROJ = (bf16_t*)(wsb + OFF_PROJ); \
  bf16_t* CKV = (bf16_t*)(wsb + OFF_CKV); \
  bf16_t* KIDX = (bf16_t*)(wsb + OFF_KIDX); \
  bf16_t* YPOOL = (bf16_t*)(wsb + OFF_YPOOL); \
  bf16_t* YP2 = (bf16_t*)(wsb + OFF_YP2); \
  bf16_t* QLAT = (bf16_t*)(wsb + OFF_QLAT); \
  bf16_t* OLAT = (bf16_t*)(wsb + OFF_OLAT); \
  bf16_t* OB = (bf16_t*)(wsb + OFF_O); \
  float* MB = (float*)(wsb + OFF_MB); \
  bf16_t* MERGED = (bf16_t*)(wsb + OFF_MERGED); \
  bf16_t* WIN = (bf16_t*)(wsb + OFF_WIN); \
  bf16_t* WUK = (bf16_t*)(wsb + OFF_WUK); \
  bf16_t* WUV = (bf16_t*)(wsb + OFF_WUV); \
  bf16_t* WAO = (bf16_t*)(wsb + OFF_WAO); \
  bf16_t* WPOOL = (bf16_t*)(wsb + OFF_WPOOL); \
  bf16_t* WPO = (bf16_t*)(wsb + OFF_WPO); \
  bf16_t* WOUT = (bf16_t*)(wsb + OFF_WOUT); \
  bf16_t* WMI = (bf16_t*)(wsb + OFF_WMI); \
  bf16_t* WMO = (bf16_t*)(wsb + OFF_WMO); \
  bf16_t* UB = PROJ; \
  (void)HRES; (void)HN; (void)CKV; (void)KIDX; (void)YPOOL; (void)YP2; (void)QLAT; (void)OLAT; (void)OB; (void)MB; (void)MERGED; (void)WIN; (void)WUK; (void)WUV; (void)WAO; (void)WPOOL; (void)WPO; (void)WOUT; (void)WMI; (void)WMO; (void)UB;
#define PHASE_IDS                                  \
  int tid = wave_s * 64 + lane_id();               \
  asm volatile("" : "+v"(tid));                    \
  const int wave = tid >> 6, lane = tid & 63, gw = bid * 8 + wave; \
  (void)lane; (void)gw; \
  PHASE_PTRS


#pragma unroll 1
  for (int l = 0; l < DEPTH; ++l) {
    BLOCK_IDS
    for (int rep = 0; rep < REP_P1; ++rep) {
      PHASE_IDS
      if (l == 0) {
        const float* g0 = p.in[2];
        for (int r = gw; r < NKEYS; r += NGW) {
          const float* src = (r < NMETA) ? p.in[1] + (size_t)r * D : p.in[0] + (size_t)(r - NMETA) * D;
          f32x4 v[8];
          float sq = 0.f;
#pragma unroll
          for (int j = 0; j < 8; ++j) {
            v[j] = __builtin_nontemporal_load((const f32x4*)(src + j * 256 + lane * 4));
            sq += v[j][0] * v[j][0] + v[j][1] * v[j][1] + v[j][2] * v[j][2] + v[j][3] * v[j][3];
          }
#pragma unroll
          for (int o = 1; o < 64; o <<= 1) sq += shx(sq, o, lane);
          const float rs = rsqrtf(sq * (1.0f / D) + 1e-6f);
#pragma unroll
          for (int j = 0; j < 8; ++j) {
            *(f32x4*)(HRES + (size_t)r * D + j * 256 + lane * 4) = v[j];
            const f32x4 gg = *(const f32x4*)(g0 + j * 256 + lane * 4);
            uint2 o2;
            o2.x = pk2(v[j][0] * rs * gg[0], v[j][1] * rs * gg[1]); o2.y = pk2(v[j][2] * rs * gg[2], v[j][3] * rs * gg[3]);
            *(uint2*)(HN + (size_t)r * D + j * 256 + lane * 4) = o2;
          }
        }
      } else {
        rmsnorm_rows(HRES, p.in[2] + (size_t)l * D, HN, gw, NGW, lane);
      }
      wconv_T(p.in[3] + (size_t)l * D * NIN, D, NIN, NINP, WIN, D, 1, 0, 0, 1.0f, wave_s);
      wconv_T(p.in[7] + (size_t)l * 16 * 256 * 128, 256, 128, 256, WUV, 256, 16, (size_t)256 * 128, (size_t)65536, 1.0f, wave_s);
      wconv_T(p.in[8] + (size_t)l * D * D, D, D, D, WAO, D, 1, 0, 0, 1.0f, wave_s, true);
      wconv_T(p.in[9] + (size_t)l * 4 * 65536, 256, 256, 256, WPOOL, 256, 4, (size_t)65536, (size_t)65536, 1.0f, wave_s);
      wconv_T(p.in[11] + (size_t)l * 1024 * D, 1024, D, D, WPO, 1024, 1, 0, 0, 1.0f, wave_s);
      wconv_T(p.in[12] + (size_t)l * D * D, D, D, D, WOUT, D, 1, 0, 0, 1.0f, wave_s, true);
      wconv_T(p.in[14] + (size_t)l * D * DFF, D, DFF, DFF, WMI, D, 1, 0, 0, 1.0f, wave_s, true);
      wconv_T(p.in[15] + (size_t)l * DFF * D, DFF, D, D, WMO, DFF, 1, 0, 0, 1.0f, wave_s, true);
      {
        const float* wuk = p.in[6] + (size_t)l * 16 * 256 * 128;
        const float sc = 0.08838834764831845f * 1.4426950408889634f;
        for (int i = bid * 512 + tid; i < 16 * 256 * 32; i += G * 512) {
          const int row = i >> 5, kc = (i & 31) * 8;
          uint4 o = make_uint4(0u, 0u, 0u, 0u);
          if (kc < 128) {
            const f32x4 a = __builtin_nontemporal_load((const f32x4*)(wuk + (size_t)row * 128 + kc));
            const f32x4 b = __builtin_nontemporal_load((const f32x4*)(wuk + (size_t)row * 128 + kc + 4));
            o.x = pk2(a[0] * sc, a[1] * sc); o.y = pk2(a[2] * sc, a[3] * sc);
            o.z = pk2(b[0] * sc, b[1] * sc); o.w = pk2(b[2] * sc, b[3] * sc);
          }
          *(uint4*)(WUK + (size_t)row * 256 + kc) = o;
        }
      }
    }
    if (l == 0) grid.sync();
    else xcd_barrier(xbar, wave_s);

    {
      PHASE_PTRS
      auto epi = [&](int row, int col, f32x4 v) {
        uint2 o; o.x = pk2(v[0], v[1]); o.y = pk2(v[2], v[3]);
        *(uint2*)(PROJ + (size_t)row * NINP + col) = o;
      };
      auto epi8 = [&](int row, int col, f32x4 a, f32x4 b) {
        uint4 o; o.x = pk2(a[0], a[1]); o.y = pk2(a[2], a[3]); o.z = pk2(b[0], b[1]); o.w = pk2(b[2], b[3]);
        *(uint4*)(PROJ + (size_t)row * NINP + col) = o;
      };
      const int nN = NINP / 256, ntiles = NMT * nN;
      for (int t = bid; t < ntiles; t += G) {
        int pm, pn; tile_map(t, NMT, nN, pm, pn);
        gemm_tile(HN, D, WIN, D, pm * 256, pn * 256, D, epi8, wave_s);
      }
      tail_gemm8(HN + (size_t)TAIL0 * D, D, WIN, D, NINP / 16, D, epi, wave_s);
    }
    xcd_barrier(xbar, wave_s);

    {
      PHASE_IDS
      const float* gkv = p.in[4] + (size_t)l * 256;
      const float* gik = p.in[5] + (size_t)l * 64;
      for (int r = gw; r < NKEYS; r += NGW) {
        const bf16_t* pr = PROJ + (size_t)r * NINP;
        {
          const uint2 raw = *(const uint2*)(pr + C_CKV + lane * 4);
          float a0 = bf2f(raw.x & 0xffff), a1 = bf2f(raw.x >> 16), a2 = bf2f(raw.y & 0xffff), a3 = bf2f(raw.y >> 16);
          float s = wave_sum(a0 * a0 + a1 * a1 + a2 * a2 + a3 * a3, lane);
          const float rs = rsqrtf(s * (1.0f / 256.0f) + 1e-6f);
          const float4 gg = *(const float4*)(gkv + lane * 4);
          uint2 o; o.x = pk2(a0 * rs * gg.x, a1 * rs * gg.y); o.y = pk2(a2 * rs * gg.z, a3 * rs * gg.w);
          *(uint2*)(CKV + (size_t)r * 256 + lane * 4) = o;
        }
        {
          const float a = bf2f(pr[C_KIDX + lane]);
          const float s = wave_sum(a * a, lane);
          const float rs = rsqrtf(s * (1.0f / 64.0f) + 1e-6f);
          KIDX[((size_t)((r >> 5) * 4 + (lane >> 4)) * 64 + ((lane >> 3) & 1) * 32 + (r & 31)) * 8 + (lane & 7)] = f2bf(a * rs * gik[lane]);
        }
        pool_group<0>(PROJ, YPOOL, r, lane);
        pool_group<1>(PROJ, YPOOL, r, lane);
        pool_group<2>(PROJ, YPOOL, r, lane);
        pool_group<3>(PROJ, YPOOL, r, lane);
      }
      const int ntiles = 16 * NMT;
      for (int t = bid; t < ntiles; t += G) {
        const int h = t / NMT, pm = t % NMT;
        auto epi8 = [&](int row, int col, f32x4 a, f32x4 b) {
          uint4 o; o.x = pk2(a[0], a[1]); o.y = pk2(a[2], a[3]); o.z = pk2(b[0], b[1]); o.w = pk2(b[2], b[3]);
          *(uint4*)(QLAT + (size_t)row * 4096 + h * 256 + col) = o;
        };
        gemm_tile(PROJ + h * 128, NINP, WUK + (size_t)h * 65536, 256, pm * 256, 0, 128, epi8, wave_s);
      }
      int tid2 = wave_s * 64 + lane_id();
      asm volatile("" : "+v"(tid2));
      const int lane2 = tid2 & 63, gw2 = bid * 8 + (tid2 >> 6);
      for (int task = gw2; task < 16 * 16; task += NGW) {
        const int h = task >> 4, ct = task & 15;
        auto epi = [&](int row, int col, f32x4 v) {
          uint2 o; o.x = pk2(v[0], v[1]); o.y = pk2(v[2], v[3]);
          *(uint2*)(QLAT + (size_t)row * 4096 + h * 256 + col) = o;
        };
        tail_tile1(PROJ + (size_t)TAIL0 * NINP + h * 128, NINP, WUK + (size_t)h * 65536, 256, ct, 128, lane2, epi);
      }
    }
    xcd_barrier(xbar, wave_s);

    {
      PHASE_IDS
      unsigned* SC = (unsigned*)shm;
      int* IDX = (int*)((char*)shm + LDS_IDX_OFF);
      int* CAND = (int*)((char*)shm + LDS_CAND_OFF);
      const int nunits = NKEYS / 4;
      unsigned* qctr = (unsigned*)(wsb + OFF_BAR) + 3520 + 64 * l;
      volatile int* QW = (volatile int*)((char*)shm + LDS_XCH_OFF) + 32;
      unsigned* HIST = (unsigned*)CAND;
      {
        u32x4* hz = (u32x4*)HIST + tid * 2;
        unsigned z = 0u;
        asm volatile("" : "+v"(z));
        hz[0] = (u32x4){z, z, z, z}; hz[1] = (u32x4){z, z, z, z};
      }
      int tkt;
      {
        if (wave == 0 && lane == 0) *QW = (int)__hip_atomic_fetch_add(qctr, 1u, __ATOMIC_RELAXED, __HIP_MEMORY_SCOPE_AGENT);
        __syncthreads();
        tkt = __builtin_amdgcn_readfirstlane(*QW);
      }
#pragma unroll 1
      while (tkt < nunits) {
        int nxt = 0;
        if (wave == 0 && lane == 0) nxt = (int)__hip_atomic_fetch_add(qctr, 1u, __ATOMIC_RELAXED, __HIP_MEMORY_SCOPE_AGENT);
        const int u = nunits - 1 - tkt;
        int lane_u_ = lane;
        asm volatile("" : "+v"(lane_u_));
        const int lane = lane_u_;
        const int q0 = u * 4;
        const int nk = q0 + 4;
        const int nit = (nk + 255) >> 8;
        const int ntile = nit * 8;
        for (int rsc = 0; rsc < REP_SC; ++rsc) {
          const int r = lane & 31, kg = lane >> 5, qi = r & 3, head = r >> 2;
          bf16x8 qa[4];
          const bf16_t* qp = PROJ + (size_t)(q0 + qi) * NINP + C_QIDX + head * 64 + kg * 8;
#pragma unroll
          for (int ks = 0; ks < 4; ++ks) qa[ks] = *(const bf16x8*)(qp + ks * 16);
          float wv[4][4];
#pragma unroll
          for (int i = 0; i < 4; ++i)
#pragma unroll
            for (int j = 0; j < 4; ++j) wv[i][j] = bf2f(PROJ[(size_t)(q0 + j) * NINP + C_WIDX + 2 * i + kg]);
          const unsigned klane = (unsigned)lane * 8u;
          bf16x8 kbuf[4][4];
#pragma unroll
          for (int pi = 0; pi < 3; ++pi) {
            const int tp = wave_s + 8 * ((pi < nit) ? pi : nit - 1);
#pragma unroll
            for (int ks = 0; ks < 4; ++ks) kbuf[pi][ks] = *(const bf16x8*)(KIDX + (size_t)(tp * 4 + ks) * 512 + klane);
          }
          for (int base = 0; base < nit; base += 4) {
#pragma unroll
            for (int uu = 0; uu < 4; ++uu) {
              const int i = (base + uu < nit) ? base + uu : nit - 1;
              {
                {
                  const int ip = (base + uu + 3 < nit) ? base + uu + 3 : nit - 1;
                  const int tp = wave_s + 8 * ip;
#pragma unroll
                  for (int ks = 0; ks < 4; ++ks) kbuf[(uu + 3) % 4][ks] = *(const bf16x8*)(KIDX + (size_t)(tp * 4 + ks) * 512 + klane);
                }
                if (base + uu < nit) {
                const int tt = wave_s + 8 * i;
                const int key = tt * 32 + r;
                f32x16 acc;
#pragma unroll
                for (int q = 0; q < 16; ++q) acc[q] = 0.f;
#pragma unroll
                for (int ks = 0; ks < 4; ++ks) acc = __builtin_amdgcn_mfma_f32_32x32x16_bf16(qa[ks], kbuf[uu][ks], acc, 0, 0, 0);
#define RELU_(x) __int_as_float(max(__float_as_int(x), 0))
                const float p0 = wv[0][0] * RELU_(acc[0]) + wv[1][0] * RELU_(acc[4]) + wv[2][0] * RELU_(acc[8]) + wv[3][0] * RELU_(acc[12]);
                const float p1 = wv[0][1] * RELU_(acc[1]) + wv[1][1] * RELU_(acc[5]) + wv[2][1] * RELU_(acc[9]) + wv[3][1] * RELU_(acc[13]);
                const float p2 = wv[0][2] * RELU_(acc[2]) + wv[1][2] * RELU_(acc[6]) + wv[2][2] * RELU_(acc[10]) + wv[3][2] * RELU_(acc[14]);
                const float p3 = wv[0][3] * RELU_(acc[3]) + wv[1][3] * RELU_(acc[7]) + wv[2][3] * RELU_(acc[11]) + wv[3][3] * RELU_(acc[15]);
#undef RELU_
                const auto r02 = __builtin_amdgcn_permlane32_swap(__float_as_uint(p0), __float_as_uint(p2), false, false);
                const auto r13 = __builtin_amdgcn_permlane32_swap(__float_as_uint(p1), __float_as_uint(p3), false, false);
                const float sa = __uint_as_float(r02[0]) + __uint_as_float(r02[1]);
                const float sb = __uint_as_float(r13[0]) + __uint_as_float(r13[1]);
#pragma unroll
                for (int jj = 0; jj < 2; ++jj) {
                  const int j = kg * 2 + jj;
                  const float s = (jj ? sb : sa) + 0.0f;
                  unsigned ub = __float_as_uint(s);
                  ub ^= (unsigned)((int)ub >> 31) | 0x80000000u;
                  if (key > q0 + j) ub = 0u;
                  SC[j * SCLD + key] = ub;
                  if (ub != 0u) {
                    const unsigned bin = ub >> 21;
                    __hip_atomic_fetch_add(HIST + j * 1024 + (bin >> 1), 1u << ((bin & 1u) * 16u), __ATOMIC_RELAXED, __HIP_MEMORY_SCOPE_WORKGROUP);
                  }
                }
                }
              }
            }
          }
        }
        __syncthreads();
        for (int rsel = 0; rsel < REP_SEL; ++rsel) {
          const int j = wave & 3, half = wave >> 2, qpos = q0 + j, nvalid = qpos + 1;
          const bool big = nvalid > 256;
          int* idx = IDX + j * 256;
          int* cand = CAND + (j * 2 + half) * CAND_CAP2;
          int* XCH = (int*)((char*)shm + LDS_XCH_OFF);
          const unsigned* sc1 = SC + j * SCLD;
          const uint4* sc4 = (const uint4*)sc1;
          const int nh = (nit + 1) >> 1;
          const int g0 = half ? nh : 0, g1 = half ? nit : nh;
          unsigned prefix = 0u;
          if (big) {
            const u32x4* hq = (const u32x4*)(HIST + j * 1024) + lane * 4;
            const u32x4 w0 = hq[0], w1 = hq[1], w2 = hq[2], w3 = hq[3];
            unsigned cw[16];
#pragma unroll
            for (int q = 0; q < 4; ++q) { cw[q] = w0[q]; cw[4 + q] = w1[q]; cw[8 + q] = w2[q]; cw[12 + q] = w3[q]; }
            int sl = 0;
#pragma unroll
            for (int q = 0; q < 16; ++q) sl += (int)(cw[q] & 0xffffu) + (int)(cw[q] >> 16);
            int S = sl;
#pragma unroll
            for (int o = 1; o < 64; o <<= 1) {
              const int tv = __builtin_amdgcn_ds_bpermute(((lane + o) & 63) << 2, S);
              if (lane + o < 64) S += tv;
            }
            const int L = __popcll(__ballot(S >= 256)) - 1;
            int run = S - sl, found = -1;
#pragma unroll
            for (int bb = 31; bb >= 0; --bb) {
              run += (bb & 1) ? (int)(cw[bb >> 1] >> 16) : (int)(cw[bb >> 1] & 0xffffu);
              if (run >= 256 && found < 0) found = bb;
            }
            const int fb = __builtin_amdgcn_readlane(found, L);
            prefix = (unsigned)(L * 32 + fb) << 21;
          }
          __syncthreads();
          const unsigned P = prefix >> 21;
          int c = 0, m = 0;
          if (big) {
            for (int it = g0 * 4; it < g1 * 4; it += 4) {
              unsigned x[4];
#pragma unroll
              for (int e = 0; e < 4; ++e) x[e] = sc1[(it + e) * 64 + lane];
#pragma unroll
              for (int e = 0; e < 4; ++e) {
                const unsigned t = x[e] >> 21;
                const bool isA = t > P, isB = t == P;
                const unsigned long long mA = __ballot(isA), mB = __ballot(isB);
                const int oA = __builtin_amdgcn_mbcnt_hi((unsigned)(mA >> 32), __builtin_amdgcn_mbcnt_lo((unsigned)mA, 0u));
                const int oB = __builtin_amdgcn_mbcnt_hi((unsigned)(mB >> 32), __builtin_amdgcn_mbcnt_lo((unsigned)mB, 0u));
                if (isA) idx[half ? (255 - (c + oA)) : (c + oA)] = (it + e) * 64 + lane;
                if (isB && (m + oB) < CAND_CAP2) cand[m + oB] = (it + e) * 64 + lane;
                c += __popcll(mA);
                m += __popcll(mB);
              }
            }
          }
          if (lane == 0) { XCH[16 + wave * 2] = c; XCH[16 + wave * 2 + 1] = m; }
          __syncthreads();
          if (half == 0) {
            if (!big) {
              for (int i = lane; i < 256; i += 64) idx[i] = (i < nvalid) ? i : 0;
            } else {
              const int cB = XCH[16 + (wave + 4) * 2], mB = XCH[16 + (wave + 4) * 2 + 1];
              const int mA = m, mt = mA + mB;
              const int* candB = CAND + (j * 2 + 1) * CAND_CAP2;
              if (mA <= CAND_CAP2 && mB <= CAND_CAP2) {
                const int need = 256 - c - cB;
                unsigned T = prefix;
                auto fine = [&](auto KMtag) {
                  constexpr int KM = decltype(KMtag)::value;
                  unsigned cv[KM];
                  int ci[KM];
#pragma unroll
                  for (int k = 0; k < KM; ++k) {
                    const int i = k * 64 + lane;
                    ci[k] = (i < mA) ? cand[i] : ((i < mt) ? candB[i - mA] : 0);
                    cv[k] = (i < mt) ? sc1[ci[k]] : 0u;
                  }
                  for (int bit = 20; bit >= 0; --bit) {
                    const unsigned cd = T | (1u << bit);
                    int cnt = 0;
#pragma unroll
                    for (int k = 0; k < KM; ++k) cnt += __popcll(__ballot(cv[k] >= cd));
                    if (cnt >= need) T = cd;
                  }
                  int pos = c;
#pragma unroll
                  for (int k = 0; k < KM; ++k) {
                    const bool sel = cv[k] > T;
                    const unsigned long long mk = __ballot(sel);
                    const int off = __builtin_amdgcn_mbcnt_hi((unsigned)(mk >> 32), __builtin_amdgcn_mbcnt_lo((unsigned)mk, 0u));
                    if (sel) idx[pos + off] = ci[k];
                    pos += __popcll(mk);
                  }
                  const int lim = 256 - cB;
#pragma unroll
                  for (int k = 0; k < KM; ++k) {
                    const bool sel = cv[k] == T;
                    const unsigned long long mk = __ballot(sel);
                    const int off = __builtin_amdgcn_mbcnt_hi((unsigned)(mk >> 32), __builtin_amdgcn_mbcnt_lo((unsigned)mk, 0u));
                    if (sel && (pos + off) < lim) idx[pos + off] = ci[k];
                    pos += __popcll(mk);
                  }
                };
                if (mt <= 256) fine(std::integral_constant<int, 4>{});
                else fine(std::integral_constant<int, (2 * CAND_CAP2) / 64>{});
              } else {
                unsigned pf = 0u;
                for (int bit = 31; bit >= 0; --bit) {
                  const unsigned cd = pf | (1u << bit);
                  int cnt = 0;
                  for (int it = 0; it < nit; ++it) {
                    const uint4 v = sc4[it * 64 + lane];
                    cnt += __popcll(__ballot(v.x >= cd)) + __popcll(__ballot(v.y >= cd)) + __popcll(__ballot(v.z >= cd)) + __popcll(__ballot(v.w >= cd));
                  }
                  if (cnt >= 256) pf = cd;
                }
                const unsigned T = pf;
                int c2 = 0;
                const int nit64 = nit * 4;
                for (int it = 0; it < nit64; ++it) {
                  const unsigned x = sc1[it * 64 + lane];
                  const bool sel = x > T;
                  const unsigned long long mask = __ballot(sel);
                  const int off = __builtin_amdgcn_mbcnt_hi((unsigned)(mask >> 32), __builtin_amdgcn_mbcnt_lo((unsigned)mask, 0u));
                  if (sel) idx[c2 + off] = it * 64 + lane;
                  c2 += __popcll(mask);
                }
                for (int it = 0; it < nit64 && c2 < 256; ++it) {
                  const unsigned x = sc1[it * 64 + lane];
                  const bool sel = x == T;
                  const unsigned long long mask = __ballot(sel);
                  const int off = __builtin_amdgcn_mbcnt_hi((unsigned)(mask >> 32), __builtin_amdgcn_mbcnt_lo((unsigned)mask, 0u));
                  if (sel && (c2 + off) < 256) idx[c2 + off] = it * 64 + lane;
                  c2 += __popcll(mask);
                }
              }
            }
          }
          if (rsel + 1 < REP_SEL) __syncthreads();
        }
        __syncthreads();
        {
          u32x4* hz = (u32x4*)HIST + (wave * 64 + lane) * 2;
          unsigned z = 0u;
          asm volatile("" : "+v"(z));
          hz[0] = (u32x4){z, z, z, z}; hz[1] = (u32x4){z, z, z, z};
        }
        for (int ratt = 0; ratt < REP_ATT; ++ratt) {
          if (ratt) __syncthreads();
          const int j = wave & 3, half = wave >> 2, qpos = q0 + j;
          const int nsel = (qpos + 1) < 256 ? (qpos + 1) : 256;
          const int* idx = IDX + j * 256;
          bf16_t* ST = (bf16_t*)((char*)shm + wave * (32 * ST_LD * 2));
          float* XF = (float*)ST;
          const int fr = lane & 15, fq = lane >> 4;
          bf16x8 qb[8];
          const bf16_t* qlp = QLAT + (size_t)qpos * 4096 + fr * 256 + fq * 8;
#pragma unroll
          for (int ks = 0; ks < 8; ++ks) qb[ks] = *(const bf16x8*)(qlp + ks * 32);
          f32x4 o[16];
#pragma unroll
          for (int i = 0; i < 16; ++i) o[i] = (f32x4){0.f, 0.f, 0.f, 0.f};
          float mrun = -INFINITY, lrun = 0.f;
          const int nchunk = (nsel + 31) >> 5, nfirst = (nchunk + 1) >> 1;
          const int cb = half ? nfirst : 0, ce = half ? nchunk : nfirst;
          const unsigned st_base = (unsigned)(size_t)(__attribute__((address_space(3))) char*)ST;
          const unsigned tr_addr = st_base + (unsigned)(((fq * 4 + (fr >> 2)) * ST_LD + (fr & 3) * 4) * 2);
          bf16x8 ar[2][8];
          {
            const int c0 = (cb < ce) ? cb : 0;
#pragma unroll
            for (int tt = 0; tt < 2; ++tt) {
              const bf16_t* kr = CKV + (size_t)idx[c0 * 32 + tt * 16 + fr] * 256 + fq * 8;
#pragma unroll
              for (int ks = 0; ks < 8; ++ks) ar[tt][ks] = *(const bf16x8*)(kr + ks * 32);
            }
          }
          for (int ch = cb; ch < ce; ++ch) {
            f32x4 s[2];
#pragma unroll
            for (int tt = 0; tt < 2; ++tt) {
              s[tt] = (f32x4){0.f, 0.f, 0.f, 0.f};
#pragma unroll
              for (int ks = 0; ks < 8; ++ks) s[tt] = __builtin_amdgcn_mfma_f32_16x16x32_bf16(ar[tt][ks], qb[ks], s[tt], 0, 0, 0);
            }
#pragma unroll
            for (int tt = 0; tt < 2; ++tt)
#pragma unroll
              for (int ks = 0; ks < 8; ++ks) *(bf16x8*)(ST + (tt * 16 + fr) * ST_LD + ks * 32 + fq * 8) = ar[tt][ks];
            asm volatile("s_waitcnt lgkmcnt(0)" ::: "memory");
            __builtin_amdgcn_wave_barrier();
            {
              const int cn = (ch + 1 < ce) ? ch + 1 : ch;
#pragma unroll
              for (int tt = 0; tt < 2; ++tt) {
                const bf16_t* kr = CKV + (size_t)idx[cn * 32 + tt * 16 + fr] * 256 + fq * 8;
#pragma unroll
                for (int ks = 0; ks < 8; ++ks) ar[tt][ks] = *(const bf16x8*)(kr + ks * 32);
              }
            }
            if (nsel < 256) {
#pragma unroll
              for (int tt = 0; tt < 2; ++tt)
#pragma unroll
                for (int e = 0; e < 4; ++e)
                  if (ch * 32 + tt * 16 + fq * 4 + e >= nsel) s[tt][e] = -INFINITY;
            }
            float mx = fmaxf(fmaxf(fmaxf(s[0][0], s[0][1]), fmaxf(s[0][2], s[0][3])), fmaxf(fmaxf(s[1][0], s[1][1]), fmaxf(s[1][2], s[1][3])));
            mx = fmaxf(mx, shx(mx, 16, lane));
            mx = fmaxf(mx, shx(mx, 32, lane));
            const float mnew = fmaxf(mrun, mx);
            const float alpha = __builtin_amdgcn_exp2f(mrun - mnew);
            float ps = 0.f;
            float pv[8];
#pragma unroll
            for (int tt = 0; tt < 2; ++tt)
#pragma unroll
              for (int e = 0; e < 4; ++e) {
                const float pe = __builtin_amdgcn_exp2f(s[tt][e] - mnew);
                pv[tt * 4 + e] = pe;
                ps += pe;
              }
            ps += shx(ps, 16, lane);
            ps += shx(ps, 32, lane);
            lrun = lrun * alpha + ps;
            mrun = mnew;
            union { bf16x8 v; unsigned u[4]; } pb;
            pb.u[0] = pk2(pv[0], pv[1]); pb.u[1] = pk2(pv[2], pv[3]); pb.u[2] = pk2(pv[4], pv[5]); pb.u[3] = pk2(pv[6], pv[7]);
#pragma unroll
            for (int rt = 0; rt < 16; ++rt) o[rt] *= alpha;
#pragma unroll
            for (int rb = 0; rb < 4; ++rb) {
              union { bf16x8 v; u16x4 h[2]; } va[4];
              asm volatile(
                  "ds_read_b64_tr_b16 %0, %8 offset:%9\n\t"
                  "ds_read_b64_tr_b16 %1, %8 offset:%10\n\t"
                  "ds_read_b64_tr_b16 %2, %8 offset:%11\n\t"
                  "ds_read_b64_tr_b16 %3, %8 offset:%12\n\t"
                  "ds_read_b64_tr_b16 %4, %8 offset:%13\n\t"
                  "ds_read_b64_tr_b16 %5, %8 offset:%14\n\t"
                  "ds_read_b64_tr_b16 %6, %8 offset:%15\n\t"
                  "ds_read_b64_tr_b16 %7, %8 offset:%16\n\t"
                  "s_waitcnt lgkmcnt(0)"
                  : "=&v"(va[0].h[0]), "=&v"(va[0].h[1]), "=&v"(va[1].h[0]), "=&v"(va[1].h[1]),
                    "=&v"(va[2].h[0]), "=&v"(va[2].h[1]), "=&v"(va[3].h[0]), "=&v"(va[3].h[1])
                  : "v"(tr_addr),
                    "i"((rb * 4 + 0) * 32), "i"((rb * 4 + 0) * 32 + 16 * ST_LD * 2),
                    "i"((rb * 4 + 1) * 32), "i"((rb * 4 + 1) * 32 + 16 * ST_LD * 2),
                    "i"((rb * 4 + 2) * 32), "i"((rb * 4 + 2) * 32 + 16 * ST_LD * 2),
                    "i"((rb * 4 + 3) * 32), "i"((rb * 4 + 3) * 32 + 16 * ST_LD * 2)
                  : "memory");
#pragma unroll
              for (int q = 0; q < 4; ++q)
                o[rb * 4 + q] = __builtin_amdgcn_mfma_f32_16x16x32_bf16(va[q].v, pb.v, o[rb * 4 + q], 0, 0, 0);
            }
            asm volatile("s_waitcnt lgkmcnt(0)" ::: "memory");
            __builtin_amdgcn_wave_barrier();
          }
          if (half == 1) {
            XF[lane] = mrun;
            XF[64 + lane] = lrun;
#pragma unroll
            for (int rt = 0; rt < 16; ++rt)
#pragma unroll
              for (int e = 0; e < 4; ++e) XF[(2 + rt * 4 + e) * 64 + lane] = o[rt][e];
          }
          __syncthreads();
          if (half == 0) {
            const float* XP = (const float*)((char*)shm + (wave + 4) * (32 * ST_LD * 2));
            const float m1 = XP[lane], l1 = XP[64 + lane];
            const float mm = fmaxf(mrun, m1);
            const float a0 = __builtin_amdgcn_exp2f(mrun - mm), a1 = __builtin_amdgcn_exp2f(m1 - mm);
            const float invl = 1.0f / (lrun * a0 + l1 * a1);
            const float w0 = a0 * invl, w1 = a1 * invl;
            bf16_t* op = OLAT + (size_t)qpos * 4096 + fr * 256 + fq * 4;
#pragma unroll
            for (int rt = 0; rt < 16; ++rt) {
              float r[4];
#pragma unroll
              for (int e = 0; e < 4; ++e) r[e] = o[rt][e] * w0 + XP[(2 + rt * 4 + e) * 64 + lane] * w1;
              uint2 w; w.x = pk2(r[0], r[1]); w.y = pk2(r[2], r[3]);
              *(uint2*)(op + rt * 16) = w;
            }
          }
        }
        if (wave == 0 && lane == 0) *QW = nxt;
        __syncthreads();
        tkt = __builtin_amdgcn_readfirstlane(*QW);
      }
      {
        const float* psc = p.in[10] + (size_t)l * 1024;
        const int ntiles = 4 * NMT;
        for (int t = bid; t < ntiles; t += G) {
          const int g = t / NMT, pm = t % NMT;
          auto epi8 = [&](int row, int col, f32x4 a, f32x4 b) {
            const float4 sa = *(const float4*)(psc + g * 256 + col), sb = *(const float4*)(psc + g * 256 + col + 4);
            uint4 o; o.x = pk2(a[0] * sa.x, a[1] * sa.y); o.y = pk2(a[2] * sa.z, a[3] * sa.w); o.z = pk2(b[0] * sb.x, b[1] * sb.y); o.w = pk2(b[2] * sb.z, b[3] * sb.w);
            *(uint4*)(YP2 + (size_t)row * 1024 + g * 256 + col) = o;
          };
          gemm_tile(YPOOL + g * 256, 1024, WPOOL + (size_t)g * 65536, 256, pm * 256, 0, 256, epi8, wave_s);
        }
        int tid2 = wave_s * 64 + lane_id();
        asm volatile("" : "+v"(tid2));
        const int lane2 = tid2 & 63, gw2 = bid * 8 + (tid2 >> 6);
        for (int task = gw2; task < 4 * 16; task += NGW) {
          const int g = task >> 4, ct = task & 15;
          auto epi = [&](int row, int col, f32x4 v) {
            const float4 sc = *(const float4*)(psc + g * 256 + col);
            uint2 o; o.x = pk2(v[0] * sc.x, v[1] * sc.y); o.y = pk2(v[2] * sc.z, v[3] * sc.w);
            *(uint2*)(YP2 + (size_t)row * 1024 + g * 256 + col) = o;
          };
          tail_tile1(YPOOL + (size_t)TAIL0 * 1024 + g * 256, 1024, WPOOL + (size_t)g * 65536, 256, ct, 256, lane2, epi);
        }
      }
    }
    xcd_barrier(xbar, wave_s);

    {
      PHASE_PTRS
      auto epib = [&](int row, int col, f32x4 v) {
        const uint2 raw = *(const uint2*)(PROJ + (size_t)row * NINP + C_GB + col);
        f32x4 o;
        o[0] = sigmoidf(bf2f(raw.x & 0xffff)) * v[0]; o[1] = sigmoidf(bf2f(raw.x >> 16)) * v[1];
        o[2] = sigmoidf(bf2f(raw.y & 0xffff)) * v[2]; o[3] = sigmoidf(bf2f(raw.y >> 16)) * v[3];
        *(f32x4*)(MB + (size_t)row * D + col) = o;
      };
      auto epib8 = [&](int row, int col, f32x4 a, f32x4 b) {
        const uint4 raw = *(const uint4*)(PROJ + (size_t)row * NINP + C_GB + col);
        f32x4 oa, ob;
        oa[0] = sigmoidf(bf2f(raw.x & 0xffff)) * a[0]; oa[1] = sigmoidf(bf2f(raw.x >> 16)) * a[1];
        oa[2] = sigmoidf(bf2f(raw.y & 0xffff)) * a[2]; oa[3] = sigmoidf(bf2f(raw.y >> 16)) * a[3];
        ob[0] = sigmoidf(bf2f(raw.z & 0xffff)) * b[0]; ob[1] = sigmoidf(bf2f(raw.z >> 16)) * b[1];
        ob[2] = sigmoidf(bf2f(raw.w & 0xffff)) * b[2]; ob[3] = sigmoidf(bf2f(raw.w >> 16)) * b[3];
        f32x4* mp = (f32x4*)(MB + (size_t)row * D + col);
        mp[0] = oa; mp[1] = ob;
      };
      const int n1 = 16 * NMT, n2 = NMT * 8;
      for (int t = bid; t < n1 + n2; t += G) {
        if (t < n1) {
          const int h = t / NMT, pm = t % NMT;
          auto epi8 = [&](int row, int col, f32x4 a, f32x4 b) {
            if (col < 128) {
              uint4 o; o.x = pk2(a[0], a[1]); o.y = pk2(a[2], a[3]); o.z = pk2(b[0], b[1]); o.w = pk2(b[2], b[3]);
              *(uint4*)(OB + (size_t)row * D + h * 128 + col) = o;
            }
          };
          gemm_tile(OLAT + h * 256, 4096, WUV + (size_t)h * 65536, 256, pm * 256, 0, 256, epi8, wave_s);
        } else {
          int pm, pn; tile_map(t - n1, NMT, 8, pm, pn);
          gemm_tile(YP2, 1024, WPO, 1024, pm * 256, pn * 256, 1024, epib8, wave_s);
        }
      }
      int tid2 = wave_s * 64 + lane_id();
      asm volatile("" : "+v"(tid2));
      const int lane2 = tid2 & 63, gw2 = bid * 8 + (tid2 >> 6);
      for (int task = gw2; task < 16 * 8; task += NGW) {
        const int h = task >> 3, ct = task & 7;
        auto epi = [&](int row, int col, f32x4 v) {
          uint2 o; o.x = pk2(v[0], v[1]); o.y = pk2(v[2], v[3]);
          *(uint2*)(OB + (size_t)row * D + h * 128 + col) = o;
        };
        tail_tile1(OLAT + (size_t)TAIL0 * 4096 + h * 256, 4096, WUV + (size_t)h * 65536, 256, ct, 256, lane2, epi);
      }
      tail_gemm8(YP2 + (size_t)TAIL0 * 1024, 1024, WPO, 1024, D / 16, 1024, epib, wave_s);
    }
    xcd_barrier(xbar, wave_s);

    {
      PHASE_PTRS
      auto epi = [&](int row, int col, f32x4 v) {
        const uint2 raw = *(const uint2*)(PROJ + (size_t)row * NINP + C_GA + col);
        const f32x4 mb = *(const f32x4*)(MB + (size_t)row * D + col);
        uint2 o;
        o.x = pk2(sigmoidf(bf2f(raw.x & 0xffff)) * v[0] + mb[0], sigmoidf(bf2f(raw.x >> 16)) * v[1] + mb[1]);
        o.y = pk2(sigmoidf(bf2f(raw.y & 0xffff)) * v[2] + mb[2], sigmoidf(bf2f(raw.y >> 16)) * v[3] + mb[3]);
        *(uint2*)(MERGED + (size_t)row * D + col) = o;
      };
      auto epi8 = [&](int row, int col, f32x4 a, f32x4 b) {
        const uint4 raw = *(const uint4*)(PROJ + (size_t)row * NINP + C_GA + col);
        const f32x4* mp = (const f32x4*)(MB + (size_t)row * D + col);
        const f32x4 ma = mp[0], mb = mp[1];
        uint4 o;
        o.x = pk2(sigmoidf(bf2f(raw.x & 0xffff)) * a[0] + ma[0], sigmoidf(bf2f(raw.x >> 16)) * a[1] + ma[1]);
        o.y = pk2(sigmoidf(bf2f(raw.y & 0xffff)) * a[2] + ma[2], sigmoidf(bf2f(raw.y >> 16)) * a[3] + ma[3]);
        o.z = pk2(sigmoidf(bf2f(raw.z & 0xffff)) * b[0] + mb[0], sigmoidf(bf2f(raw.z >> 16)) * b[1] + mb[1]);
        o.w = pk2(sigmoidf(bf2f(raw.w & 0xffff)) * b[2] + mb[2], sigmoidf(bf2f(raw.w >> 16)) * b[3] + mb[3]);
        *(uint4*)(MERGED + (size_t)row * D + col) = o;
      };
      for (int t = bid; t < NMT * 8; t += G) {
        int pm, pn; tile_map(t, NMT, 8, pm, pn);
        gemm_tile(OB, D, WAO, D, pm * 256, pn * 256, D, epi8, wave_s);
      }
      tail_gemm8(OB + (size_t)TAIL0 * D, D, WAO, D, D / 16, D, epi, wave_s);
    }
    xcd_barrier(xbar, wave_s);

    {
      PHASE_PTRS
      auto epi = [&](int row, int col, f32x4 v) {
        f32x4* hp = (f32x4*)(HRES + (size_t)row * D + col);
        *hp = *hp + v;
      };
      auto epi8 = [&](int row, int col, f32x4 a, f32x4 b) {
        f32x4* hp = (f32x4*)(HRES + (size_t)row * D + col);
        const f32x4 ha = hp[0], hb = hp[1];
        hp[0] = ha + a; hp[1] = hb + b;
      };
      for (int t = bid; t < NMT * 8; t += G) {
        int pm, pn; tile_map(t, NMT, 8, pm, pn);
        gemm_tile(MERGED, D, WOUT, D, pm * 256, pn * 256, D, epi8, wave_s);
      }
      tail_gemm8(MERGED + (size_t)TAIL0 * D, D, WOUT, D, D / 16, D, epi, wave_s);
    }
    xcd_barrier(xbar, wave_s);

    {
      PHASE_IDS
      rmsnorm_rows(HRES, p.in[13] + (size_t)l * D, HN, gw, NGW, lane);
    }
    xcd_barrier(xbar, wave_s);

    for (int rep = 0; rep < REP_P9; ++rep) {
      PHASE_PTRS
      auto epi = [&](int row, int col, f32x4 v) {
        float a0 = fmaxf(v[0], 0.f), a1 = fmaxf(v[1], 0.f), a2 = fmaxf(v[2], 0.f), a3 = fmaxf(v[3], 0.f);
        uint2 o; o.x = pk2(a0 * a0, a1 * a1); o.y = pk2(a2 * a2, a3 * a3);
        *(uint2*)(UB + (size_t)row * DFF + col) = o;
      };
      auto epi8 = [&](int row, int col, f32x4 a, f32x4 b) {
        const float a0 = fmaxf(a[0], 0.f), a1 = fmaxf(a[1], 0.f), a2 = fmaxf(a[2], 0.f), a3 = fmaxf(a[3], 0.f);
        const float b0 = fmaxf(b[0], 0.f), b1 = fmaxf(b[1], 0.f), b2 = fmaxf(b[2], 0.f), b3 = fmaxf(b[3], 0.f);
        uint4 o; o.x = pk2(a0 * a0, a1 * a1); o.y = pk2(a2 * a2, a3 * a3); o.z = pk2(b0 * b0, b1 * b1); o.w = pk2(b2 * b2, b3 * b3);
        *(uint4*)(UB + (size_t)row * DFF + col) = o;
      };
      const int nN = DFF / 256, ntiles = NMT * nN;
      for (int t = bid; t < ntiles; t += G) {
        int pm, pn; tile_map(t, NMT, nN, pm, pn);
        gemm_tile(HN, D, WMI, D, pm * 256, pn * 256, D, epi8, wave_s);
      }
      tail_gemm8(HN + (size_t)TAIL0 * D, D, WMI, D, DFF / 16, D, epi, wave_s);
    }
    xcd_barrier(xbar, wave_s);

    {
      PHASE_PTRS
      auto epi = [&](int row, int col, f32x4 v) {
        f32x4* hp = (f32x4*)(HRES + (size_t)row * D + col);
        *hp = *hp + v;
      };
      auto epi8 = [&](int row, int col, f32x4 a, f32x4 b) {
        f32x4* hp = (f32x4*)(HRES + (size_t)row * D + col);
        const f32x4 ha = hp[0], hb = hp[1];
        hp[0] = ha + a; hp[1] = hb + b;
      };
      for (int t = bid; t < NMT * 8; t += G) {
        int pm, pn; tile_map(t, NMT, 8, pm, pn);
        gemm_tile(UB, DFF, WMO, DFF, pm * 256, pn * 256, DFF, epi8, wave_s);
      }
      tail_gemm8(UB + (size_t)TAIL0 * DFF, DFF, WMO, DFF, D / 16, DFF, epi, wave_s);
    }
    xcd_barrier(xbar, wave_s);
  }

  {
    BLOCK_IDS
    PHASE_IDS
    const float* g = p.in[16];
    for (int r0 = gw; r0 < SEQ; r0 += 2 * NGW) {
      const int r1 = (r0 + NGW < SEQ) ? r0 + NGW : r0;
      f32x4 va[8], vb[8];
#pragma unroll
      for (int j = 0; j < 8; ++j) {
        va[j] = __builtin_nontemporal_load((const f32x4*)(HRES + (size_t)(r0 + NMETA) * D + j * 256 + lane * 4));
        vb[j] = __builtin_nontemporal_load((const f32x4*)(HRES + (size_t)(r1 + NMETA) * D + j * 256 + lane * 4));
      }
      float sa = 0.f, sb = 0.f;
#pragma unroll
      for (int j = 0; j < 8; ++j) {
        sa += va[j][0] * va[j][0] + va[j][1] * va[j][1] + va[j][2] * va[j][2] + va[j][3] * va[j][3];
        sb += vb[j][0] * vb[j][0] + vb[j][1] * vb[j][1] + vb[j][2] * vb[j][2] + vb[j][3] * vb[j][3];
      }
#pragma unroll
      for (int o = 1; o < 64; o <<= 1) { sa += shx(sa, o, lane); sb += shx(sb, o, lane); }
      const float ra = rsqrtf(sa * (1.0f / D) + 1e-6f), rb = rsqrtf(sb * (1.0f / D) + 1e-6f);
#pragma unroll
      for (int j = 0; j < 8; ++j) {
        const f32x4 gg = *(const f32x4*)(g + j * 256 + lane * 4);
        __builtin_nontemporal_store((f32x4){va[j][0] * ra * gg[0], va[j][1] * ra * gg[1], va[j][2] * ra * gg[2], va[j][3] * ra * gg[3]}, (f32x4*)(p.out + (size_t)r0 * D + j * 256 + lane * 4));
        __builtin_nontemporal_store((f32x4){vb[j][0] * rb * gg[0], vb[j][1] * rb * gg[1], vb[j][2] * rb * gg[2], vb[j][3] * rb * gg[3]}, (f32x4*)(p.out + (size_t)r1 * D + j * 256 + lane * 4));
      }
    }
  }
}

extern "C" void kernel_launch(void* const* d_in, const int* in_sizes, int n_in, void* d_out, int out_size,
                              void* d_ws, size_t ws_size, hipStream_t stream) {
  static int grid_blocks = 0;
  if (!grid_blocks) {
    int dev = 0, cus = 0, per_cu = 0;
    (void)hipGetDevice(&dev);
    (void)hipDeviceGetAttribute(&cus, hipDeviceAttributeMultiprocessorCount, dev);
    (void)hipFuncSetAttribute((const void*)fwd, hipFuncAttributeMaxDynamicSharedMemorySize, LDS_BYTES);
    (void)hipOccupancyMaxActiveBlocksPerMultiprocessor(&per_cu, (const void*)fwd, 512, LDS_BYTES);
    (void)hipGetLastError();
    grid_blocks = cus > 0 ? cus : 256;
    if (ws_size < WS_END) { fprintf(stderr, "workspace too small: %zu < %zu\n", ws_size, (size_t)WS_END); grid_blocks = -1; }
  }
  if (grid_blocks < 0) return;
  Params p{};
  for (int i = 0; i < 17; ++i) p.in[i] = (const float*)d_in[i];
  p.out = (float*)d_out;
  p.ws = (unsigned char*)d_ws;
  (void)hipMemsetAsync((unsigned char*)d_ws + OFF_BAR, 0, BAR_BYTES, stream);
  void* args[] = {&p};
  hipError_t e = hipLaunchCooperativeKernel((void*)fwd, dim3(grid_blocks), dim3(512), args, LDS_BYTES, stream);
  if (e != hipSuccess) fprintf(stderr, "cooperative launch failed: %s (grid %d)\n", hipGetErrorString(e), grid_blocks);
}
```
